# Optimizing an MI355X kernel written in HIP

```python
import jax, jax.numpy as jnp
from jax import lax
import numpy as np

D_MODEL = 2048
BATCH = 2
SEQ = 4096
DEPTH = 1

HEAD_DIM = 128
MIX_WIDTH = D_MODEL
N_HEADS_A = MIX_WIDTH // (2 * HEAD_DIM)
N_HEADS_B = MIX_WIDTH // (2 * HEAD_DIM)
GQA_REP = 4
N_KV_B = N_HEADS_B // GQA_REP
WIDTH_A = N_HEADS_A * HEAD_DIM
WIDTH_B = N_HEADS_B * HEAD_DIM
KV_WIDTH_B = N_KV_B * HEAD_DIM
DILATED_GROUPS = ((128, 1), (512, 4), (2048, 16))
HALF_WINDOW_B = 128
N_MEM = 256
N_HEADS_MEM = 4
WIDTH_MEM = N_HEADS_MEM * HEAD_DIM
N_EXPERTS = 16
EC_CAPACITY = 2
D_FF_EXPERT = D_MODEL
ROPE_THETA = 10000.0
EPS = 1e-6
NEG_INF = -1e30
IN_WIDTHS = (WIDTH_A, WIDTH_A, WIDTH_A, WIDTH_B, KV_WIDTH_B, KV_WIDTH_B)
IN_OFFSETS = tuple(int(o) for o in np.cumsum(IN_WIDTHS)[:-1])
D_IN = int(sum(IN_WIDTHS))

kernel_name = "hybrid_dilated_swa_sink_ec_moe_encoder"


def rmsnorm(x, g):
    xf = x.astype(jnp.float32)
    y = xf * lax.rsqrt(jnp.mean(xf * xf, axis=-1, keepdims=True) + EPS)
    return (y * g.astype(jnp.float32)).astype(x.dtype)


def rope_tables(positions):
    inv_freq = ROPE_THETA ** (-jnp.arange(0, HEAD_DIM, 2, dtype=jnp.float32) / HEAD_DIM)
    ang = positions.astype(jnp.float32)[..., None] * inv_freq
    return jnp.cos(ang)[:, None], jnp.sin(ang)[:, None]


def apply_rope(t, cos, sin):
    tf = t.astype(jnp.float32)
    t1, t2 = tf[..., : HEAD_DIM // 2], tf[..., HEAD_DIM // 2:]
    out = jnp.concatenate([t1 * cos - t2 * sin, t2 * cos + t1 * sin], axis=-1)
    return out.astype(t.dtype)


def to_heads(t, n):
    b, s, _ = t.shape
    return t.reshape(b, s, n, HEAD_DIM).transpose(0, 2, 1, 3)


def merge_heads(t):
    b, h, s, d = t.shape
    return t.transpose(0, 2, 1, 3).reshape(b, s, h * d)


def pad_axis(t, axis, before, after):
    widths = [(0, 0)] * t.ndim
    widths[axis % t.ndim] = (before, after)
    return jnp.pad(t, widths)


def three_blocks(t, nb, blk):
    t = t.reshape(t.shape[:-2] + (nb + 2, blk, t.shape[-1]))
    return jnp.concatenate([t[..., :nb, :, :], t[..., 1:nb + 1, :, :], t[..., 2:, :, :]], axis=-2)


def banded_attention(q, k, v, key_valid, half, sink=None):
    blk = half
    L = q.shape[-2]
    nb = -(-L // blk)
    extra = nb * blk - L
    qb = pad_axis(q, -2, 0, extra)
    qb = qb.reshape(qb.shape[:-2] + (nb, blk, qb.shape[-1]))
    kb = three_blocks(pad_axis(k, -2, blk, extra + blk), nb, blk)
    vb = three_blocks(pad_axis(v, -2, blk, extra + blk), nb, blk)
    valid = three_blocks(pad_axis(key_valid, -1, blk, extra + blk)[..., None], nb, blk)[..., 0]
    a = np.arange(blk)[:, None]
    c = np.arange(3 * blk)[None, :]
    band = jnp.asarray(np.abs(c - blk - a) <= half)
    mask = band & valid[..., None, :]
    scale = 1.0 / np.sqrt(HEAD_DIM)
    s = jnp.matmul(qb, jnp.swapaxes(kb, -1, -2), preferred_element_type=jnp.float32) * scale
    s = jnp.where(mask, s, NEG_INF)
    if sink is not None:
        s = jnp.concatenate([s, jnp.broadcast_to(sink.astype(jnp.float32), s.shape[:-1] + (1,))], axis=-1)
    lse = jax.nn.logsumexp(s, axis=-1, keepdims=True)
    p = jnp.exp(s - lse)
    if sink is not None:
        p = p[..., :-1]
    o = jnp.matmul(p.astype(v.dtype), vb, preferred_element_type=jnp.float32)
    o = o.reshape(o.shape[:-3] + (nb * blk, o.shape[-1]))[..., :L, :]
    lse = lse.reshape(lse.shape[:-3] + (nb * blk,))[..., :L]
    return o, lse


def dilated_mixture_attention(q, k, v):
    b, h, s, hd = q.shape
    outs, lses = [], []
    for (w, d) in DILATED_GROUPS:
        half = w // (2 * d)
        L = -(-s // d)
        sp = L * d

        def to_strided(t):
            t = pad_axis(t, 2, 0, sp - s)
            return jnp.swapaxes(t.reshape(b, h, L, d, hd), 2, 3)

        key_valid = jnp.asarray((np.arange(L)[None, :] * d + np.arange(d)[:, None]) < s)
        o, lse = banded_attention(to_strided(q), to_strided(k), to_strided(v), key_valid, half)
        outs.append(jnp.swapaxes(o, 2, 3).reshape(b, h, sp, hd)[:, :, :s])
        lses.append(jnp.swapaxes(lse, 2, 3).reshape(b, h, sp)[:, :, :s])
    weights = jax.nn.softmax(jnp.stack(lses), axis=0)
    return jnp.sum(weights[..., None] * jnp.stack(outs), axis=0)


def memory_cross_attention(h, m, w_q, w_kv, g_q, g_k, w_o):
    q = rmsnorm(to_heads(h @ w_q, N_HEADS_MEM), g_q)
    kv = m @ w_kv
    k = rmsnorm(to_heads(kv[..., :WIDTH_MEM], N_HEADS_MEM), g_k)
    v = to_heads(kv[..., WIDTH_MEM:], N_HEADS_MEM)
    s = jnp.einsum('bhqd,bhkd->bhqk', q, k, preferred_element_type=jnp.float32) / np.sqrt(HEAD_DIM)
    p = jax.nn.softmax(s, axis=-1)
    o = jnp.einsum('bhqk,bhkd->bhqd', p.astype(v.dtype), v)
    return merge_heads(o) @ w_o


def expert_choice_moe(h, w_router, w_gate, w_up, w_down):
    b, s, _ = h.shape
    cap = EC_CAPACITY * s // N_EXPERTS
    aff = jax.nn.softmax((h @ w_router).astype(jnp.float32), axis=-1)
    gate, idx = lax.top_k(jnp.swapaxes(aff, 1, 2), cap)
    b_idx = jnp.arange(b)[:, None, None]
    xe = h[b_idx, idx]
    g = jnp.einsum('becd,edf->becf', xe, w_gate)
    u = jnp.einsum('becd,edf->becf', xe, w_up)
    y = jnp.einsum('becf,efd->becd', jax.nn.silu(g) * u, w_down)
    y = y * gate[..., None].astype(y.dtype)
    return jnp.zeros_like(h).at[b_idx, idx].add(y)


def setup_inputs(seed: int = 0) -> dict:
    key = jax.random.key(seed)
    ks = jax.random.split(key, 26)
    f32 = jnp.float32

    def nrm(k, shape, scale):
        return jax.random.normal(k, shape, f32) * scale

    def gain(k, shape):
        return 1.0 + 0.02 * jax.random.normal(k, shape, f32)

    positions = jnp.broadcast_to(jnp.arange(SEQ, dtype=jnp.int32)[None], (BATCH, SEQ))
    return {
        "x": nrm(ks[0], (BATCH, SEQ, D_MODEL), 1.0),
        "mem": nrm(ks[1], (BATCH, N_MEM, D_MODEL), 1.0),
        "positions": positions,
        "g_mix": gain(ks[2], (DEPTH, D_MODEL)),
        "w_in": nrm(ks[3], (DEPTH, D_MODEL, D_IN), D_MODEL ** -0.5),
        "g_qa": gain(ks[4], (DEPTH, HEAD_DIM)),
        "g_ka": gain(ks[5], (DEPTH, HEAD_DIM)),
        "g_qb": gain(ks[6], (DEPTH, HEAD_DIM)),
        "g_kb": gain(ks[7], (DEPTH, HEAD_DIM)),
        "sink_b": nrm(ks[8], (DEPTH, N_HEADS_B), 0.5),
        "g_oa": gain(ks[9], (DEPTH, WIDTH_A)),
        "g_ob": gain(ks[10], (DEPTH, WIDTH_B)),
        "w_out": nrm(ks[11], (DEPTH, MIX_WIDTH, D_MODEL), MIX_WIDTH ** -0.5),
        "g_cross": gain(ks[12], (DEPTH, D_MODEL)),
        "g_mem": gain(ks[13], (DEPTH, D_MODEL)),
        "w_q_mem": nrm(ks[14], (DEPTH, D_MODEL, WIDTH_MEM), D_MODEL ** -0.5),
        "w_kv_mem": nrm(ks[15], (DEPTH, D_MODEL, 2 * WIDTH_MEM), D_MODEL ** -0.5),
        "g_qm": gain(ks[16], (DEPTH, HEAD_DIM)),
        "g_km": gain(ks[17], (DEPTH, HEAD_DIM)),
        "w_o_mem": nrm(ks[18], (DEPTH, WIDTH_MEM, D_MODEL), WIDTH_MEM ** -0.5),
        "g_moe": gain(ks[19], (DEPTH, D_MODEL)),
        "w_router": nrm(ks[20], (DEPTH, D_MODEL, N_EXPERTS), D_MODEL ** -0.5),
        "w_gate": nrm(ks[21], (DEPTH, N_EXPERTS, D_MODEL, D_FF_EXPERT), D_MODEL ** -0.5),
        "w_up": nrm(ks[22], (DEPTH, N_EXPERTS, D_MODEL, D_FF_EXPERT), D_MODEL ** -0.5),
        "w_down": nrm(ks[23], (DEPTH, N_EXPERTS, D_FF_EXPERT, D_MODEL), D_FF_EXPERT ** -0.5),
    }


def reference(x, mem, positions, g_mix, w_in, g_qa, g_ka, g_qb, g_kb, sink_b, g_oa, g_ob,
              w_out, g_cross, g_mem, w_q_mem, w_kv_mem, g_qm, g_km, w_o_mem, g_moe,
              w_router, w_gate, w_up, w_down):
    b, s, _ = x.shape
    cos, sin = rope_tables(positions)
    key_valid_b = jnp.ones((s,), dtype=bool)
    for l in range(DEPTH):
        h = rmsnorm(x, g_mix[l])
        proj = h @ w_in[l]
        qa, ka, va, qb, kb, vb = jnp.split(proj, IN_OFFSETS, axis=-1)
        qa = apply_rope(rmsnorm(to_heads(qa, N_HEADS_A), g_qa[l]), cos, sin)
        ka = apply_rope(rmsnorm(to_heads(ka, N_HEADS_A), g_ka[l]), cos, sin)
        va = to_heads(va, N_HEADS_A)
        oa = dilated_mixture_attention(qa, ka, va).astype(x.dtype)

        qb = apply_rope(rmsnorm(to_heads(qb, N_HEADS_B), g_qb[l]), cos, sin)
        kb = apply_rope(rmsnorm(to_heads(kb, N_KV_B), g_kb[l]), cos, sin)
        vb = to_heads(vb, N_KV_B)
        qb = qb.reshape(b, N_KV_B, GQA_REP, s, HEAD_DIM)
        sink = sink_b[l].reshape(N_KV_B, GQA_REP, 1, 1, 1)
        ob, _ = banded_attention(qb, kb[:, :, None], vb[:, :, None], key_valid_b,
                                 HALF_WINDOW_B, sink=sink)
        ob = ob.reshape(b, N_HEADS_B, s, HEAD_DIM).astype(x.dtype)

        mixed = jnp.concatenate([rmsnorm(merge_heads(oa), g_oa[l]),
                                 rmsnorm(merge_heads(ob), g_ob[l])], axis=-1)
        x = x + mixed @ w_out[l]

        x = x + memory_cross_attention(rmsnorm(x, g_cross[l]), rmsnorm(mem, g_mem[l]),
                                       w_q_mem[l], w_kv_mem[l], g_qm[l], g_km[l], w_o_mem[l])

        x = x + expert_choice_moe(rmsnorm(x, g_moe[l]), w_router[l], w_gate[l], w_up[l], w_down[l])
    return x
```

```cpp
#include <hip/hip_runtime.h>
#include <hip/hip_bf16.h>
#include <cstdio>
#include <cstdint>

#ifndef MK_ONE_LAUNCH
#define MK_ONE_LAUNCH 0
#endif

constexpr int BATCH = 2, SEQ = 4096, DM = 2048, TOK = BATCH * SEQ, HD = 128;
constexpr int DIN = 4608, NMEM = 256, WMEM = 512, NEXP = 16, CAP = 512, DFF = 2048;
constexpr int OFF_QA = 0, OFF_KA = 1024, OFF_VA = 2048, OFF_QB = 3072, OFF_KB = 4096, OFF_VB = 4352;
constexpr float EPS = 1e-6f;
constexpr float LOG2E = 1.4426950408889634f;
constexpr float QSCALE = 0.08838834764831845f * LOG2E;
constexpr float SQRT_HD = 11.313708498984761f;

namespace pg8 {
#define PG8_LAS __attribute__((address_space(3)))
typedef unsigned short bf16_t;
typedef short bf16x8 __attribute__((ext_vector_type(8)));
typedef float f32x4 __attribute__((ext_vector_type(4)));
typedef unsigned u32x4 __attribute__((ext_vector_type(4)));
constexpr int BM = 256, BK = 64, HALF = 128, HTB = HALF * BK * 2  , STAGE_BYTES = 8 * HTB, NXCD = 8, WGM = 8;

__host__ __device__ __forceinline__ int lds_byte(int r, int c) { const int st = (r >> 4) * 2 + (c >> 5), rr = r & 15, cc = c & 31, ob = rr * 64 + cc * 2; return st * 1024 + (ob ^ (((ob >> 9) & 1) << 5)); }
__host__ __device__ __forceinline__ void stage_rc(int b, int& R, int& C) { const int st = b / 1024, sb = b % 1024, swz = sb ^ (((sb >> 9) & 1) << 5); R = (st >> 1) * 16 + swz / 64; C = (st & 1) * 32 + (swz % 64) / 2; }
__host__ __device__ __forceinline__ int perm32(int rho) { const int n = rho >> 4, i = rho & 15; return 8 * (i >> 2) + 4 * n + (i & 3); }

struct Unit { int pm, pn, kind; const char* A; const char* B; };

__device__ __forceinline__ bool static_order(int i, int G, int c, int nM, int nN, int& pm, int& pn) {
    const int nwg = nM * nN; const long L = (long)i * G + c; if (L >= nwg) return false;
    int wgid = (int)L; { const int q = nwg / NXCD, r = nwg % NXCD, xcd = wgid % NXCD, off = wgid / NXCD; wgid = (xcd < r ? xcd * (q + 1) : r * (q + 1) + (xcd - r) * q) + off; }
    const int nig = WGM * nN, gid = wgid / nig, fm = gid * WGM, gsz = (nM - fm) < WGM ? (nM - fm) : WGM;
    pm = fm + ((wgid % nig) % gsz); pn = (wgid % nig) / gsz; return true;
}

__device__ __forceinline__ unsigned cvt_pk_bf16(float lo, float hi) { unsigned r; asm volatile("v_cvt_pk_bf16_f32 %0, %1, %2" : "=v"(r) : "v"(lo), "v"(hi)); return r; }

struct EpiBf16 {
    static constexpr bool PERM = true, AFTER_DRAIN = false;
    bf16_t* O0; int ldc0; bf16_t* O1; int ldc1;
    __device__ __forceinline__ void operator()(const f32x4 (&acc)[2][2][4][2], const Unit& u, int wr, int wc, int fr, int fq) const {
        bf16_t* base = u.kind ? O1 : O0; const int ldc = u.kind ? ldc1 : ldc0;
        const int row0 = u.pm * BM + wr * 64 + fr, col0 = u.pn * BM + wc * 32 + 8 * fq;
#pragma unroll
        for (int ai = 0; ai < 2; ++ai)
#pragma unroll
            for (int m = 0; m < 4; ++m) { bf16_t* rowp = base + (size_t)(row0 + ai * HALF + m * 16) * ldc + col0;
#pragma unroll
                for (int bj = 0; bj < 2; ++bj) { const f32x4 v0 = acc[ai][bj][m][0], v1 = acc[ai][bj][m][1];
                    u32x4 w; w.x = cvt_pk_bf16(v0[0], v0[1]); w.y = cvt_pk_bf16(v0[2], v0[3]); w.z = cvt_pk_bf16(v1[0], v1[1]); w.w = cvt_pk_bf16(v1[2], v1[3]);
                    *(u32x4*)(rowp + bj * HALF) = w; } }
    }
};
struct EpiResidF32 {
    static constexpr bool PERM = false, AFTER_DRAIN = false;
    const float* base; float* out; int ldc;
    __device__ __forceinline__ void operator()(const f32x4 (&acc)[2][2][4][2], const Unit& u, int wr, int wc, int fr, int fq) const {
        const int row0 = u.pm * BM + wr * 64 + fr, col0 = u.pn * BM + wc * 32 + 4 * fq;
#pragma unroll
        for (int ai = 0; ai < 2; ++ai)
#pragma unroll
            for (int m = 0; m < 4; ++m) { const size_t off = (size_t)(row0 + ai * HALF + m * 16) * ldc + col0;
#pragma unroll
                for (int bj = 0; bj < 2; ++bj)
#pragma unroll
                    for (int n = 0; n < 2; ++n) { const f32x4 b = *(const f32x4*)(base + off + bj * HALF + n * 16); *(f32x4*)(out + off + bj * HALF + n * 16) = acc[ai][bj][m][n] + b; } }
    }
};
struct EpiSwiGlu {
    static constexpr bool PERM = true, AFTER_DRAIN = false;
    bf16_t* O; int ldc;
    __device__ __forceinline__ float sw(float g, float u) const { return g * u * __builtin_amdgcn_rcpf(1.0f + __builtin_amdgcn_exp2f(-g * LOG2E)); }
    __device__ __forceinline__ void operator()(const f32x4 (&acc)[2][2][4][2], const Unit& u, int wr, int wc, int fr, int fq) const {
        const int row0 = u.pm * BM + wr * 64 + fr, col0 = u.pn * HALF + wc * 32 + 8 * fq;
#pragma unroll
        for (int ai = 0; ai < 2; ++ai)
#pragma unroll
            for (int m = 0; m < 4; ++m) { bf16_t* rowp = O + (size_t)(row0 + ai * HALF + m * 16) * ldc + col0;
                const f32x4 g0 = acc[ai][0][m][0], g1 = acc[ai][0][m][1], u0 = acc[ai][1][m][0], u1 = acc[ai][1][m][1];
                u32x4 w; w.x = cvt_pk_bf16(sw(g0[0], u0[0]), sw(g0[1], u0[1])); w.y = cvt_pk_bf16(sw(g0[2], u0[2]), sw(g0[3], u0[3]));
                w.z = cvt_pk_bf16(sw(g1[0], u1[0]), sw(g1[1], u1[1])); w.w = cvt_pk_bf16(sw(g1[2], u1[2]), sw(g1[3], u1[3]));
                *(u32x4*)rowp = w; }
    }
};
struct EpiScaleBf16 {
    static constexpr bool PERM = true, AFTER_DRAIN = false;
    bf16_t* O; int ldc; const float* rowscale;
    __device__ __forceinline__ void operator()(const f32x4 (&acc)[2][2][4][2], const Unit& u, int wr, int wc, int fr, int fq) const {
        const int row0 = u.pm * BM + wr * 64 + fr, col0 = u.pn * BM + wc * 32 + 8 * fq;
#pragma unroll
        for (int ai = 0; ai < 2; ++ai)
#pragma unroll
            for (int m = 0; m < 4; ++m) { const int row = row0 + ai * HALF + m * 16; const float s = rowscale[row]; bf16_t* rowp = O + (size_t)row * ldc + col0;
#pragma unroll
                for (int bj = 0; bj < 2; ++bj) { const f32x4 v0 = acc[ai][bj][m][0] * s, v1 = acc[ai][bj][m][1] * s;
                    u32x4 w; w.x = cvt_pk_bf16(v0[0], v0[1]); w.y = cvt_pk_bf16(v0[2], v0[3]); w.z = cvt_pk_bf16(v1[0], v1[1]); w.w = cvt_pk_bf16(v1[2], v1[3]);
                    *(u32x4*)(rowp + bj * HALF) = w; } }
    }
};

template <class Epi, class Sched, bool ALIGN_EPI = false, bool SP2 = false>
__device__ __forceinline__ void gemm_phase(PG8_LAS unsigned char* lds, const int K, const Sched& S, const Epi& E) {
    const int tid = threadIdx.x, wid = __builtin_amdgcn_readfirstlane(tid >> 6), lane = tid & 63, wr = wid >> 2, wc = wid & 3, fr = lane & 15, fq = lane >> 4;
    const int nt = K / BK;
    unsigned voffA[2], voffB[2];
#pragma unroll
    for (int i = 0; i < 2; ++i) { int R, C; stage_rc(tid * 16 + i * 8192, R, C); const int Rb = Epi::PERM ? ((R & ~31) + perm32(R & 31)) : R;
        voffA[i] = (unsigned)(R * K + C) * 2u; voffB[i] = (unsigned)(Rb * K + C) * 2u; }
    const size_t kstep = (size_t)(BK * 2);
    const size_t hstep = (size_t)HALF * K * 2;
    const unsigned ldsw = (unsigned)wid * 1024u;
    const int aoff = lds_byte(wr * 64 + fr, fq * 8), boff = lds_byte(wc * 32 + fr, fq * 8);
#define PG8_SA(b, h) (((b) * 2 + (h)) * HTB)
#define PG8_SB(b, h) ((4 + (b) * 2 + (h)) * HTB)
#define PG8_STAGE(bufoff, gbase, voff) do { _Pragma("unroll") for (int _i = 0; _i < 2; ++_i) \
        __builtin_amdgcn_global_load_lds((const unsigned*)((const char*)(gbase) + (voff)[_i]), (PG8_LAS unsigned*)(lds + (bufoff) + ldsw + _i * 8192), 16, 0, 0); } while (0)
#define PG8_LDA(dst, b, h) do { _Pragma("unroll") for (int m = 0; m < 4; ++m) _Pragma("unroll") for (int k = 0; k < 2; ++k) dst[m][k] = *(const PG8_LAS bf16x8*)(lds + PG8_SA(b, h) + aoff + m * 2048 + k * 1024); } while (0)
#define PG8_LDB(dst, b, h) do { _Pragma("unroll") for (int n = 0; n < 2; ++n) _Pragma("unroll") for (int k = 0; k < 2; ++k) dst[n][k] = *(const PG8_LAS bf16x8*)(lds + PG8_SB(b, h) + boff + n * 2048 + k * 1024); } while (0)
#define PG8_MMA(ai, bj, At, Bt) do { __builtin_amdgcn_s_setprio(1); _Pragma("unroll") for (int m = 0; m < 4; ++m) _Pragma("unroll") for (int n = 0; n < 2; ++n) _Pragma("unroll") for (int k = 0; k < 2; ++k) \
        acc[ai][bj][m][n] = __builtin_amdgcn_mfma_f32_16x16x32_bf16(Bt[n][k], At[m][k], acc[ai][bj][m][n], 0, 0, 0); __builtin_amdgcn_s_setprio(0); } while (0)
#define PG8_WAIT_V(n) asm volatile("s_waitcnt vmcnt(" #n ")" ::: "memory")
#define PG8_WAIT_L(n) asm volatile("s_waitcnt lgkmcnt(" #n ")" ::: "memory")
#define PG8_BAR __builtin_amdgcn_s_barrier()
#define PG8_SCHED __builtin_amdgcn_sched_barrier(0)
    Unit cur, nxt; int ui = 0;
    if (!S.next(0, cur)) return;
    f32x4 acc[2][2][4][2];
#pragma unroll
    for (int a = 0; a < 2; ++a)
#pragma unroll
        for (int b = 0; b < 2; ++b)
#pragma unroll
            for (int m = 0; m < 4; ++m)
#pragma unroll
                for (int n = 0; n < 2; ++n) acc[a][b][m][n] = (f32x4){0.f, 0.f, 0.f, 0.f};
    bf16x8 At[4][2], B0[2][2], B1[2][2];
    const char* cA = cur.A; const char* cB = cur.B;
    S.a_ready(cur);
    if constexpr (SP2) {
        PG8_STAGE(PG8_SB(0, 0), cB, voffB); PG8_STAGE(PG8_SB(0, 1), cB + hstep, voffB); PG8_STAGE(PG8_SA(0, 0), cA, voffA); PG8_STAGE(PG8_SA(0, 1), cA + hstep, voffA);
        if (wr == 1) PG8_BAR;
        PG8_WAIT_V(2); PG8_BAR;
        PG8_STAGE(PG8_SB(1, 0), cB + kstep, voffB); PG8_STAGE(PG8_SA(1, 0), cA + kstep, voffA); PG8_STAGE(PG8_SB(1, 1), cB + hstep + kstep, voffB);
        PG8_WAIT_V(6); PG8_BAR;
    } else {
        PG8_STAGE(PG8_SB(0, 0), cB, voffB); PG8_STAGE(PG8_SA(0, 0), cA, voffA); PG8_STAGE(PG8_SB(0, 1), cB + hstep, voffB); PG8_STAGE(PG8_SA(0, 1), cA + hstep, voffA);
        if (wr == 1) PG8_BAR;
        PG8_WAIT_V(4); PG8_BAR;
        PG8_STAGE(PG8_SB(1, 0), cB + kstep, voffB); PG8_STAGE(PG8_SA(1, 0), cA + kstep, voffA); PG8_STAGE(PG8_SB(1, 1), cB + hstep + kstep, voffB);
        PG8_WAIT_V(6); PG8_BAR;
    }
    for (;;) {
        const bool has_next = S.next(ui + 1, nxt);
        const char* nA = has_next ? nxt.A : cA; const char* nB = has_next ? nxt.B : cB;
        for (int t = 0; t < nt; t += 2) {
            const bool last = (t == nt - 2);
            const char* a1 = cA + (size_t)(t + 1) * kstep;
            const char* a2 = last ? nA : cA + (size_t)(t + 2) * kstep; const char* b2 = last ? nB : cB + (size_t)(t + 2) * kstep;
            const char* a3 = a2 + kstep; const char* b3 = b2 + kstep;
            if (last && has_next) S.a_ready(nxt);
            if constexpr (SP2) {
            PG8_LDB(B0, 0, 0); PG8_LDB(B1, 0, 1); PG8_SCHED; PG8_LDA(At, 0, 0); PG8_STAGE(PG8_SA(1, 1), a1 + hstep, voffA);
            PG8_WAIT_V(8); PG8_WAIT_L(0); PG8_BAR; PG8_MMA(0, 0, At, B0); PG8_MMA(0, 1, At, B1); PG8_BAR; PG8_SCHED;
            PG8_LDA(At, 0, 1); PG8_STAGE(PG8_SB(0, 0), b2, voffB); PG8_STAGE(PG8_SB(0, 1), b2 + hstep, voffB); PG8_STAGE(PG8_SA(0, 0), a2, voffA);
            PG8_WAIT_V(8); PG8_WAIT_L(0); PG8_BAR; PG8_MMA(1, 0, At, B0); PG8_MMA(1, 1, At, B1); PG8_BAR; PG8_SCHED;
            PG8_LDB(B0, 1, 0); PG8_LDB(B1, 1, 1); PG8_SCHED; PG8_LDA(At, 1, 0); PG8_STAGE(PG8_SA(0, 1), a2 + hstep, voffA);
            PG8_WAIT_V(8); PG8_WAIT_L(0); PG8_BAR; PG8_MMA(0, 0, At, B0); PG8_MMA(0, 1, At, B1); PG8_BAR; PG8_SCHED;
            PG8_LDA(At, 1, 1); PG8_STAGE(PG8_SB(1, 0), b3, voffB); PG8_STAGE(PG8_SB(1, 1), b3 + hstep, voffB); PG8_STAGE(PG8_SA(1, 0), a3, voffA);
            PG8_WAIT_V(8); PG8_WAIT_L(0); PG8_BAR; PG8_MMA(1, 0, At, B0); PG8_MMA(1, 1, At, B1); PG8_BAR; PG8_SCHED;
            } else {
            PG8_LDB(B0, 0, 0); PG8_SCHED; PG8_LDA(At, 0, 0); PG8_STAGE(PG8_SA(1, 1), a1 + hstep, voffA);
            PG8_WAIT_L(8); PG8_BAR; PG8_WAIT_L(0); PG8_MMA(0, 0, At, B0); PG8_BAR; PG8_SCHED;
            PG8_LDB(B1, 0, 1); PG8_STAGE(PG8_SB(0, 0), b2, voffB);
            PG8_BAR; PG8_WAIT_L(0); PG8_MMA(0, 1, At, B1); PG8_BAR;
            PG8_LDA(At, 0, 1); PG8_STAGE(PG8_SA(0, 0), a2, voffA);
            PG8_BAR; PG8_WAIT_L(0); PG8_MMA(1, 0, At, B0); PG8_BAR; PG8_SCHED;
            PG8_STAGE(PG8_SB(0, 1), b2 + hstep, voffB);
            PG8_WAIT_V(6); PG8_BAR; PG8_MMA(1, 1, At, B1); PG8_BAR;
            PG8_LDB(B0, 1, 0); PG8_SCHED; PG8_LDA(At, 1, 0); PG8_STAGE(PG8_SA(0, 1), a2 + hstep, voffA);
            PG8_WAIT_L(8); PG8_BAR; PG8_WAIT_L(0); PG8_MMA(0, 0, At, B0); PG8_BAR; PG8_SCHED;
            PG8_LDB(B1, 1, 1); PG8_STAGE(PG8_SB(1, 0), b3, voffB);
            PG8_BAR; PG8_WAIT_L(0); PG8_MMA(0, 1, At, B1); PG8_BAR;
            PG8_LDA(At, 1, 1); PG8_STAGE(PG8_SA(1, 0), a3, voffA);
            PG8_BAR; PG8_WAIT_L(0); PG8_MMA(1, 0, At, B0); PG8_BAR; PG8_SCHED;
            PG8_STAGE(PG8_SB(1, 1), b3 + hstep, voffB);
            PG8_WAIT_V(6); PG8_BAR; PG8_MMA(1, 1, At, B1); PG8_BAR;
            }
        }
        if constexpr (ALIGN_EPI) { if (wr == 0) PG8_BAR; }
        if constexpr (!Epi::AFTER_DRAIN) { E(acc, cur, wr, wc, fr, fq); S.done(cur); }
        if (!has_next) break;
#pragma unroll
        for (int a = 0; a < 2; ++a)
#pragma unroll
            for (int b = 0; b < 2; ++b)
#pragma unroll
                for (int m = 0; m < 4; ++m)
#pragma unroll
                    for (int n = 0; n < 2; ++n) acc[a][b][m][n] = (f32x4){0.f, 0.f, 0.f, 0.f};
        cur = nxt; cA = nA; cB = nB; ++ui;
        if constexpr (ALIGN_EPI) { if (wr == 1) PG8_BAR; }
    }
    PG8_WAIT_V(0);
    if constexpr (!ALIGN_EPI) { if (wr == 0) PG8_BAR; }
    PG8_BAR;
    if constexpr (Epi::AFTER_DRAIN) { E.fused(acc, cur, wr, wc, fr, fq, lds, wid, lane); S.done(cur); }
#undef PG8_SA
#undef PG8_SB
#undef PG8_STAGE
#undef PG8_LDA
#undef PG8_LDB
#undef PG8_MMA
#undef PG8_WAIT_V
#undef PG8_WAIT_L
#undef PG8_BAR
#undef PG8_SCHED
}
}

#define GAS __attribute__((address_space(1)))
#define LAS __attribute__((address_space(3)))
typedef unsigned short bf16;
typedef unsigned v4u __attribute__((ext_vector_type(4)));
typedef float f32x4 __attribute__((ext_vector_type(4)));
typedef short bf16x8 __attribute__((ext_vector_type(8)));
typedef GAS unsigned gu32;
typedef GAS unsigned long long gu64;
#define RLX_AGENT __ATOMIC_RELAXED, __HIP_MEMORY_SCOPE_AGENT
#define LDS_WAIT() asm volatile("s_waitcnt lgkmcnt(0)" ::: "memory")
#define VM_WAIT() asm volatile("s_waitcnt vmcnt(0)" ::: "memory")
__device__ __forceinline__ unsigned long long rt() { return __builtin_amdgcn_s_memrealtime(); }
__device__ __forceinline__ unsigned f2bf(float f) { unsigned u = __builtin_bit_cast(unsigned, f); return (u + 0x7fffu + ((u >> 16) & 1u)) >> 16; }
__device__ __forceinline__ unsigned pk2(float lo, float hi) { return f2bf(lo) | (f2bf(hi) << 16); }

#define XB_TMO      128
#define XB_XCNT(j)  (256  + 64 * (j))
#define XB_XSUB(j)  (1280 + 64 * (j))
#define XB_XGEN(j)  (2304 + 64 * (j))
#define XB_TOP      3328
#define XB_TOPGEN   3392
#define XCD_BAR_WORDS 3456
#define XB_SPIN_CAP (1u << 18)

__device__ __forceinline__ unsigned xb_ld(unsigned* p)              { return __hip_atomic_load(p, __ATOMIC_RELAXED, __HIP_MEMORY_SCOPE_AGENT); }
__device__ __forceinline__ unsigned xb_add(unsigned* p, unsigned v) { return __hip_atomic_fetch_add(p, v, __ATOMIC_RELAXED, __HIP_MEMORY_SCOPE_AGENT); }
__device__ __forceinline__ unsigned xb_xcc_id() { return (unsigned)__builtin_amdgcn_s_getreg((3 << 11) | 20) & 0xFu; }
#define XB_SPIN(cond, bar) do { unsigned _sp = 0; while (cond) { __builtin_amdgcn_s_sleep(1); \
    if ((++_sp & 255u) == 0u) { if (xb_ld(&(bar)[XB_TMO])) break; if (_sp > XB_SPIN_CAP) { atomicAdd(&(bar)[XB_TMO], 1u); break; } } } } while (0)

struct XcdBarrier {
    unsigned* bar; unsigned x;
    volatile LAS unsigned* st;
};

__device__ __forceinline__ XcdBarrier xcd_barrier_post(unsigned* bar, volatile LAS unsigned* st) {
    XcdBarrier b; b.bar = bar; b.x = xb_xcc_id(); b.st = st;
    if (threadIdx.x == 0) (void)xb_add(&bar[XB_XCNT(b.x)], 1u);
    return b;
}
__device__ __forceinline__ void xcd_barrier_complete(unsigned* bar, unsigned x, unsigned& nloc, unsigned& nx) {
    const unsigned G = gridDim.x * gridDim.y * gridDim.z;
    unsigned sum, cnt, mine, sp = 0u;
    for (;;) {
        sum = 0u; cnt = 0u; mine = 0u;
#pragma unroll
        for (unsigned j = 0; j < 16; ++j) { const unsigned c = xb_ld(&bar[XB_XCNT(j)]); sum += c; cnt += (c > 0u) ? 1u : 0u; mine = (j == x) ? c : mine; }
        if (sum == G) break;
        __builtin_amdgcn_s_sleep(1);
        if ((++sp & 255u) == 0u) { if (xb_ld(&bar[XB_TMO])) break; if (sp > XB_SPIN_CAP) { atomicAdd(&bar[XB_TMO], 1u); break; } }
    }
    nloc = mine > 0u ? mine : 1u; nx = cnt > 0u ? cnt : 1u;
}

__device__ __forceinline__ void xcd_barrier(const XcdBarrier& b) {
    asm volatile("s_waitcnt vmcnt(0)" ::: "memory");
    __syncthreads();
    if (threadIdx.x == 0) {
        unsigned* bar = b.bar;
        __builtin_amdgcn_s_waitcnt(0);
        unsigned nloc = b.st[0], nx = b.st[1];
        if (nloc == 0u) { xcd_barrier_complete(bar, b.x, nloc, nx); b.st[0] = nloc; b.st[1] = nx; }
        const unsigned old = xb_add(&bar[XB_XSUB(b.x)], 1u);
        const unsigned gen = old / nloc;
        if (old + 1u == (gen + 1u) * nloc) {
            __builtin_amdgcn_fence(__ATOMIC_RELEASE, "agent");
            asm volatile("s_waitcnt vmcnt(0)" ::: "memory");
            const unsigned og = xb_add(&bar[XB_TOP], 1u);
            const unsigned tg = og / nx;
            if (og + 1u == (tg + 1u) * nx) xb_add(&bar[XB_TOPGEN], 1u);
            else XB_SPIN(xb_ld(&bar[XB_TOPGEN]) == tg, bar);
            __builtin_amdgcn_fence(__ATOMIC_ACQUIRE, "agent");
            xb_add(&bar[XB_XGEN(b.x)], 1u);
            asm volatile("s_waitcnt vmcnt(0)" ::: "memory");
        } else {
            XB_SPIN(xb_ld(&bar[XB_XGEN(b.x)]) == gen, bar);
            __builtin_amdgcn_fence(__ATOMIC_ACQUIRE, "agent");
            asm volatile("s_waitcnt vmcnt(0)" ::: "memory");
        }
    }
    __syncthreads();
}


constexpr size_t MiB = 1u << 20;
constexpr size_t WS_CTL = 0, CTL_ZERO_BYTES = 1 * MiB;
constexpr size_t WS_WIN = 1 * MiB;
constexpr size_t WS_WOUT = 19 * MiB;
constexpr size_t WS_WQM = 27 * MiB;
constexpr size_t WS_WKV = 29 * MiB;
constexpr size_t WS_WOM = 33 * MiB;
constexpr size_t WS_WGU = 35 * MiB;
constexpr size_t WS_WD = 291 * MiB;
constexpr size_t WS_XN = 419 * MiB;
constexpr size_t WS_MEMN = 451 * MiB;
constexpr size_t WS_PROJ = 453 * MiB;
constexpr size_t WS_KVM = 525 * MiB;
constexpr size_t WS_OPART = 526 * MiB;
constexpr size_t WS_OB = 574 * MiB;
constexpr size_t WS_LPART = 590 * MiB;
constexpr size_t WS_MIXED = 591 * MiB;
constexpr size_t WS_X1 = 623 * MiB;
constexpr size_t WS_QM = 687 * MiB;
constexpr size_t WS_OM = 695 * MiB;
constexpr size_t WS_AFF = 703 * MiB;
constexpr size_t WS_IDX = 704 * MiB;
constexpr size_t WS_GATE = 704 * MiB + 65536;
constexpr size_t WS_INV = 704 * MiB + 131072;
constexpr size_t WS_XE = 705 * MiB;
constexpr size_t WS_ACT = 769 * MiB;
constexpr size_t WS_YS = 833 * MiB;
constexpr size_t WS_END = 897 * MiB;
constexpr int CW_BAR = 4096;

constexpr int RING_BYTES = 131072;
constexpr int LDSCTL_OFF = RING_BYTES, MISC_OFF = LDSCTL_OFF + 320;
constexpr int LDS_BYTES = 147456;
constexpr int NWAVES = 8, NTHREADS = 512;

typedef unsigned v2u __attribute__((ext_vector_type(2)));
typedef float f32x2 __attribute__((ext_vector_type(2)));
typedef __bf16 bf16x2_t __attribute__((ext_vector_type(2)));
__device__ __forceinline__ unsigned cvtpk(float lo, float hi) { f32x2 v = {lo, hi}; bf16x2_t b = __builtin_convertvector(v, bf16x2_t); return __builtin_bit_cast(unsigned, b); }
__device__ __forceinline__ float bflo(unsigned w) { return __uint_as_float(w << 16); }
__device__ __forceinline__ float bfhi(unsigned w) { return __uint_as_float(w & 0xffff0000u); }
__device__ __forceinline__ float bf2f(unsigned short h) { return __uint_as_float((unsigned)h << 16); }
__device__ __forceinline__ float wave_sum(float v) {
#pragma unroll
    for (int o = 1; o < 64; o <<= 1) v += __shfl_xor(v, o);
    return v;
}
__device__ __forceinline__ float wave_max(float v) {
#pragma unroll
    for (int o = 1; o < 64; o <<= 1) v = fmaxf(v, __shfl_xor(v, o));
    return v;
}
__device__ __forceinline__ float gain_absmax(const float* g, int lane) { return wave_max(fmaxf(fabsf(g[lane]), fabsf(g[lane + 64]))); }

struct CvtTile { const float* src; bf16* dst; int N, K, mode, k0, n0; };
constexpr int T_IN = 16 * 18, T_OUT = 16 * 8, T_QM = 16 * 2, T_KV = 16 * 4, T_OM = 4 * 8, T_EXP = 16 * 128;
constexpr int T_TOTAL = T_IN + T_OUT + T_QM + T_KV + T_OM + 3 * T_EXP;
template <class A_> __device__ __forceinline__ CvtTile cvt_decode(int it, const A_& args, unsigned char* ws) {
    CvtTile t; int r = it;
    if (r < T_IN) { t.src = args.in[4]; t.dst = (bf16*)(ws + WS_WIN); t.N = DIN; t.K = DM; t.mode = 0; t.k0 = (r / 18) * 128; t.n0 = (r % 18) * 256; return t; } r -= T_IN;
    if (r < T_OUT) { t.src = args.in[12]; t.dst = (bf16*)(ws + WS_WOUT); t.N = DM; t.K = DM; t.mode = 0; t.k0 = (r / 8) * 128; t.n0 = (r % 8) * 256; return t; } r -= T_OUT;
    if (r < T_QM) { t.src = args.in[15]; t.dst = (bf16*)(ws + WS_WQM); t.N = WMEM; t.K = DM; t.mode = 0; t.k0 = (r / 2) * 128; t.n0 = (r % 2) * 256; return t; } r -= T_QM;
    if (r < T_KV) { t.src = args.in[16]; t.dst = (bf16*)(ws + WS_WKV); t.N = 2 * WMEM; t.K = DM; t.mode = 0; t.k0 = (r / 4) * 128; t.n0 = (r % 4) * 256; return t; } r -= T_KV;
    if (r < T_OM) { t.src = args.in[19]; t.dst = (bf16*)(ws + WS_WOM); t.N = DM; t.K = WMEM; t.mode = 0; t.k0 = (r / 8) * 128; t.n0 = (r % 8) * 256; return t; } r -= T_OM;
    const int which = r / T_EXP; r -= which * T_EXP; const int e = r / 128, rr = r % 128;
    t.N = DM; t.K = DM; t.k0 = (rr / 8) * 128; t.n0 = (rr % 8) * 256;
    if (which == 0) { t.src = args.in[22] + (size_t)e * DM * DFF; t.dst = (bf16*)(ws + WS_WGU) + (size_t)e * 2 * DFF * DM; t.mode = 1; }
    else if (which == 1) { t.src = args.in[23] + (size_t)e * DM * DFF; t.dst = (bf16*)(ws + WS_WGU) + (size_t)e * 2 * DFF * DM; t.mode = 2; }
    else { t.src = args.in[24] + (size_t)e * DFF * DM; t.dst = (bf16*)(ws + WS_WD) + (size_t)e * DM * DFF; t.mode = 0; }
    return t;
}
#define CVT_ISSUE(v, t) do { const float* p_ = (t).src + (size_t)((t).k0 + 4 * (tid >> 6)) * (t).N + (t).n0 + 4 * (tid & 63); \
    _Pragma("unroll") for (int ps_ = 0; ps_ < 4; ++ps_) _Pragma("unroll") for (int r_ = 0; r_ < 4; ++r_) v[ps_ * 4 + r_] = *(const GAS f32x4*)(p_ + (size_t)(32 * ps_ + r_) * (t).N); } while (0)
__device__ __forceinline__ void cvt_to_lds(const f32x4 (&v)[16], LAS unsigned char* lds, int tid) {
    const int c = tid & 63, kg = tid >> 6, f = c & 15;
#pragma unroll
    for (int ps = 0; ps < 4; ++ps) { const int kch = 8 * ps + kg;
#pragma unroll
        for (int j = 0; j < 4; ++j) { v2u w; w.x = cvtpk(v[ps * 4 + 0][j], v[ps * 4 + 1][j]); w.y = cvtpk(v[ps * 4 + 2][j], v[ps * 4 + 3][j]);
            *(LAS v2u*)(lds + (4 * c + j) * 256 + ((kch ^ f) * 8)) = w; } }
}
__device__ __forceinline__ void cvt_store(const CvtTile& t, LAS unsigned char* lds, int tid) {
    const int q = tid & 15;
#pragma unroll
    for (int ps = 0; ps < 8; ++ps) { const int n = (tid >> 4) + 32 * ps, f = (n >> 2) & 15; v4u w = *(LAS v4u*)(lds + n * 256 + ((q ^ (f >> 1)) * 16));
        if (f & 1) { const unsigned a = w.x, b = w.y; w.x = w.z; w.y = w.w; w.z = a; w.w = b; }
        const int nn = t.n0 + n; const int drow = t.mode == 0 ? nn : ((nn >> 7) * 256 + (nn & 127) + (t.mode == 2 ? 128 : 0));
        *(GAS v4u*)(t.dst + (size_t)drow * t.K + t.k0 + 8 * q) = w; }
}
__device__ __forceinline__ void norm_row_bf16(const float* xrow, const float* g, bf16* orow, int lane) {
    f32x4 v[8]; float ss = 0.f;
#pragma unroll
    for (int j = 0; j < 8; ++j) { v[j] = *(const GAS f32x4*)(xrow + lane * 4 + 256 * j); ss += (v[j].x * v[j].x + v[j].y * v[j].y) + (v[j].z * v[j].z + v[j].w * v[j].w); }
    const float rstd = 1.0f / sqrtf(wave_sum(ss) * (1.0f / DM) + EPS);
#pragma unroll
    for (int j = 0; j < 8; ++j) { const f32x4 gg = *(const GAS f32x4*)(g + lane * 4 + 256 * j); v2u w; w.x = cvtpk(v[j].x * rstd * gg.x, v[j].y * rstd * gg.y); w.y = cvtpk(v[j].z * rstd * gg.z, v[j].w * rstd * gg.w);
        *(GAS v2u*)(orow + lane * 4 + 256 * j) = w; }
}

namespace att {
typedef short s16x4 __attribute__((ext_vector_type(4)));
typedef float f32x16 __attribute__((ext_vector_type(16)));
constexpr int VBUF = 32768, TILEB = 16384, STG_PITCH = 272, STG_W = 32 * STG_PITCH, WSF = 8 * STG_W;
__device__ __forceinline__ int crow(int r, int hi) { return (r & 3) + 8 * (r >> 2) + 4 * hi; }
__device__ __forceinline__ s16x4 vtr(const LAS unsigned char* p) { return __builtin_bit_cast(s16x4, __builtin_amdgcn_ds_read_tr16_b64_v4i16((LAS s16x4*)p)); }
template <bool MASK, bool QNORM, bool NORMALIZE>
__device__ __forceinline__ void attn_unit(LAS unsigned char* lds, const bf16* qw, long q_stride, const bf16* k0, const bf16* v0, long kv_stride,
                                          int tlo, int thi, int a, int half, float negM2, float l_extra, bf16* ow, long o_stride, float* lw, long l_stride) {
    int tid_ = threadIdx.x; asm volatile("" : "+v"(tid_));
    const int tid = tid_, lane = tid & 63, c = lane & 31, hi = lane >> 5, wid = __builtin_amdgcn_readfirstlane(tid >> 6);
    bf16x8 qf[8];
    { const bf16* qp = qw + (long)c * q_stride + 8 * hi;
#pragma unroll
      for (int ks = 0; ks < 8; ++ks) qf[ks] = *(const GAS bf16x8*)(qp + 16 * ks); }
    float qs = 1.f;
    if (QNORM) { float ss = 0.f;
#pragma unroll
        for (int ks = 0; ks < 8; ++ks)
#pragma unroll
            for (int j = 0; j < 8; ++j) { const float f = bf2f((unsigned short)qf[ks][j]); ss += f * f; }
        ss += __shfl_xor(ss, 32); qs = QSCALE / sqrtf(ss * (1.0f / HD) + EPS); }
    const int srow = tid >> 4, sch = tid & 15;
    const bf16* kg = k0 + (long)srow * kv_stride + (sch ^ (srow & 15)) * 8; const bf16* vg = v0 + (long)srow * kv_stride + (sch ^ (((srow & 3) << 2) | ((srow >> 2) & 3))) * 8;
    const unsigned ldsw = (unsigned)wid * 1024u;
    const unsigned kbase = c * 256; const int cx = c & 15;
    const int q4 = (lane & 15) >> 2, p = lane & 3, g = (lane >> 4) & 1;
    unsigned vb[4][2];
#pragma unroll
    for (int db = 0; db < 4; ++db)
#pragma unroll
        for (int u = 0; u < 2; ++u) vb[db][u] = VBUF + 256 * (4 * hi + 8 * u + q4) + 16 * ((((db ^ q4)) << 2) | ((g ^ u) << 1) | ((p >> 1) ^ hi)) + 8 * (p & 1);
    f32x16 o[4];
#pragma unroll
    for (int db = 0; db < 4; ++db)
#pragma unroll
        for (int r = 0; r < 16; ++r) o[db][r] = 0.f;
    float lsum = 0.f;
#define AT_ISSUE(t, bw) do { const long r_ = (long)(t) * 64; \
        __builtin_amdgcn_global_load_lds((const unsigned*)(kg + r_ * kv_stride), (LAS unsigned*)(lds + (bw) * TILEB + ldsw), 16, 0, 0); \
        __builtin_amdgcn_global_load_lds((const unsigned*)(kg + (r_ + 32) * kv_stride), (LAS unsigned*)(lds + (bw) * TILEB + 8192 + ldsw), 16, 0, 0); \
        __builtin_amdgcn_global_load_lds((const unsigned*)(vg + r_ * kv_stride), (LAS unsigned*)(lds + VBUF + (bw) * TILEB + ldsw), 16, 0, 0); \
        __builtin_amdgcn_global_load_lds((const unsigned*)(vg + (r_ + 32) * kv_stride), (LAS unsigned*)(lds + VBUF + (bw) * TILEB + 8192 + ldsw), 16, 0, 0); } while (0)
    AT_ISSUE(tlo, 0); VM_WAIT(); __syncthreads();
    for (int t = tlo; t < thi; ++t) {
        const int buf = (t - tlo) & 1; const bool more = (t + 1 < thi);
        if (more) AT_ISSUE(t + 1, buf ^ 1);
        const bool need = !MASK || ((64 * t + 63 >= a - half) && (64 * t <= a + 31 + half));
        if (need) {
            const LAS unsigned char* kt = lds + buf * TILEB + kbase; const LAS unsigned char* vt = lds + buf * TILEB;
            const float ini = QNORM ? 0.f : negM2;
            const int jb = 64 * t + 4 * hi - (a + c);
            v4u pw[4];
#pragma unroll
            for (int kb = 0; kb < 2; ++kb) {
                f32x16 pp;
#pragma unroll
                for (int r = 0; r < 16; ++r) pp[r] = ini;
#pragma unroll
                for (int ks = 0; ks < 8; ++ks) { const int off = 16 * ((2 * ks + hi) ^ cx) + 8192 * kb;
                    const bf16x8 ka = *(const LAS bf16x8*)(kt + off);
                    pp = __builtin_amdgcn_mfma_f32_32x32x16_bf16(ka, qf[ks], pp, 0, 0, 0); }
#pragma unroll
                for (int r = 0; r < 16; ++r) {
                    float e0 = QNORM ? __builtin_amdgcn_exp2f(__builtin_fmaf(pp[r], qs, negM2)) : __builtin_amdgcn_exp2f(pp[r]);
                    if (MASK) { const int d0 = jb + 32 * kb + (r & 3) + 8 * (r >> 2); if ((unsigned)(d0 + half) > (unsigned)(2 * half)) e0 = 0.f; }
                    pp[r] = e0; lsum += e0; }
                pw[2 * kb] = (v4u){cvtpk(pp[0], pp[1]), cvtpk(pp[2], pp[3]), cvtpk(pp[4], pp[5]), cvtpk(pp[6], pp[7])};
                pw[2 * kb + 1] = (v4u){cvtpk(pp[8], pp[9]), cvtpk(pp[10], pp[11]), cvtpk(pp[12], pp[13]), cvtpk(pp[14], pp[15])};
            }
#pragma unroll
            for (int db = 0; db < 4; ++db)
#pragma unroll
                for (int sp = 0; sp < 4; ++sp) { const int imm = 8192 * (sp >> 1) + 4096 * (sp & 1);
                    const s16x4 lo = vtr(vt + vb[db][0] + imm), hv = vtr(vt + vb[db][1] + imm);
                    const bf16x8 vf = (bf16x8){lo[0], lo[1], lo[2], lo[3], hv[0], hv[1], hv[2], hv[3]};
                    o[db] = __builtin_amdgcn_mfma_f32_32x32x16_bf16(__builtin_bit_cast(bf16x8, pw[sp]), vf, o[db], 0, 0, 0); }
        }
        VM_WAIT(); __syncthreads();
    }
#undef AT_ISSUE
    lsum += __shfl_xor(lsum, 32); lsum += l_extra;
    LAS float* wsf = (LAS float*)(lds + WSF + wid * 256);
    if (NORMALIZE) { if (hi == 0) wsf[c] = 1.0f / lsum; } else { if (hi == 0) lw[(long)c * l_stride] = lsum; }
    LDS_WAIT();
    LAS unsigned char* stg = lds + wid * STG_W;
#pragma unroll
    for (int r = 0; r < 16; ++r) { const int row = crow(r, hi); const float sc = NORMALIZE ? wsf[row] : 1.0f;
#pragma unroll
        for (int db = 0; db < 4; ++db) *(LAS unsigned short*)(stg + row * STG_PITCH + (32 * db + c) * 2) = (unsigned short)f2bf(o[db][r] * sc); }
    LDS_WAIT();
#pragma unroll
    for (int i = 0; i < 8; ++i) { const int row = 4 * i + (lane >> 4), ch = lane & 15; const v4u w = *(const LAS v4u*)(stg + row * STG_PITCH + ch * 16);
        *(GAS v4u*)(ow + (long)row * o_stride + ch * 8) = w; }
    LDS_WAIT();
    __syncthreads();
}
}

struct OrderP1 {
    int G, c; const char* XN; const char* WIN; const char* MEMN; const char* WKV;
    __device__ __forceinline__ bool next(int i, pg8::Unit& u) const {
        int pm, pn;
        if (pg8::static_order(i, G, c, 32, 18, pm, pn)) { u.pm = pm; u.pn = pn; u.kind = 0; u.A = XN + (size_t)pm * 256 * DM * 2; u.B = WIN + (size_t)pn * 256 * DM * 2; return true; }
        const long L = (long)i * G + c - 576; if (L < 0 || L >= 8) return false;
        u.pm = (int)L >> 2; u.pn = (int)L & 3; u.kind = 1; u.A = MEMN + (size_t)u.pm * 256 * DM * 2; u.B = WKV + (size_t)u.pn * 256 * DM * 2; return true;
    }
    __device__ __forceinline__ void a_ready(const pg8::Unit&) const {}
    __device__ __forceinline__ void done(const pg8::Unit&) const {}
};
struct OrderPlain {
    int G, c, nM, nN, K; const char* A; const char* B;
    __device__ __forceinline__ bool next(int i, pg8::Unit& u) const {
        int pm, pn; if (!pg8::static_order(i, G, c, nM, nN, pm, pn)) return false;
        u.pm = pm; u.pn = pn; u.kind = 0; u.A = A + (size_t)pm * 256 * K * 2; u.B = B + (size_t)pn * 256 * K * 2; return true;
    }
    __device__ __forceinline__ void a_ready(const pg8::Unit&) const {}
    __device__ __forceinline__ void done(const pg8::Unit&) const {}
};
struct OrderMoe {
    int G, c, nN, K; const char* A; const char* B;
    __device__ __forceinline__ bool next(int i, pg8::Unit& u) const {
        int pm, pn; if (!pg8::static_order(i, G, c, 64, nN, pm, pn)) return false;
        u.pm = pm; u.pn = pn; u.kind = 0; u.A = A + (size_t)pm * 256 * K * 2; u.B = B + ((size_t)(pm >> 2) * nN + pn) * 256 * K * 2; return true;
    }
    __device__ __forceinline__ void a_ready(const pg8::Unit&) const {}
    __device__ __forceinline__ void done(const pg8::Unit&) const {}
};

constexpr int NPHASE = 16;
struct Args { const float* in[25]; float* out; unsigned char* ws; int ph_lo, ph_hi; };
static_assert(sizeof(Args) == 25 * 8 + 8 + 8 + 8, "Args has no padding");

__global__ void __launch_bounds__(NTHREADS, 2) fwd_kernel(Args args) {
    extern __shared__ __attribute__((aligned(16))) unsigned char lds_raw[];
    LAS unsigned char* lds = (LAS unsigned char*)lds_raw;
    volatile LAS unsigned* MISC = (volatile LAS unsigned*)(lds + MISC_OFF);
    const int tid = threadIdx.x, lane = tid & 63, wave = __builtin_amdgcn_readfirstlane(tid >> 6);
    const int G = gridDim.x; const int bx = blockIdx.x; const int vcu = (G % 8 == 0) ? (bx % 8) * (G / 8) + bx / 8 : bx;
    unsigned char* ws = args.ws;
    gu32* ctl = (gu32*)(ws + WS_CTL);
    for (int u = tid; u < (LDS_BYTES - LDSCTL_OFF) / 4; u += NTHREADS) ((LAS unsigned*)(lds + LDSCTL_OFF))[u] = 0u;
    __syncthreads();
    XcdBarrier bar; bar.bar = (unsigned*)(ctl + CW_BAR); bar.x = 0; bar.st = nullptr;
    if (MK_ONE_LAUNCH) bar = xcd_barrier_post((unsigned*)(ctl + CW_BAR), MISC + 8);
    const int lo = args.ph_lo, hi = args.ph_hi;
#ifndef PH_MASK
#define PH_MASK 0xffff
#endif
#define IN(k) (((PH_MASK >> (k)) & 1) && lo <= (k) && (k) < hi)
#define SEAM(k) do { if (IN(k) && IN((k) + 1)) xcd_barrier(bar); } while (0)
    const int gw = vcu * NWAVES + wave, NGW = G * NWAVES;
#define PHASE_IDS int tid_p_ = threadIdx.x; asm volatile("" : "+v"(tid_p_)); const int tid = tid_p_, lane = tid_p_ & 63; (void)tid; (void)lane;

    bf16* const WIN = (bf16*)(ws + WS_WIN); bf16* const WOUT = (bf16*)(ws + WS_WOUT); bf16* const WQM = (bf16*)(ws + WS_WQM); bf16* const WKV = (bf16*)(ws + WS_WKV);
    bf16* const WOM = (bf16*)(ws + WS_WOM); bf16* const WGU = (bf16*)(ws + WS_WGU); bf16* const WD = (bf16*)(ws + WS_WD);
    bf16* const XN = (bf16*)(ws + WS_XN); bf16* const MEMN = (bf16*)(ws + WS_MEMN); bf16* const PROJ = (bf16*)(ws + WS_PROJ); bf16* const KVM = (bf16*)(ws + WS_KVM);
    bf16* const OPART = (bf16*)(ws + WS_OPART); bf16* const OB = (bf16*)(ws + WS_OB); float* const LPART = (float*)(ws + WS_LPART); bf16* const MIXED = (bf16*)(ws + WS_MIXED);
    float* const X1 = (float*)(ws + WS_X1); bf16* const QM = (bf16*)(ws + WS_QM); bf16* const OM = (bf16*)(ws + WS_OM); float* const AFF = (float*)(ws + WS_AFF);
    int* const IDX = (int*)(ws + WS_IDX); float* const GATE = (float*)(ws + WS_GATE); int* const INV = (int*)(ws + WS_INV);
    bf16* const XE = (bf16*)(ws + WS_XE); bf16* const ACT = (bf16*)(ws + WS_ACT); bf16* const YS = (bf16*)(ws + WS_YS);
    float* const OUT = args.out;

    if (IN(0)) { PHASE_IDS
        f32x4 v[16];
        int it = vcu; bool have = it < T_TOTAL; CvtTile cur = cvt_decode(have ? it : 0, args, ws);
        if (have) CVT_ISSUE(v, cur);
        while (have) {
            __syncthreads();
            cvt_to_lds(v, lds, tid);
            it += G; const bool hn = it < T_TOTAL; const CvtTile nxt = cvt_decode(hn ? it : 0, args, ws);
            if (hn) CVT_ISSUE(v, nxt);
            LDS_WAIT(); __syncthreads();
            cvt_store(cur, lds, tid);
            cur = nxt; have = hn;
        }
        for (int m = gw; m < TOK + BATCH * NMEM; m += NGW) {
            if (m < TOK) norm_row_bf16(args.in[0] + (size_t)m * DM, args.in[3], XN + (size_t)m * DM, lane);
            else norm_row_bf16(args.in[1] + (size_t)(m - TOK) * DM, args.in[14], MEMN + (size_t)(m - TOK) * DM, lane);
        }
    }
    SEAM(0);
    if (IN(1)) { PHASE_IDS
        OrderP1 S{G, bx, (const char*)XN, (const char*)WIN, (const char*)MEMN, (const char*)WKV};
        pg8::EpiBf16 E{PROJ, DIN, KVM, 2 * WMEM};
        pg8::gemm_phase<pg8::EpiBf16, OrderP1, true, true>(lds, DM, S, E);
    }
    SEAM(1);
    if (IN(2)) { PHASE_IDS
        const int* pos = (const int*)args.in[2];
        for (int m = gw; m < TOK + BATCH * NMEM; m += NGW) {
            if (m < TOK) {
                const float inv_freq = exp2f(-(float)lane * (13.287712379549449f / 64.0f));
                const float ang = (float)pos[m] * inv_freq;
                const double ad = (double)ang; const double nrev = rint(ad * 0.15915494309189535); const float rf = (float)(ad - nrev * 6.283185307179586);
                const float cs = cosf(rf), sn = sinf(rf);
                bf16* row = PROJ + (size_t)m * DIN;
#pragma unroll 1
                for (int s = 0; s < 26; ++s) {
                    int col; const float* g; float sc;
                    if (s < 8) { col = OFF_QA + 128 * s; g = args.in[5]; sc = QSCALE; } else if (s < 16) { col = OFF_KA + 128 * (s - 8); g = args.in[6]; sc = 1.f; }
                    else if (s < 24) { col = OFF_QB + 128 * (s - 16); g = args.in[7]; sc = QSCALE; } else { col = OFF_KB + 128 * (s - 24); g = args.in[8]; sc = 1.f; }
                    const float t1 = bf2f(row[col + lane]), t2 = bf2f(row[col + 64 + lane]);
                    const float rstd = 1.0f / sqrtf(wave_sum(t1 * t1 + t2 * t2) * (1.0f / HD) + EPS);
                    const float n1 = t1 * rstd * g[lane], n2 = t2 * rstd * g[lane + 64];
                    row[col + lane] = (bf16)f2bf((n1 * cs - n2 * sn) * sc); row[col + 64 + lane] = (bf16)f2bf((n2 * cs + n1 * sn) * sc);
                }
            } else {
                bf16* row = KVM + (size_t)(m - TOK) * (2 * WMEM);
#pragma unroll 1
                for (int s = 0; s < 4; ++s) { const int col = 128 * s;
                    const float t1 = bf2f(row[col + lane]), t2 = bf2f(row[col + 64 + lane]);
                    const float rstd = 1.0f / sqrtf(wave_sum(t1 * t1 + t2 * t2) * (1.0f / HD) + EPS);
                    row[col + lane] = (bf16)f2bf(t1 * rstd * args.in[18][lane] * args.in[17][lane]); row[col + 64 + lane] = (bf16)f2bf(t2 * rstd * args.in[18][lane + 64] * args.in[17][lane + 64]); }
            }
        }
    }
    SEAM(2);
    if (IN(3)) { PHASE_IDS
        const float negM2a = -(SQRT_HD * LOG2E) * gain_absmax(args.in[5], lane) * gain_absmax(args.in[6], lane);
        const float negM2b = -(SQRT_HD * LOG2E) * gain_absmax(args.in[7], lane) * gain_absmax(args.in[8], lane);
        for (int u = vcu; u < 1024; u += G) {
            if (u < 768) {
                const int gi = u >> 8, rem = u & 255, b = rem >> 7, h = (rem >> 4) & 7, x = rem & 15;
                const int dlog = 2 * gi, d = 1 << dlog, r = x & (d - 1), blk = x >> dlog;
                const int L = SEQ >> dlog, i0 = blk * 256, a = i0 + 32 * wave;
                const int tlo = (i0 >> 6) - 1 < 0 ? 0 : (i0 >> 6) - 1, thi = (i0 >> 6) + 5 > (L >> 6) ? (L >> 6) : (i0 >> 6) + 5;
                const size_t tok0 = (size_t)b * SEQ + r;
                att::attn_unit<true, false, false>(lds, PROJ + (tok0 + (size_t)d * a) * DIN + OFF_QA + h * HD, (long)d * DIN,
                    PROJ + tok0 * DIN + OFF_KA + h * HD, PROJ + tok0 * DIN + OFF_VA + h * HD, (long)d * DIN, tlo, thi, a, 64, negM2a, 0.f,
                    OPART + (size_t)gi * TOK * 1024 + (tok0 + (size_t)d * a) * 1024 + h * HD, (long)d * 1024, LPART + (size_t)gi * TOK * 8 + (tok0 + (size_t)d * a) * 8 + h, (long)d * 8);
            } else {
                const int ub = u - 768, b = ub >> 7, kvh = (ub >> 6) & 1, blk = ub & 63;
                const int i0 = blk * 64, a = i0 + 32 * (wave & 1), head = kvh * 4 + (wave >> 1);
                const int tlo = blk - 2 < 0 ? 0 : blk - 2, thi = blk + 3 > 64 ? 64 : blk + 3;
                const size_t tok0 = (size_t)b * SEQ;
                const float lx = __builtin_amdgcn_exp2f(args.in[9][head] * LOG2E + negM2b);
                att::attn_unit<true, false, true>(lds, PROJ + (tok0 + a) * DIN + OFF_QB + head * HD, (long)DIN,
                    PROJ + tok0 * DIN + OFF_KB + kvh * HD, PROJ + tok0 * DIN + OFF_VB + kvh * HD, (long)DIN, tlo, thi, a, 128, negM2b, lx,
                    OB + (tok0 + a) * 1024 + head * HD, 1024L, nullptr, 0L);
            }
        }
    }
    SEAM(3);
    if (IN(4)) { PHASE_IDS
        for (int m = gw; m < TOK; m += NGW) {
            const int hd = lane >> 3; float oa[16], ob[16];
            float l = 0.f;
#pragma unroll
            for (int k = 0; k < 16; ++k) oa[k] = 0.f;
#pragma unroll
            for (int gi = 0; gi < 3; ++gi) { l += LPART[(size_t)gi * TOK * 8 + (size_t)m * 8 + hd];
                const GAS v4u* p = (const GAS v4u*)(OPART + (size_t)gi * TOK * 1024 + (size_t)m * 1024 + lane * 16);
#pragma unroll
                for (int q = 0; q < 2; ++q) { const v4u w = p[q]; oa[8 * q + 0] += bflo(w.x); oa[8 * q + 1] += bfhi(w.x); oa[8 * q + 2] += bflo(w.y); oa[8 * q + 3] += bfhi(w.y);
                    oa[8 * q + 4] += bflo(w.z); oa[8 * q + 5] += bfhi(w.z); oa[8 * q + 6] += bflo(w.w); oa[8 * q + 7] += bfhi(w.w); } }
            const float il = 1.0f / l; float ssa = 0.f, ssb = 0.f;
#pragma unroll
            for (int k = 0; k < 16; ++k) { oa[k] *= il; ssa += oa[k] * oa[k]; }
            { const GAS v4u* p = (const GAS v4u*)(OB + (size_t)m * 1024 + lane * 16);
#pragma unroll
              for (int q = 0; q < 2; ++q) { const v4u w = p[q]; ob[8 * q + 0] = bflo(w.x); ob[8 * q + 1] = bfhi(w.x); ob[8 * q + 2] = bflo(w.y); ob[8 * q + 3] = bfhi(w.y);
                  ob[8 * q + 4] = bflo(w.z); ob[8 * q + 5] = bfhi(w.z); ob[8 * q + 6] = bflo(w.w); ob[8 * q + 7] = bfhi(w.w); } }
#pragma unroll
            for (int k = 0; k < 16; ++k) ssb += ob[k] * ob[k];
            const float ra = 1.0f / sqrtf(wave_sum(ssa) * (1.0f / 1024.0f) + EPS), rb = 1.0f / sqrtf(wave_sum(ssb) * (1.0f / 1024.0f) + EPS);
            const float* ga = args.in[10] + lane * 16; const float* gb = args.in[11] + lane * 16;
            v4u wa[2], wb[2];
#pragma unroll
            for (int q = 0; q < 2; ++q) {
                wa[q] = (v4u){cvtpk(oa[8 * q] * ra * ga[8 * q], oa[8 * q + 1] * ra * ga[8 * q + 1]), cvtpk(oa[8 * q + 2] * ra * ga[8 * q + 2], oa[8 * q + 3] * ra * ga[8 * q + 3]),
                              cvtpk(oa[8 * q + 4] * ra * ga[8 * q + 4], oa[8 * q + 5] * ra * ga[8 * q + 5]), cvtpk(oa[8 * q + 6] * ra * ga[8 * q + 6], oa[8 * q + 7] * ra * ga[8 * q + 7])};
                wb[q] = (v4u){cvtpk(ob[8 * q] * rb * gb[8 * q], ob[8 * q + 1] * rb * gb[8 * q + 1]), cvtpk(ob[8 * q + 2] * rb * gb[8 * q + 2], ob[8 * q + 3] * rb * gb[8 * q + 3]),
                              cvtpk(ob[8 * q + 4] * rb * gb[8 * q + 4], ob[8 * q + 5] * rb * gb[8 * q + 5]), cvtpk(ob[8 * q + 6] * rb * gb[8 * q + 6], ob[8 * q + 7] * rb * gb[8 * q + 7])}; }
            GAS v4u* pa = (GAS v4u*)(MIXED + (size_t)m * DM + lane * 16); GAS v4u* pb = (GAS v4u*)(MIXED + (size_t)m * DM + 1024 + lane * 16);
            pa[0] = wa[0]; pa[1] = wa[1]; pb[0] = wb[0]; pb[1] = wb[1];
        }
    }
    SEAM(4);
    if (IN(5)) { PHASE_IDS
        OrderPlain S{G, bx, 32, 8, DM, (const char*)MIXED, (const char*)WOUT};
        pg8::EpiResidF32 E{args.in[0], X1, DM};
        pg8::gemm_phase<pg8::EpiResidF32, OrderPlain, true, true>(lds, DM, S, E);
    }
    SEAM(5);
    if (IN(6)) { PHASE_IDS for (int m = gw; m < TOK; m += NGW) norm_row_bf16(X1 + (size_t)m * DM, args.in[13], XN + (size_t)m * DM, lane); }
    SEAM(6);
    if (IN(7)) { PHASE_IDS
        OrderPlain S{G, bx, 32, 2, DM, (const char*)XN, (const char*)WQM};
        pg8::EpiBf16 E{QM, WMEM, QM, WMEM};
        pg8::gemm_phase<pg8::EpiBf16, OrderPlain, true, true>(lds, DM, S, E);
    }
    SEAM(7);
    if (IN(8)) { PHASE_IDS
        const float gg = wave_max(fmaxf(fabsf(args.in[17][lane] * args.in[18][lane]), fabsf(args.in[17][lane + 64] * args.in[18][lane + 64])));
        const float negM2c = -(SQRT_HD * LOG2E) * gg;
        for (int u = vcu; u < 128; u += G) {
            const int b = u >> 6, h = (u >> 4) & 3, blk = u & 15, a = blk * 256 + 32 * wave;
            const size_t tok0 = (size_t)b * SEQ;
            att::attn_unit<false, true, true>(lds, QM + (tok0 + a) * WMEM + h * HD, (long)WMEM, KVM + (size_t)b * NMEM * 2 * WMEM + h * HD, KVM + (size_t)b * NMEM * 2 * WMEM + WMEM + h * HD, 2L * WMEM,
                0, 4, a, 1 << 20, negM2c, 0.f, OM + (tok0 + a) * WMEM + h * HD, (long)WMEM, nullptr, 0L);
        }
    }
    SEAM(8);
    if (IN(9)) { PHASE_IDS
        OrderPlain S{G, bx, 32, 8, WMEM, (const char*)OM, (const char*)WOM};
        pg8::EpiResidF32 E{X1, OUT, DM};
        pg8::gemm_phase<pg8::EpiResidF32, OrderPlain, true, true>(lds, WMEM, S, E);
    }
    SEAM(9);
    if (IN(10)) { PHASE_IDS
        LAS float* wrT = (LAS float*)lds;
        for (int i = tid; i < DM * NEXP / 4; i += NTHREADS) { const f32x4 w = *(const GAS f32x4*)(args.in[21] + 4 * i); const int k = i >> 2, e0 = (i & 3) * 4;
            wrT[(e0 + 0) * DM + k] = w.x; wrT[(e0 + 1) * DM + k] = w.y; wrT[(e0 + 2) * DM + k] = w.z; wrT[(e0 + 3) * DM + k] = w.w; }
        LDS_WAIT(); __syncthreads();
        for (int m = gw; m < TOK; m += NGW) {
            const float* xrow = OUT + (size_t)m * DM; f32x4 v[8]; float ss = 0.f;
#pragma unroll
            for (int j = 0; j < 8; ++j) { v[j] = *(const GAS f32x4*)(xrow + lane * 4 + 256 * j); ss += (v[j].x * v[j].x + v[j].y * v[j].y) + (v[j].z * v[j].z + v[j].w * v[j].w); }
            const float rstd = 1.0f / sqrtf(wave_sum(ss) * (1.0f / DM) + EPS);
#pragma unroll
            for (int j = 0; j < 8; ++j) { const f32x4 gg = *(const GAS f32x4*)(args.in[20] + lane * 4 + 256 * j); v[j].x *= rstd * gg.x; v[j].y *= rstd * gg.y; v[j].z *= rstd * gg.z; v[j].w *= rstd * gg.w;
                v2u w; w.x = cvtpk(v[j].x, v[j].y); w.y = cvtpk(v[j].z, v[j].w); *(GAS v2u*)(XN + (size_t)m * DM + lane * 4 + 256 * j) = w; }
            float lg[16];
#pragma unroll
            for (int e = 0; e < 16; ++e) { float s = 0.f;
#pragma unroll
                for (int j = 0; j < 8; ++j) { const f32x4 w = *(const LAS f32x4*)(wrT + e * DM + lane * 4 + 256 * j); s += (v[j].x * w.x + v[j].y * w.y) + (v[j].z * w.z + v[j].w * w.w); }
                lg[e] = wave_sum(s); asm volatile("" ::: "memory"); }
            float mx = lg[0];
#pragma unroll
            for (int e = 1; e < 16; ++e) mx = fmaxf(mx, lg[e]);
            float den = 0.f, mine = 0.f;
#pragma unroll
            for (int e = 0; e < 16; ++e) { const float ex = expf(lg[e] - mx); den += ex; if (lane == e) mine = ex; }
            if (lane < 16) AFF[((size_t)(m >> 12) * NEXP + lane) * SEQ + (m & (SEQ - 1))] = mine / den;
        }
    }
    SEAM(10);
    if (IN(11)) { PHASE_IDS
        LAS unsigned* hist = (LAS unsigned*)lds; LAS unsigned* misc = hist + 256; LAS unsigned* wtot = hist + 272;
        for (int u = vcu; u < BATCH * NEXP; u += G) {
            const int b = u >> 4, e = u & 15; const float* aff = AFF + (size_t)u * SEQ;
            const f32x4 a0 = *(const GAS f32x4*)(aff + tid * 8), a1 = *(const GAS f32x4*)(aff + tid * 8 + 4);
            unsigned bits[8] = {__float_as_uint(a0.x), __float_as_uint(a0.y), __float_as_uint(a0.z), __float_as_uint(a0.w), __float_as_uint(a1.x), __float_as_uint(a1.y), __float_as_uint(a1.z), __float_as_uint(a1.w)};
            unsigned prefix = 0u, krem = CAP;
#pragma unroll 1
            for (int pass = 0; pass < 4; ++pass) { const int shift = 24 - 8 * pass;
                __syncthreads();
                if (tid < 256) hist[tid] = 0u;
                __syncthreads();
#pragma unroll
                for (int i = 0; i < 8; ++i) if (pass == 0 || (bits[i] >> (shift + 8)) == prefix) __hip_atomic_fetch_add(&hist[(bits[i] >> shift) & 255u], 1u, __ATOMIC_RELAXED, __HIP_MEMORY_SCOPE_WORKGROUP);
                __syncthreads();
                if (wave == 0) {
                    const unsigned h0 = hist[255 - 4 * lane], h1 = hist[254 - 4 * lane], h2 = hist[253 - 4 * lane], h3 = hist[252 - 4 * lane];
                    const unsigned s = h0 + h1 + h2 + h3; unsigned incl = s;
#pragma unroll
                    for (int o = 1; o < 64; o <<= 1) { const unsigned t = __shfl_up(incl, o); if (lane >= o) incl += t; }
                    const unsigned excl = incl - s;
                    if (excl < krem && krem <= incl) { unsigned rem = krem - excl; unsigned bin;
                        if (rem <= h0) bin = 255 - 4 * lane; else { rem -= h0; if (rem <= h1) bin = 254 - 4 * lane; else { rem -= h1; if (rem <= h2) bin = 253 - 4 * lane; else { rem -= h2; bin = 252 - 4 * lane; } } }
                        misc[0] = (prefix << 8) | bin; misc[1] = rem; }
                }
                __syncthreads();
                prefix = misc[0]; krem = misc[1];
            }
            unsigned ngt = 0u, neq = 0u;
#pragma unroll
            for (int i = 0; i < 8; ++i) { ngt += bits[i] > prefix; neq += bits[i] == prefix; }
            unsigned cnt = ngt | (neq << 16), incl = cnt;
#pragma unroll
            for (int o = 1; o < 64; o <<= 1) { const unsigned t = __shfl_up(incl, o); if (lane >= o) incl += t; }
            if (lane == 63) wtot[wave] = incl;
            __syncthreads();
            unsigned base = 0u;
#pragma unroll
            for (int w = 0; w < 8; ++w) if (w < wave) base += wtot[w];
            const unsigned excl = base + incl - cnt; unsigned gtb = excl & 0xffffu, eqb = excl >> 16;
            const int rowbase = (e * BATCH + b) * CAP;
            const float vals[8] = {a0.x, a0.y, a0.z, a0.w, a1.x, a1.y, a1.z, a1.w};
#pragma unroll
            for (int i = 0; i < 8; ++i) { const bool gt = bits[i] > prefix, eq = bits[i] == prefix; const bool sel = gt || (eq && eqb < krem);
                const int slot = (int)(gtb + (eqb < krem ? eqb : krem)); const int s = tid * 8 + i;
                if (sel) { IDX[rowbase + slot] = s; GATE[rowbase + slot] = vals[i]; }
                INV[((size_t)b * SEQ + s) * NEXP + e] = sel ? rowbase + slot : -1;
                gtb += gt; eqb += eq; }
            __syncthreads();
        }
    }
    SEAM(11);
    if (IN(12)) { PHASE_IDS
        for (int r = gw; r < NEXP * BATCH * CAP; r += NGW) { const int b = (r >> 9) & 1; const size_t tok = (size_t)b * SEQ + IDX[r];
            const GAS v4u* s = (const GAS v4u*)(XN + tok * DM); GAS v4u* d = (GAS v4u*)(XE + (size_t)r * DM);
#pragma unroll
            for (int j = 0; j < 4; ++j) d[lane + 64 * j] = s[lane + 64 * j]; }
    }
    SEAM(12);
    if (IN(13)) { PHASE_IDS
        OrderMoe S{G, bx, 16, DM, (const char*)XE, (const char*)WGU};
        pg8::EpiSwiGlu E{ACT, DFF};
        pg8::gemm_phase<pg8::EpiSwiGlu, OrderMoe, true, true>(lds, DM, S, E);
    }
    SEAM(13);
    if (IN(14)) { PHASE_IDS
        OrderMoe S{G, bx, 8, DFF, (const char*)ACT, (const char*)WD};
        pg8::EpiScaleBf16 E{YS, DM, GATE};
        pg8::gemm_phase<pg8::EpiScaleBf16, OrderMoe, true, true>(lds, DFF, S, E);
    }
    SEAM(14);
    if (IN(15)) { PHASE_IDS
        for (int m = gw; m < TOK; m += NGW) {
            float* orow = OUT + (size_t)m * DM + lane * 32; f32x4 acc[8];
#pragma unroll
            for (int j = 0; j < 8; ++j) acc[j] = *(const GAS f32x4*)(orow + 4 * j);
#pragma unroll 1
            for (int e = 0; e < NEXP; ++e) { const int r = INV[(size_t)m * NEXP + e];
                if (r >= 0) { const GAS v4u* p = (const GAS v4u*)(YS + (size_t)r * DM + lane * 32);
#pragma unroll
                    for (int q = 0; q < 4; ++q) { const v4u w = p[q]; acc[2 * q].x += bflo(w.x); acc[2 * q].y += bfhi(w.x); acc[2 * q].z += bflo(w.y); acc[2 * q].w += bfhi(w.y);
                        acc[2 * q + 1].x += bflo(w.z); acc[2 * q + 1].y += bfhi(w.z); acc[2 * q + 1].z += bflo(w.w); acc[2 * q + 1].w += bfhi(w.w); } } }
#pragma unroll
            for (int j = 0; j < 8; ++j) *(GAS f32x4*)(orow + 4 * j) = acc[j];
        }
    }
#undef IN
#undef SEAM
}

extern "C" void kernel_launch(void* const* d_in, const int* in_sizes, int n_in, void* d_out, int out_size, void* d_ws, size_t ws_size, hipStream_t stream) {
    static int grid = 0;
    if (grid == 0) {
        if (n_in != 25 || out_size != TOK * DM || ws_size < WS_END) { fprintf(stderr, "kernel_launch: unexpected problem (n_in %d out %d ws %zu)\n", n_in, out_size, ws_size); grid = -1; return; }
        int dev = 0, cus = 0;
        if (hipGetDevice(&dev) != hipSuccess || hipDeviceGetAttribute(&cus, hipDeviceAttributeMultiprocessorCount, dev) != hipSuccess) { grid = -1; return; }
        if (hipFuncSetAttribute((const void*)fwd_kernel, hipFuncAttributeMaxDynamicSharedMemorySize, LDS_BYTES) != hipSuccess) { fprintf(stderr, "kernel_launch: hipFuncSetAttribute failed\n"); grid = -1; return; }
        int per_cu = 0; (void)hipOccupancyMaxActiveBlocksPerMultiprocessor(&per_cu, (const void*)fwd_kernel, NTHREADS, LDS_BYTES); (void)hipGetLastError();
        grid = cus;
    }
    if (grid < 0) return;
    (void)hipMemsetAsync((char*)d_ws + WS_CTL, 0, CTL_ZERO_BYTES, stream);
    Args a{};
    for (int i = 0; i < 25; ++i) a.in[i] = (const float*)d_in[i];
    a.out = (float*)d_out; a.ws = (unsigned char*)d_ws;
#if MK_ONE_LAUNCH
    a.ph_lo = 0; a.ph_hi = NPHASE;
    hipLaunchKernelGGL(fwd_kernel, dim3(grid), dim3(NTHREADS), LDS_BYTES, stream, a);
#else
    for (int p = 0; p < NPHASE; ++p) { a.ph_lo = p; a.ph_hi = p + 1; hipLaunchKernelGGL(fwd_kernel, dim3(grid), dim3(NTHREADS), LDS_BYTES, stream, a); }
#endif
}
```

```cpp
#include <hip/hip_runtime.h>
#include <hip/hip_bf16.h>
#include <cstdio>
#include <cstdint>

#ifndef MK_ONE_LAUNCH
#define MK_ONE_LAUNCH 1
#endif

constexpr int BATCH = 2, SEQ = 4096, DM = 2048, TOK = BATCH * SEQ, HD = 128;
constexpr int DIN = 4608, NMEM = 256, WMEM = 512, NEXP = 16, CAP = 512, DFF = 2048;
constexpr int OFF_QA = 0, OFF_KA = 1024, OFF_VA = 2048, OFF_QB = 3072, OFF_KB = 4096, OFF_VB = 4352;
constexpr float EPS = 1e-6f;
constexpr float LOG2E = 1.4426950408889634f;
constexpr float QSCALE = 0.08838834764831845f * LOG2E;
constexpr float SQRT_HD = 11.313708498984761f;

namespace pg8 {
#define PG8_LAS __attribute__((address_space(3)))
typedef unsigned short bf16_t;
typedef short bf16x8 __attribute__((ext_vector_type(8)));
typedef float f32x4 __attribute__((ext_vector_type(4)));
typedef unsigned u32x4 __attribute__((ext_vector_type(4)));
constexpr int BM = 256, BK = 64, HALF = 128, HTB = HALF * BK * 2  , STAGE_BYTES = 8 * HTB, NXCD = 8, WGM = 8;

__host__ __device__ __forceinline__ int lds_byte(int r, int c) { const int st = (r >> 4) * 2 + (c >> 5), rr = r & 15, cc = c & 31, ob = rr * 64 + cc * 2; return st * 1024 + (ob ^ (((ob >> 9) & 1) << 5)); }
__host__ __device__ __forceinline__ void stage_rc(int b, int& R, int& C) { const int st = b / 1024, sb = b % 1024, swz = sb ^ (((sb >> 9) & 1) << 5); R = (st >> 1) * 16 + swz / 64; C = (st & 1) * 32 + (swz % 64) / 2; }
__host__ __device__ __forceinline__ int perm32(int rho) { const int n = rho >> 4, i = rho & 15; return 8 * (i >> 2) + 4 * n + (i & 3); }

struct Unit { int pm, pn, kind; const char* A; const char* B; const int* rows; };

__device__ __forceinline__ bool static_order(int i, int G, int c, int nM, int nN, int& pm, int& pn) {
    const int nwg = nM * nN; const long L = (long)i * G + c; if (L >= nwg) return false;
    int wgid = (int)L; { const int q = nwg / NXCD, r = nwg % NXCD, xcd = wgid % NXCD, off = wgid / NXCD; wgid = (xcd < r ? xcd * (q + 1) : r * (q + 1) + (xcd - r) * q) + off; }
    const int nig = WGM * nN, gid = wgid / nig, fm = gid * WGM, gsz = (nM - fm) < WGM ? (nM - fm) : WGM;
    pm = fm + ((wgid % nig) % gsz); pn = (wgid % nig) / gsz; return true;
}

__device__ __forceinline__ unsigned cvt_pk_bf16(float lo, float hi) { unsigned r; asm volatile("v_cvt_pk_bf16_f32 %0, %1, %2" : "=v"(r) : "v"(lo), "v"(hi)); return r; }

#define PG8_ZERO_INIT __device__ __forceinline__ void init(f32x4 (&acc)[2][2][4][2], const Unit&, int, int, int, int) const { \
        _Pragma("unroll") for (int a = 0; a < 2; ++a) _Pragma("unroll") for (int b = 0; b < 2; ++b) _Pragma("unroll") for (int m = 0; m < 4; ++m) _Pragma("unroll") for (int n = 0; n < 2; ++n) acc[a][b][m][n] = (f32x4){0.f, 0.f, 0.f, 0.f}; }
struct EpiBf16 {
    static constexpr bool PERM = true, AFTER_DRAIN = false;
    bf16_t* O0; int ldc0; bf16_t* O1; int ldc1;
    PG8_ZERO_INIT
    __device__ __forceinline__ void operator()(const f32x4 (&acc)[2][2][4][2], const Unit& u, int wr, int wc, int fr, int fq) const {
        bf16_t* base = u.kind ? O1 : O0; const int ldc = u.kind ? ldc1 : ldc0;
        const int row0 = u.pm * BM + wr * 64 + fr, col0 = u.pn * BM + wc * 32 + 8 * fq;
#pragma unroll
        for (int ai = 0; ai < 2; ++ai)
#pragma unroll
            for (int m = 0; m < 4; ++m) { bf16_t* rowp = base + (size_t)(row0 + ai * HALF + m * 16) * ldc + col0;
#pragma unroll
                for (int bj = 0; bj < 2; ++bj) { const f32x4 v0 = acc[ai][bj][m][0], v1 = acc[ai][bj][m][1];
                    u32x4 w; w.x = cvt_pk_bf16(v0[0], v0[1]); w.y = cvt_pk_bf16(v0[2], v0[3]); w.z = cvt_pk_bf16(v1[0], v1[1]); w.w = cvt_pk_bf16(v1[2], v1[3]);
                    *(u32x4*)(rowp + bj * HALF) = w; } }
    }
};
struct EpiResidX {
    static constexpr bool PERM = false, AFTER_DRAIN = false;
    const float* base; float* out; bf16_t* xb; float* ss; int ldc;
    __device__ __forceinline__ void init(f32x4 (&acc)[2][2][4][2], const Unit& u, int wr, int wc, int fr, int fq) const {
        const int row0 = u.pm * BM + wr * 64 + fr, col0 = u.pn * BM + wc * 32 + 4 * fq;
#pragma unroll
        for (int ai = 0; ai < 2; ++ai)
#pragma unroll
            for (int m = 0; m < 4; ++m) { const size_t off = (size_t)(row0 + ai * HALF + m * 16) * ldc + col0;
#pragma unroll
                for (int bj = 0; bj < 2; ++bj)
#pragma unroll
                    for (int n = 0; n < 2; ++n) acc[ai][bj][m][n] = *(const f32x4*)(base + off + bj * HALF + n * 16); }
    }
    __device__ __forceinline__ void operator()(const f32x4 (&acc)[2][2][4][2], const Unit& u, int wr, int wc, int fr, int fq) const {
        const int row0 = u.pm * BM + wr * 64 + fr, col0 = u.pn * BM + wc * 32 + 4 * fq;
#pragma unroll
        for (int ai = 0; ai < 2; ++ai)
#pragma unroll
            for (int m = 0; m < 4; ++m) { const int row = row0 + ai * HALF + m * 16; const size_t off = (size_t)row * ldc + col0; float sq = 0.f;
#pragma unroll
                for (int bj = 0; bj < 2; ++bj)
#pragma unroll
                    for (int n = 0; n < 2; ++n) { const f32x4 v = acc[ai][bj][m][n]; *(f32x4*)(out + off + bj * HALF + n * 16) = v;
                        sq += (v[0] * v[0] + v[1] * v[1]) + (v[2] * v[2] + v[3] * v[3]);
                        typedef unsigned u32x2 __attribute__((ext_vector_type(2))); u32x2 w; w.x = cvt_pk_bf16(v[0], v[1]); w.y = cvt_pk_bf16(v[2], v[3]); *(u32x2*)(xb + off + bj * HALF + n * 16) = w; }
                sq += __shfl_xor(sq, 16); sq += __shfl_xor(sq, 32);
                if (fq == 0) atomicAdd(ss + row, sq); }
    }
};
struct EpiSwiGlu {
    static constexpr bool PERM = true, AFTER_DRAIN = false;
    bf16_t* O; int ldc; const float* rs;
    PG8_ZERO_INIT
    __device__ __forceinline__ float sw(float g, float u) const { return g * u * __builtin_amdgcn_rcpf(1.0f + __builtin_amdgcn_exp2f(-g * LOG2E)); }
    __device__ __forceinline__ void operator()(const f32x4 (&acc)[2][2][4][2], const Unit& u, int wr, int wc, int fr, int fq) const {
        const int row0 = u.pm * BM + wr * 64 + fr, col0 = u.pn * HALF + wc * 32 + 8 * fq;
#pragma unroll
        for (int ai = 0; ai < 2; ++ai)
#pragma unroll
            for (int m = 0; m < 4; ++m) { const int row = row0 + ai * HALF + m * 16; const float r = rs[row]; bf16_t* rowp = O + (size_t)row * ldc + col0;
                const f32x4 g0 = acc[ai][0][m][0] * r, g1 = acc[ai][0][m][1] * r, u0 = acc[ai][1][m][0] * r, u1 = acc[ai][1][m][1] * r;
                u32x4 w; w.x = cvt_pk_bf16(sw(g0[0], u0[0]), sw(g0[1], u0[1])); w.y = cvt_pk_bf16(sw(g0[2], u0[2]), sw(g0[3], u0[3]));
                w.z = cvt_pk_bf16(sw(g1[0], u1[0]), sw(g1[1], u1[1])); w.w = cvt_pk_bf16(sw(g1[2], u1[2]), sw(g1[3], u1[3]));
                *(u32x4*)rowp = w; }
    }
};
struct EpiScaleBf16 {
    static constexpr bool PERM = true, AFTER_DRAIN = false;
    bf16_t* O; int ldc; const float* rowscale;
    PG8_ZERO_INIT
    __device__ __forceinline__ void operator()(const f32x4 (&acc)[2][2][4][2], const Unit& u, int wr, int wc, int fr, int fq) const {
        const int row0 = u.pm * BM + wr * 64 + fr, col0 = u.pn * BM + wc * 32 + 8 * fq;
#pragma unroll
        for (int ai = 0; ai < 2; ++ai)
#pragma unroll
            for (int m = 0; m < 4; ++m) { const int row = row0 + ai * HALF + m * 16; const float s = rowscale[row]; bf16_t* rowp = O + (size_t)row * ldc + col0;
#pragma unroll
                for (int bj = 0; bj < 2; ++bj) { const f32x4 v0 = acc[ai][bj][m][0] * s, v1 = acc[ai][bj][m][1] * s;
                    u32x4 w; w.x = cvt_pk_bf16(v0[0], v0[1]); w.y = cvt_pk_bf16(v0[2], v0[3]); w.z = cvt_pk_bf16(v1[0], v1[1]); w.w = cvt_pk_bf16(v1[2], v1[3]);
                    *(u32x4*)(rowp + bj * HALF) = w; } }
    }
};

template <class Epi, class Sched, bool ALIGN_EPI = true>
__device__ __forceinline__ void gemm_phase(PG8_LAS unsigned char* lds, const int K, const int ldb, const Sched& S, const Epi& E) {
    const int tid = threadIdx.x, wid = __builtin_amdgcn_readfirstlane(tid >> 6), lane = tid & 63, wr = wid >> 2, wc = wid & 3, fr = lane & 15, fq = lane >> 4;
    const int nt = K / BK;
    int RA[2], CA[2]; unsigned voffB[2];
#pragma unroll
    for (int i = 0; i < 2; ++i) { int R, C; stage_rc(tid * 16 + i * 8192, R, C); const int Rb = Epi::PERM ? ((R & ~31) + perm32(R & 31)) : R;
        RA[i] = R; CA[i] = C; voffB[i] = (unsigned)(Rb * ldb + C) * 2u; }
    const size_t kstep = (size_t)(BK * 2);
    const size_t hstep = (size_t)HALF * ldb * 2;
    const unsigned ldsw = (unsigned)wid * 1024u;
    const int aoff = lds_byte(wr * 64 + fr, fq * 8), boff = lds_byte(wc * 32 + fr, fq * 8);
#define PG8_SA(b, h) (((b) * 2 + (h)) * HTB)
#define PG8_SB(b, h) ((4 + (b) * 2 + (h)) * HTB)
#define PG8_STAGE(bufoff, gbase, voff) do { _Pragma("unroll") for (int _i = 0; _i < 2; ++_i) \
        __builtin_amdgcn_global_load_lds((const unsigned*)((const char*)(gbase) + (voff)[_i]), (PG8_LAS unsigned*)(lds + (bufoff) + ldsw + _i * 8192), 16, 0, 0); } while (0)
#define PG8_LDA(dst, b, h) do { _Pragma("unroll") for (int m = 0; m < 4; ++m) _Pragma("unroll") for (int k = 0; k < 2; ++k) dst[m][k] = *(const PG8_LAS bf16x8*)(lds + PG8_SA(b, h) + aoff + m * 2048 + k * 1024); } while (0)
#define PG8_LDB(dst, b, h) do { _Pragma("unroll") for (int n = 0; n < 2; ++n) _Pragma("unroll") for (int k = 0; k < 2; ++k) dst[n][k] = *(const PG8_LAS bf16x8*)(lds + PG8_SB(b, h) + boff + n * 2048 + k * 1024); } while (0)
#define PG8_MMA(ai, bj, At, Bt) do { __builtin_amdgcn_s_setprio(1); _Pragma("unroll") for (int m = 0; m < 4; ++m) _Pragma("unroll") for (int n = 0; n < 2; ++n) _Pragma("unroll") for (int k = 0; k < 2; ++k) \
        acc[ai][bj][m][n] = __builtin_amdgcn_mfma_f32_16x16x32_bf16(Bt[n][k], At[m][k], acc[ai][bj][m][n], 0, 0, 0); __builtin_amdgcn_s_setprio(0); } while (0)
#define PG8_WAIT_V(n) asm volatile("s_waitcnt vmcnt(" #n ")" ::: "memory")
#define PG8_WAIT_L(n) asm volatile("s_waitcnt lgkmcnt(" #n ")" ::: "memory")
#define PG8_BAR __builtin_amdgcn_s_barrier()
#define PG8_SCHED __builtin_amdgcn_sched_barrier(0)
    Unit cur, nxt; int ui = 0;
    if (!S.next(0, cur)) return;
    unsigned vAc[2][2], vAn[2][2];
    S.a_offs(cur, RA, CA, vAc);
    f32x4 acc[2][2][4][2];
    E.init(acc, cur, wr, wc, fr, fq);
    bf16x8 At[4][2], B0[2][2], B1[2][2];
    const char* cA = cur.A; const char* cB = cur.B;
    PG8_STAGE(PG8_SB(0, 0), cB, voffB); PG8_STAGE(PG8_SB(0, 1), cB + hstep, voffB); PG8_STAGE(PG8_SA(0, 0), cA, vAc[0]); PG8_STAGE(PG8_SA(0, 1), cA, vAc[1]);
    if (wr == 1) PG8_BAR;
    PG8_WAIT_V(2); PG8_BAR;
    PG8_STAGE(PG8_SB(1, 0), cB + kstep, voffB); PG8_STAGE(PG8_SA(1, 0), cA + kstep, vAc[0]); PG8_STAGE(PG8_SB(1, 1), cB + hstep + kstep, voffB);
    PG8_WAIT_V(6); PG8_BAR;
    for (;;) {
        const bool has_next = S.next(ui + 1, nxt);
        const char* nA = has_next ? nxt.A : cA; const char* nB = has_next ? nxt.B : cB;
        if (Sched::GATHER && has_next) S.a_offs(nxt, RA, CA, vAn);
        else {
#pragma unroll
            for (int h = 0; h < 2; ++h)
#pragma unroll
                for (int i = 0; i < 2; ++i) vAn[h][i] = vAc[h][i]; }
        for (int t = 0; t < nt; t += 2) {
            const bool last = (t == nt - 2);
            const char* a1 = cA + (size_t)(t + 1) * kstep;
            const char* a2 = last ? nA : cA + (size_t)(t + 2) * kstep; const char* b2 = last ? nB : cB + (size_t)(t + 2) * kstep;
            const char* a3 = a2 + kstep; const char* b3 = b2 + kstep;
            unsigned o2[2][2];
#pragma unroll
            for (int h = 0; h < 2; ++h)
#pragma unroll
                for (int i = 0; i < 2; ++i) o2[h][i] = (Sched::GATHER && last) ? vAn[h][i] : vAc[h][i];
            if (last && has_next) S.a_ready(nxt);
            PG8_LDB(B0, 0, 0); PG8_LDB(B1, 0, 1); PG8_SCHED; PG8_LDA(At, 0, 0); PG8_STAGE(PG8_SA(1, 1), a1, vAc[1]);
            PG8_WAIT_V(8); PG8_WAIT_L(0); PG8_BAR; PG8_MMA(0, 0, At, B0); PG8_MMA(0, 1, At, B1); PG8_BAR; PG8_SCHED;
            PG8_LDA(At, 0, 1); PG8_STAGE(PG8_SB(0, 0), b2, voffB); PG8_STAGE(PG8_SB(0, 1), b2 + hstep, voffB); PG8_STAGE(PG8_SA(0, 0), a2, o2[0]);
            PG8_WAIT_V(8); PG8_WAIT_L(0); PG8_BAR; PG8_MMA(1, 0, At, B0); PG8_MMA(1, 1, At, B1); PG8_BAR; PG8_SCHED;
            PG8_LDB(B0, 1, 0); PG8_LDB(B1, 1, 1); PG8_SCHED; PG8_LDA(At, 1, 0); PG8_STAGE(PG8_SA(0, 1), a2, o2[1]);
            PG8_WAIT_V(8); PG8_WAIT_L(0); PG8_BAR; PG8_MMA(0, 0, At, B0); PG8_MMA(0, 1, At, B1); PG8_BAR; PG8_SCHED;
            PG8_LDA(At, 1, 1); PG8_STAGE(PG8_SB(1, 0), b3, voffB); PG8_STAGE(PG8_SB(1, 1), b3 + hstep, voffB); PG8_STAGE(PG8_SA(1, 0), a3, o2[0]);
            PG8_WAIT_V(8); PG8_WAIT_L(0); PG8_BAR; PG8_MMA(1, 0, At, B0); PG8_MMA(1, 1, At, B1); PG8_BAR; PG8_SCHED;
        }
        if constexpr (ALIGN_EPI) { if (wr == 0) PG8_BAR; }
        E(acc, cur, wr, wc, fr, fq); S.done(cur);
        if (!has_next) break;
        E.init(acc, nxt, wr, wc, fr, fq);
        cur = nxt; cA = nA; cB = nB; ++ui;
#pragma unroll
        for (int h = 0; h < 2; ++h)
#pragma unroll
            for (int i = 0; i < 2; ++i) vAc[h][i] = vAn[h][i];
        if constexpr (ALIGN_EPI) { if (wr == 1) PG8_BAR; }
    }
    PG8_WAIT_V(0);
    if constexpr (!ALIGN_EPI) { if (wr == 0) PG8_BAR; }
    PG8_BAR;
#undef PG8_SA
#undef PG8_SB
#undef PG8_STAGE
#undef PG8_LDA
#undef PG8_LDB
#undef PG8_MMA
#undef PG8_WAIT_V
#undef PG8_WAIT_L
#undef PG8_BAR
#undef PG8_SCHED
}
}

#define GAS __attribute__((address_space(1)))
#define LAS __attribute__((address_space(3)))
typedef unsigned short bf16;
typedef unsigned v4u __attribute__((ext_vector_type(4)));
typedef float f32x4 __attribute__((ext_vector_type(4)));
typedef short bf16x8 __attribute__((ext_vector_type(8)));
typedef GAS unsigned gu32;
typedef GAS unsigned long long gu64;
#define RLX_AGENT __ATOMIC_RELAXED, __HIP_MEMORY_SCOPE_AGENT
#define LDS_WAIT() asm volatile("s_waitcnt lgkmcnt(0)" ::: "memory")
#define VM_WAIT() asm volatile("s_waitcnt vmcnt(0)" ::: "memory")
__device__ __forceinline__ unsigned long long rt() { return __builtin_amdgcn_s_memrealtime(); }
__device__ __forceinline__ unsigned f2bf(float f) { unsigned u = __builtin_bit_cast(unsigned, f); return (u + 0x7fffu + ((u >> 16) & 1u)) >> 16; }
__device__ __forceinline__ unsigned pk2(float lo, float hi) { return f2bf(lo) | (f2bf(hi) << 16); }

#define XB_TMO      128
#define XB_XCNT(j)  (256  + 64 * (j))
#define XB_XSUB(j)  (1280 + 64 * (j))
#define XB_XGEN(j)  (2304 + 64 * (j))
#define XB_TOP      3328
#define XB_TOPGEN   3392
#define XCD_BAR_WORDS 3456
#define XB_SPIN_CAP (1u << 18)

__device__ __forceinline__ unsigned xb_ld(unsigned* p)              { return __hip_atomic_load(p, __ATOMIC_RELAXED, __HIP_MEMORY_SCOPE_AGENT); }
__device__ __forceinline__ unsigned xb_add(unsigned* p, unsigned v) { return __hip_atomic_fetch_add(p, v, __ATOMIC_RELAXED, __HIP_MEMORY_SCOPE_AGENT); }
__device__ __forceinline__ unsigned xb_xcc_id() { return (unsigned)__builtin_amdgcn_s_getreg((3 << 11) | 20) & 0xFu; }
#define XB_SPIN(cond, bar) do { unsigned _sp = 0; while (cond) { __builtin_amdgcn_s_sleep(1); \
    if ((++_sp & 255u) == 0u) { if (xb_ld(&(bar)[XB_TMO])) break; if (_sp > XB_SPIN_CAP) { atomicAdd(&(bar)[XB_TMO], 1u); break; } } } } while (0)

struct XcdBarrier {
    unsigned* bar; unsigned x;
    volatile LAS unsigned* st;
};

__device__ __forceinline__ XcdBarrier xcd_barrier_post(unsigned* bar, volatile LAS unsigned* st) {
    XcdBarrier b; b.bar = bar; b.x = xb_xcc_id(); b.st = st;
    if (threadIdx.x == 0) (void)xb_add(&bar[XB_XCNT(b.x)], 1u);
    return b;
}
__device__ __forceinline__ void xcd_barrier_complete(unsigned* bar, unsigned x, unsigned& nloc, unsigned& nx) {
    const unsigned G = gridDim.x * gridDim.y * gridDim.z;
    unsigned sum, cnt, mine, sp = 0u;
    for (;;) {
        sum = 0u; cnt = 0u; mine = 0u;
#pragma unroll
        for (unsigned j = 0; j < 16; ++j) { const unsigned c = xb_ld(&bar[XB_XCNT(j)]); sum += c; cnt += (c > 0u) ? 1u : 0u; mine = (j == x) ? c : mine; }
        if (sum == G) break;
        __builtin_amdgcn_s_sleep(1);
        if ((++sp & 255u) == 0u) { if (xb_ld(&bar[XB_TMO])) break; if (sp > XB_SPIN_CAP) { atomicAdd(&bar[XB_TMO], 1u); break; } }
    }
    nloc = mine > 0u ? mine : 1u; nx = cnt > 0u ? cnt : 1u;
}

__device__ __forceinline__ void xcd_barrier(const XcdBarrier& b) {
    asm volatile("s_waitcnt vmcnt(0)" ::: "memory");
    __syncthreads();
    if (threadIdx.x == 0) {
        unsigned* bar = b.bar;
        __builtin_amdgcn_s_waitcnt(0);
        unsigned nloc = b.st[0], nx = b.st[1];
        if (nloc == 0u) { xcd_barrier_complete(bar, b.x, nloc, nx); b.st[0] = nloc; b.st[1] = nx; }
        const unsigned old = xb_add(&bar[XB_XSUB(b.x)], 1u);
        const unsigned gen = old / nloc;
        if (old + 1u == (gen + 1u) * nloc) {
            __builtin_amdgcn_fence(__ATOMIC_RELEASE, "agent");
            asm volatile("s_waitcnt vmcnt(0)" ::: "memory");
            const unsigned og = xb_add(&bar[XB_TOP], 1u);
            const unsigned tg = og / nx;
            if (og + 1u == (tg + 1u) * nx) xb_add(&bar[XB_TOPGEN], 1u);
            else XB_SPIN(xb_ld(&bar[XB_TOPGEN]) == tg, bar);
            __builtin_amdgcn_fence(__ATOMIC_ACQUIRE, "agent");
            xb_add(&bar[XB_XGEN(b.x)], 1u);
            asm volatile("s_waitcnt vmcnt(0)" ::: "memory");
        } else {
            XB_SPIN(xb_ld(&bar[XB_XGEN(b.x)]) == gen, bar);
            __builtin_amdgcn_fence(__ATOMIC_ACQUIRE, "agent");
            asm volatile("s_waitcnt vmcnt(0)" ::: "memory");
        }
    }
    __syncthreads();
}


constexpr size_t MiB = 1u << 20;
constexpr size_t WS_CTL = 0, CTL_ZERO_BYTES = 1 * MiB;
constexpr size_t WS_WIN = 1 * MiB;
constexpr size_t WS_WOUT = 19 * MiB;
constexpr size_t WS_WQM = 27 * MiB;
constexpr size_t WS_WKV = 29 * MiB;
constexpr size_t WS_WOM = 33 * MiB;
constexpr size_t WS_WGU = 35 * MiB;
constexpr size_t WS_WD = 291 * MiB;
constexpr size_t WS_XN = 419 * MiB;
constexpr size_t WS_MEMN = 451 * MiB;
constexpr size_t WS_PROJ = 453 * MiB;
constexpr size_t WS_KVM = 525 * MiB;
constexpr size_t WS_OPART = 526 * MiB;
constexpr size_t WS_OB = 574 * MiB;
constexpr size_t WS_LPART = 590 * MiB;
constexpr size_t WS_MIXED = 591 * MiB;
constexpr size_t WS_X1 = 623 * MiB;
constexpr size_t WS_QM = 687 * MiB;
constexpr size_t WS_OM = 695 * MiB;
constexpr size_t WS_AFF = 703 * MiB;
constexpr size_t WS_IDX = 704 * MiB;
constexpr size_t WS_GATE = 704 * MiB + 65536;
constexpr size_t WS_INV = 704 * MiB + 131072;
constexpr size_t WS_RS = 704 * MiB + 655360;
constexpr size_t WS_SS1 = 65536, WS_SS2 = 131072;
constexpr size_t WS_XE = 705 * MiB;
constexpr size_t WS_ACT = 769 * MiB;
constexpr size_t WS_YS = 833 * MiB;
constexpr size_t WS_X2 = 897 * MiB;
constexpr size_t WS_END = 961 * MiB;
constexpr int CW_BAR = 4096;

constexpr int RING_BYTES = 131072;
constexpr int LDSCTL_OFF = RING_BYTES, MISC_OFF = LDSCTL_OFF + 320;
constexpr int LDS_BYTES = 147456;
constexpr int NWAVES = 8, NTHREADS = 512;

typedef unsigned v2u __attribute__((ext_vector_type(2)));
typedef float f32x2 __attribute__((ext_vector_type(2)));
typedef __bf16 bf16x2_t __attribute__((ext_vector_type(2)));
__device__ __forceinline__ unsigned cvtpk(float lo, float hi) { f32x2 v = {lo, hi}; bf16x2_t b = __builtin_convertvector(v, bf16x2_t); return __builtin_bit_cast(unsigned, b); }
__device__ __forceinline__ float bflo(unsigned w) { return __uint_as_float(w << 16); }
__device__ __forceinline__ float bfhi(unsigned w) { return __uint_as_float(w & 0xffff0000u); }
__device__ __forceinline__ float bf2f(unsigned short h) { return __uint_as_float((unsigned)h << 16); }
__device__ __forceinline__ float wave_sum(float v) {
#pragma unroll
    for (int o = 1; o < 64; o <<= 1) v += __shfl_xor(v, o);
    return v;
}
__device__ __forceinline__ float wave_max(float v) {
#pragma unroll
    for (int o = 1; o < 64; o <<= 1) v = fmaxf(v, __shfl_xor(v, o));
    return v;
}
__device__ __forceinline__ float gain_absmax(const float* g, int lane) { return wave_max(fmaxf(fabsf(g[lane]), fabsf(g[lane + 64]))); }

struct CvtTile { const float* src; bf16* dst; const float* gk; int N, K, mode, k0, n0; };
constexpr int T_IN = 16 * 18, T_OUT = 16 * 8, T_QM = 16 * 2, T_KV = 16 * 4, T_OM = 4 * 8, T_EXP = 16 * 128;
constexpr int T_TOTAL = T_IN + T_OUT + T_QM + T_KV + T_OM + 3 * T_EXP;
template <class A_> __device__ __forceinline__ CvtTile cvt_decode(int it, const A_& args, unsigned char* ws) {
    CvtTile t; int r = it; t.gk = nullptr;
    if (r < T_IN) { t.src = args.in[4]; t.dst = (bf16*)(ws + WS_WIN); t.N = DIN; t.K = DM; t.mode = 0; t.k0 = (r / 18) * 128; t.n0 = (r % 18) * 256; return t; } r -= T_IN;
    if (r < T_KV) { t.src = args.in[16]; t.dst = (bf16*)(ws + WS_WKV); t.N = 2 * WMEM; t.K = DM; t.mode = 0; t.k0 = (r / 4) * 128; t.n0 = (r % 4) * 256; return t; } r -= T_KV;
    if (r < T_OUT) { t.src = args.in[12]; t.dst = (bf16*)(ws + WS_WOUT); t.N = DM; t.K = DM; t.mode = 0; t.k0 = (r / 8) * 128; t.n0 = (r % 8) * 256; return t; } r -= T_OUT;
    if (r < T_QM) { t.src = args.in[15]; t.gk = args.in[13]; t.dst = (bf16*)(ws + WS_WQM); t.N = WMEM; t.K = DM; t.mode = 0; t.k0 = (r / 2) * 128; t.n0 = (r % 2) * 256; return t; } r -= T_QM;
    if (r < T_OM) { t.src = args.in[19]; t.dst = (bf16*)(ws + WS_WOM); t.N = DM; t.K = WMEM; t.mode = 0; t.k0 = (r / 8) * 128; t.n0 = (r % 8) * 256; return t; } r -= T_OM;
    const int which = r / T_EXP; r -= which * T_EXP; const int e = r / 128, rr = r % 128;
    t.N = DM; t.K = DM; t.k0 = (rr / 8) * 128; t.n0 = (rr % 8) * 256;
    if (which < 2) t.gk = args.in[20];
    if (which == 0) { t.src = args.in[22] + (size_t)e * DM * DFF; t.dst = (bf16*)(ws + WS_WGU) + (size_t)e * 2 * DFF * DM; t.mode = 1; }
    else if (which == 1) { t.src = args.in[23] + (size_t)e * DM * DFF; t.dst = (bf16*)(ws + WS_WGU) + (size_t)e * 2 * DFF * DM; t.mode = 2; }
    else { t.src = args.in[24] + (size_t)e * DFF * DM; t.dst = (bf16*)(ws + WS_WD) + (size_t)e * DM * DFF; t.mode = 0; }
    return t;
}
#define CVT_ISSUE(v, t) do { const float* p_ = (t).src + (size_t)((t).k0 + 4 * (tid >> 6)) * (t).N + (t).n0 + 4 * (tid & 63); \
    _Pragma("unroll") for (int ps_ = 0; ps_ < 4; ++ps_) _Pragma("unroll") for (int r_ = 0; r_ < 4; ++r_) v[ps_ * 4 + r_] = *(const GAS f32x4*)(p_ + (size_t)(32 * ps_ + r_) * (t).N); } while (0)
__device__ __forceinline__ void cvt_to_lds(const f32x4 (&v)[16], const float* gk, int k0, LAS unsigned char* lds, int tid) {
    const int c = tid & 63, kg = tid >> 6, f = c & 15;
#pragma unroll
    for (int ps = 0; ps < 4; ++ps) { const int kch = 8 * ps + kg;
        f32x4 gq = (f32x4){1.f, 1.f, 1.f, 1.f}; if (gk) gq = *(const GAS f32x4*)(gk + k0 + 32 * ps + 4 * kg);
#pragma unroll
        for (int j = 0; j < 4; ++j) { v2u w; w.x = cvtpk(v[ps * 4 + 0][j] * gq.x, v[ps * 4 + 1][j] * gq.y); w.y = cvtpk(v[ps * 4 + 2][j] * gq.z, v[ps * 4 + 3][j] * gq.w);
            *(LAS v2u*)(lds + (4 * c + j) * 256 + ((kch ^ f) * 8)) = w; } }
}
__device__ __forceinline__ void cvt_store(const CvtTile& t, LAS unsigned char* lds, int tid) {
    const int q = tid & 15;
#pragma unroll
    for (int ps = 0; ps < 8; ++ps) { const int n = (tid >> 4) + 32 * ps, f = (n >> 2) & 15; v4u w = *(LAS v4u*)(lds + n * 256 + ((q ^ (f >> 1)) * 16));
        if (f & 1) { const unsigned a = w.x, b = w.y; w.x = w.z; w.y = w.w; w.z = a; w.w = b; }
        const int nn = t.n0 + n; const int drow = t.mode == 0 ? nn : ((nn >> 7) * 256 + (nn & 127) + (t.mode == 2 ? 128 : 0));
        *(GAS v4u*)(t.dst + (size_t)drow * t.K + t.k0 + 8 * q) = w; }
}
#define CONVERT_RANGE(t0_, t1_, j_, n_) do { f32x4 v_[16]; int it_ = (t0_) + (j_); bool have_ = it_ < (t1_); CvtTile cur_ = cvt_decode(have_ ? it_ : 0, args, ws); \
        if (have_) CVT_ISSUE(v_, cur_); \
        while (have_) { __syncthreads(); cvt_to_lds(v_, cur_.gk, cur_.k0, lds, tid); \
            it_ += (n_); const bool hn_ = it_ < (t1_); const CvtTile nxt_ = cvt_decode(hn_ ? it_ : 0, args, ws); \
            if (hn_) CVT_ISSUE(v_, nxt_); \
            LDS_WAIT(); __syncthreads(); cvt_store(cur_, lds, tid); cur_ = nxt_; have_ = hn_; } \
        __syncthreads(); } while (0)
__device__ __forceinline__ void norm_row_bf16(const float* xrow, const float* g, bf16* orow, int lane) {
    f32x4 v[8]; float ss = 0.f;
#pragma unroll
    for (int j = 0; j < 8; ++j) { v[j] = *(const GAS f32x4*)(xrow + lane * 4 + 256 * j); ss += (v[j].x * v[j].x + v[j].y * v[j].y) + (v[j].z * v[j].z + v[j].w * v[j].w); }
    const float rstd = 1.0f / sqrtf(wave_sum(ss) * (1.0f / DM) + EPS);
#pragma unroll
    for (int j = 0; j < 8; ++j) { const f32x4 gg = *(const GAS f32x4*)(g + lane * 4 + 256 * j); v2u w; w.x = cvtpk(v[j].x * rstd * gg.x, v[j].y * rstd * gg.y); w.y = cvtpk(v[j].z * rstd * gg.z, v[j].w * rstd * gg.w);
        *(GAS v2u*)(orow + lane * 4 + 256 * j) = w; }
}

namespace att {
typedef short s16x4 __attribute__((ext_vector_type(4)));
typedef float f32x16 __attribute__((ext_vector_type(16)));
constexpr int VBUF = 32768, TILEB = 16384, STG_PITCH = 272, STG_W = 32 * STG_PITCH, WSF = 8 * STG_W;
__device__ __forceinline__ int crow(int r, int hi) { return (r & 3) + 8 * (r >> 2) + 4 * hi; }
__device__ __forceinline__ s16x4 vtr(const LAS unsigned char* p) { return __builtin_bit_cast(s16x4, __builtin_amdgcn_ds_read_tr16_b64_v4i16((LAS s16x4*)p)); }
template <bool MASK, bool QNORM, bool NORMALIZE>
__device__ __forceinline__ void attn_unit(LAS unsigned char* lds, const bf16* qw, long q_stride, const bf16* k0, const bf16* v0, long kv_stride,
                                          int tlo, int thi, int a, int half, float negM2, float l_extra, bf16* ow, long o_stride, float* lw, long l_stride, const float* ssrow) {
    int tid_ = threadIdx.x; asm volatile("" : "+v"(tid_));
    const int tid = tid_, lane = tid & 63, c = lane & 31, hi = lane >> 5, wid = __builtin_amdgcn_readfirstlane(tid >> 6);
    bf16x8 qf[8];
    { const bf16* qp = qw + (long)c * q_stride + 8 * hi;
#pragma unroll
      for (int ks = 0; ks < 8; ++ks) qf[ks] = *(const GAS bf16x8*)(qp + 16 * ks); }
    float qs = 1.f;
    if (QNORM) { float ss = 0.f;
#pragma unroll
        for (int ks = 0; ks < 8; ++ks)
#pragma unroll
            for (int j = 0; j < 8; ++j) { const float f = bf2f((unsigned short)qf[ks][j]); ss += f * f; }
        ss += __shfl_xor(ss, 32); const float r1 = 1.0f / sqrtf(ssrow[c] * (1.0f / DM) + EPS);
        qs = QSCALE * r1 / sqrtf(r1 * r1 * ss * (1.0f / HD) + EPS); }
    const int srow = tid >> 4, sch = tid & 15;
    const bf16* kg = k0 + (long)srow * kv_stride + (sch ^ (srow & 15)) * 8; const bf16* vg = v0 + (long)srow * kv_stride + (sch ^ (((srow & 3) << 2) | ((srow >> 2) & 3))) * 8;
    const unsigned ldsw = (unsigned)wid * 1024u;
    const unsigned kbase = c * 256; const int cx = c & 15;
    const int q4 = (lane & 15) >> 2, p = lane & 3, g = (lane >> 4) & 1;
    unsigned vb[4][2];
#pragma unroll
    for (int db = 0; db < 4; ++db)
#pragma unroll
        for (int u = 0; u < 2; ++u) vb[db][u] = VBUF + 256 * (4 * hi + 8 * u + q4) + 16 * ((((db ^ q4)) << 2) | ((g ^ u) << 1) | ((p >> 1) ^ hi)) + 8 * (p & 1);
    f32x16 o[4];
#pragma unroll
    for (int db = 0; db < 4; ++db)
#pragma unroll
        for (int r = 0; r < 16; ++r) o[db][r] = 0.f;
    float lsum = 0.f;
#define AT_ISSUE(t, bw) do { const long r_ = (long)(t) * 64; \
        __builtin_amdgcn_global_load_lds((const unsigned*)(kg + r_ * kv_stride), (LAS unsigned*)(lds + (bw) * TILEB + ldsw), 16, 0, 0); \
        __builtin_amdgcn_global_load_lds((const unsigned*)(kg + (r_ + 32) * kv_stride), (LAS unsigned*)(lds + (bw) * TILEB + 8192 + ldsw), 16, 0, 0); \
        __builtin_amdgcn_global_load_lds((const unsigned*)(vg + r_ * kv_stride), (LAS unsigned*)(lds + VBUF + (bw) * TILEB + ldsw), 16, 0, 0); \
        __builtin_amdgcn_global_load_lds((const unsigned*)(vg + (r_ + 32) * kv_stride), (LAS unsigned*)(lds + VBUF + (bw) * TILEB + 8192 + ldsw), 16, 0, 0); } while (0)
    AT_ISSUE(tlo, 0); VM_WAIT(); __syncthreads();
    for (int t = tlo; t < thi; ++t) {
        const int buf = (t - tlo) & 1; const bool more = (t + 1 < thi);
        if (more) AT_ISSUE(t + 1, buf ^ 1);
        const bool need = !MASK || ((64 * t + 63 >= a - half) && (64 * t <= a + 31 + half));
        if (need) {
            const LAS unsigned char* kt = lds + buf * TILEB + kbase; const LAS unsigned char* vt = lds + buf * TILEB;
            const float ini = QNORM ? 0.f : negM2;
            const int jb = 64 * t + 4 * hi - (a + c);
            v4u pw[4];
#pragma unroll
            for (int kb = 0; kb < 2; ++kb) {
                f32x16 pp;
#pragma unroll
                for (int r = 0; r < 16; ++r) pp[r] = ini;
#pragma unroll
                for (int ks = 0; ks < 8; ++ks) { const int off = 16 * ((2 * ks + hi) ^ cx) + 8192 * kb;
                    const bf16x8 ka = *(const LAS bf16x8*)(kt + off);
                    pp = __builtin_amdgcn_mfma_f32_32x32x16_bf16(ka, qf[ks], pp, 0, 0, 0); }
#pragma unroll
                for (int r = 0; r < 16; ++r) {
                    float e0 = QNORM ? __builtin_amdgcn_exp2f(__builtin_fmaf(pp[r], qs, negM2)) : __builtin_amdgcn_exp2f(pp[r]);
                    if (MASK) { const int d0 = jb + 32 * kb + (r & 3) + 8 * (r >> 2); if ((unsigned)(d0 + half) > (unsigned)(2 * half)) e0 = 0.f; }
                    pp[r] = e0; lsum += e0; }
                pw[2 * kb] = (v4u){cvtpk(pp[0], pp[1]), cvtpk(pp[2], pp[3]), cvtpk(pp[4], pp[5]), cvtpk(pp[6], pp[7])};
                pw[2 * kb + 1] = (v4u){cvtpk(pp[8], pp[9]), cvtpk(pp[10], pp[11]), cvtpk(pp[12], pp[13]), cvtpk(pp[14], pp[15])};
            }
#pragma unroll
            for (int db = 0; db < 4; ++db)
#pragma unroll
                for (int sp = 0; sp < 4; ++sp) { const int imm = 8192 * (sp >> 1) + 4096 * (sp & 1);
                    const s16x4 lo = vtr(vt + vb[db][0] + imm), hv = vtr(vt + vb[db][1] + imm);
                    const bf16x8 vf = (bf16x8){lo[0], lo[1], lo[2], lo[3], hv[0], hv[1], hv[2], hv[3]};
                    o[db] = __builtin_amdgcn_mfma_f32_32x32x16_bf16(__builtin_bit_cast(bf16x8, pw[sp]), vf, o[db], 0, 0, 0); }
        }
        VM_WAIT(); __syncthreads();
    }
#undef AT_ISSUE
    lsum += __shfl_xor(lsum, 32); lsum += l_extra;
    LAS float* wsf = (LAS float*)(lds + WSF + wid * 256);
    if (NORMALIZE) { if (hi == 0) wsf[c] = 1.0f / lsum; } else { if (hi == 0) lw[(long)c * l_stride] = lsum; }
    LDS_WAIT();
    LAS unsigned char* stg = lds + wid * STG_W;
#pragma unroll
    for (int r = 0; r < 16; ++r) { const int row = crow(r, hi); const float sc = NORMALIZE ? wsf[row] : 1.0f;
#pragma unroll
        for (int db = 0; db < 4; ++db) *(LAS unsigned short*)(stg + row * STG_PITCH + (32 * db + c) * 2) = (unsigned short)f2bf(o[db][r] * sc); }
    LDS_WAIT();
#pragma unroll
    for (int i = 0; i < 8; ++i) { const int row = 4 * i + (lane >> 4), ch = lane & 15; const v4u w = *(const LAS v4u*)(stg + row * STG_PITCH + ch * 16);
        *(GAS v4u*)(ow + (long)row * o_stride + ch * 8) = w; }
    LDS_WAIT();
    __syncthreads();
}
}

#define PLAIN_A_OFFS(lda_) static constexpr bool GATHER = false; __device__ __forceinline__ void a_offs(const pg8::Unit&, const int (&RA)[2], const int (&CA)[2], unsigned (&vA)[2][2]) const { \
        _Pragma("unroll") for (int h = 0; h < 2; ++h) _Pragma("unroll") for (int i = 0; i < 2; ++i) vA[h][i] = (unsigned)((h * 128 + RA[i]) * (lda_) + CA[i]) * 2u; }
struct OrderP1 {
    int G, c; const char* XN; const char* WIN; const char* MEMN; const char* WKV;
    __device__ __forceinline__ bool next(int i, pg8::Unit& u) const {
        int pm, pn; u.rows = nullptr;
        if (pg8::static_order(i, G, c, 32, 18, pm, pn)) { u.pm = pm; u.pn = pn; u.kind = 0; u.A = XN + (size_t)pm * 256 * DM * 2; u.B = WIN + (size_t)pn * 256 * DM * 2; return true; }
        const long L = (long)i * G + c - 576; if (L < 0 || L >= 8) return false;
        u.pm = (int)L >> 2; u.pn = (int)L & 3; u.kind = 1; u.A = MEMN + (size_t)u.pm * 256 * DM * 2; u.B = WKV + (size_t)u.pn * 256 * DM * 2; return true;
    }
    PLAIN_A_OFFS(DM)
    __device__ __forceinline__ void a_ready(const pg8::Unit&) const {}
    __device__ __forceinline__ void done(const pg8::Unit&) const {}
};
struct OrderPlain {
    int G, c, nM, nN, K; const char* A; const char* B;
    __device__ __forceinline__ bool next(int i, pg8::Unit& u) const {
        int pm, pn; if (!pg8::static_order(i, G, c, nM, nN, pm, pn)) return false;
        u.pm = pm; u.pn = pn; u.kind = 0; u.rows = nullptr; u.A = A + (size_t)pm * 256 * K * 2; u.B = B + (size_t)pn * 256 * K * 2; return true;
    }
    PLAIN_A_OFFS(K)
    __device__ __forceinline__ void a_ready(const pg8::Unit&) const {}
    __device__ __forceinline__ void done(const pg8::Unit&) const {}
};
struct OrderMoe {
    int G, c, nN, K; const char* A; const char* B;
    __device__ __forceinline__ bool next(int i, pg8::Unit& u) const {
        int pm, pn; if (!pg8::static_order(i, G, c, 64, nN, pm, pn)) return false;
        u.pm = pm; u.pn = pn; u.kind = 0; u.rows = nullptr; u.A = A + (size_t)pm * 256 * K * 2; u.B = B + ((size_t)(pm >> 2) * nN + pn) * 256 * K * 2; return true;
    }
    PLAIN_A_OFFS(K)
    __device__ __forceinline__ void a_ready(const pg8::Unit&) const {}
    __device__ __forceinline__ void done(const pg8::Unit&) const {}
};
struct OrderMoeG {
    static constexpr bool GATHER = true; int G, c; const char* X; const char* B; const int* idx;
    __device__ __forceinline__ bool next(int i, pg8::Unit& u) const {
        int pm, pn; if (!pg8::static_order(i, G, c, 64, 16, pm, pn)) return false;
        u.pm = pm; u.pn = pn; u.kind = 0; u.rows = idx + pm * 256; u.A = X + (size_t)((pm >> 1) & 1) * SEQ * DM * 2; u.B = B + ((size_t)(pm >> 2) * 16 + pn) * 256 * DM * 2; return true;
    }
    __device__ __forceinline__ void a_offs(const pg8::Unit& u, const int (&RA)[2], const int (&CA)[2], unsigned (&vA)[2][2]) const {
#pragma unroll
        for (int h = 0; h < 2; ++h)
#pragma unroll
            for (int i = 0; i < 2; ++i) vA[h][i] = (unsigned)(u.rows[h * 128 + RA[i]] * DM + CA[i]) * 2u; }
    __device__ __forceinline__ void a_ready(const pg8::Unit&) const {}
    __device__ __forceinline__ void done(const pg8::Unit&) const {}
};

constexpr int NPHASE = 16;
struct Args { const float* in[25]; float* out; unsigned char* ws; int ph_lo, ph_hi; };
static_assert(sizeof(Args) == 25 * 8 + 8 + 8 + 8, "Args has no padding");

__global__ void __launch_bounds__(NTHREADS, 2) fwd_kernel(Args args) {
    extern __shared__ __attribute__((aligned(16))) unsigned char lds_raw[];
    LAS unsigned char* lds = (LAS unsigned char*)lds_raw;
    volatile LAS unsigned* MISC = (volatile LAS unsigned*)(lds + MISC_OFF);
    const int tid = threadIdx.x, lane = tid & 63, wave = __builtin_amdgcn_readfirstlane(tid >> 6);
    const int G = gridDim.x; const int bx = blockIdx.x; const int vcu = (G % 8 == 0) ? (bx % 8) * (G / 8) + bx / 8 : bx;
    unsigned char* ws = args.ws;
    gu32* ctl = (gu32*)(ws + WS_CTL);
    for (int u = tid; u < (LDS_BYTES - LDSCTL_OFF) / 4; u += NTHREADS) ((LAS unsigned*)(lds + LDSCTL_OFF))[u] = 0u;
    __syncthreads();
    XcdBarrier bar; bar.bar = (unsigned*)(ctl + CW_BAR); bar.x = 0; bar.st = nullptr;
    if (MK_ONE_LAUNCH) bar = xcd_barrier_post((unsigned*)(ctl + CW_BAR), MISC + 8);
    const int lo = args.ph_lo, hi = args.ph_hi;
#ifndef PH_MASK
#define PH_MASK 0xffff
#endif
#define IN(k) (((PH_MASK >> (k)) & 1) && lo <= (k) && (k) < hi)
#define SEAM(k) do { if (IN(k) && (k) + 1 < hi) xcd_barrier(bar); } while (0)
    const int gw = vcu * NWAVES + wave, NGW = G * NWAVES;
#define PH_BEGIN(k) if (IN(k)) { PHASE_IDS
#define PHASE_IDS int tid_p_ = threadIdx.x; asm volatile("" : "+v"(tid_p_)); const int tid = tid_p_, lane = tid_p_ & 63; (void)tid; (void)lane;

    bf16* const WIN = (bf16*)(ws + WS_WIN); bf16* const WOUT = (bf16*)(ws + WS_WOUT); bf16* const WQM = (bf16*)(ws + WS_WQM); bf16* const WKV = (bf16*)(ws + WS_WKV);
    bf16* const WOM = (bf16*)(ws + WS_WOM); bf16* const WGU = (bf16*)(ws + WS_WGU); bf16* const WD = (bf16*)(ws + WS_WD);
    bf16* const XN = (bf16*)(ws + WS_XN); bf16* const MEMN = (bf16*)(ws + WS_MEMN); bf16* const PROJ = (bf16*)(ws + WS_PROJ); bf16* const KVM = (bf16*)(ws + WS_KVM);
    bf16* const OPART = (bf16*)(ws + WS_OPART); bf16* const OB = (bf16*)(ws + WS_OB); float* const LPART = (float*)(ws + WS_LPART); bf16* const MIXED = (bf16*)(ws + WS_MIXED);
    float* const X1 = (float*)(ws + WS_X1); bf16* const QM = (bf16*)(ws + WS_QM); bf16* const OM = (bf16*)(ws + WS_OM); float* const AFF = (float*)(ws + WS_AFF);
    int* const IDX = (int*)(ws + WS_IDX); float* const GATE = (float*)(ws + WS_GATE); int* const INV = (int*)(ws + WS_INV);
    bf16* const XE = (bf16*)(ws + WS_XE); bf16* const ACT = (bf16*)(ws + WS_ACT); bf16* const YS = (bf16*)(ws + WS_YS);
    float* const OUT = args.out; float* const X2 = (float*)(ws + WS_X2);
    float* const SS1 = (float*)(ws + WS_SS1); float* const SS2 = (float*)(ws + WS_SS2); float* const RS = (float*)(ws + WS_RS);

    PH_BEGIN(0)
        CONVERT_RANGE(0, T_TOTAL, vcu, G);
        for (int m = gw; m < TOK + BATCH * NMEM; m += NGW) {
            if (m < TOK) norm_row_bf16(args.in[0] + (size_t)m * DM, args.in[3], XN + (size_t)m * DM, lane);
            else norm_row_bf16(args.in[1] + (size_t)(m - TOK) * DM, args.in[14], MEMN + (size_t)(m - TOK) * DM, lane);
        }
    }
    SEAM(0);
    PH_BEGIN(1)
        OrderP1 S{G, bx, (const char*)XN, (const char*)WIN, (const char*)MEMN, (const char*)WKV};
        pg8::EpiBf16 E{PROJ, DIN, KVM, 2 * WMEM};
        pg8::gemm_phase<pg8::EpiBf16, OrderP1>(lds, DM, DM, S, E);
    }
    SEAM(1);
    PH_BEGIN(2)
        const int* pos = (const int*)args.in[2];
        for (int m = gw; m < TOK + BATCH * NMEM; m += NGW) {
            if (m < TOK) {
                const float inv_freq = exp2f(-(float)lane * (13.287712379549449f / 64.0f));
                const float ang = (float)pos[m] * inv_freq;
                const double ad = (double)ang; const double nrev = rint(ad * 0.15915494309189535); const float rf = (float)(ad - nrev * 6.283185307179586);
                const float cs = cosf(rf), sn = sinf(rf);
                bf16* row = PROJ + (size_t)m * DIN;
                float t1[26], t2[26];
#pragma unroll
                for (int s = 0; s < 26; ++s) { const int col = (s < 8) ? OFF_QA + 128 * s : (s < 16) ? OFF_KA + 128 * (s - 8) : (s < 24) ? OFF_QB + 128 * (s - 16) : OFF_KB + 128 * (s - 24);
                    t1[s] = bf2f(row[col + lane]); t2[s] = bf2f(row[col + 64 + lane]); }
                const float gqa1 = args.in[5][lane], gqa2 = args.in[5][lane + 64], gka1 = args.in[6][lane], gka2 = args.in[6][lane + 64];
                const float gqb1 = args.in[7][lane], gqb2 = args.in[7][lane + 64], gkb1 = args.in[8][lane], gkb2 = args.in[8][lane + 64];
#pragma unroll
                for (int s = 0; s < 26; ++s) { const int col = (s < 8) ? OFF_QA + 128 * s : (s < 16) ? OFF_KA + 128 * (s - 8) : (s < 24) ? OFF_QB + 128 * (s - 16) : OFF_KB + 128 * (s - 24);
                    const float g1 = (s < 8) ? gqa1 : (s < 16) ? gka1 : (s < 24) ? gqb1 : gkb1, g2 = (s < 8) ? gqa2 : (s < 16) ? gka2 : (s < 24) ? gqb2 : gkb2;
                    const float sc = (s < 8 || (s >= 16 && s < 24)) ? QSCALE : 1.f;
                    const float rstd = 1.0f / sqrtf(wave_sum(t1[s] * t1[s] + t2[s] * t2[s]) * (1.0f / HD) + EPS);
                    const float n1 = t1[s] * rstd * g1, n2 = t2[s] * rstd * g2;
                    row[col + lane] = (bf16)f2bf((n1 * cs - n2 * sn) * sc); row[col + 64 + lane] = (bf16)f2bf((n2 * cs + n1 * sn) * sc); }
            } else {
                bf16* row = KVM + (size_t)(m - TOK) * (2 * WMEM);
#pragma unroll 1
                for (int s = 0; s < 4; ++s) { const int col = 128 * s;
                    const float t1 = bf2f(row[col + lane]), t2 = bf2f(row[col + 64 + lane]);
                    const float rstd = 1.0f / sqrtf(wave_sum(t1 * t1 + t2 * t2) * (1.0f / HD) + EPS);
                    row[col + lane] = (bf16)f2bf(t1 * rstd * args.in[18][lane] * args.in[17][lane]); row[col + 64 + lane] = (bf16)f2bf(t2 * rstd * args.in[18][lane + 64] * args.in[17][lane + 64]); }
            }
        }
    }
    SEAM(2);
    PH_BEGIN(3)
        const float negM2a = -(SQRT_HD * LOG2E) * gain_absmax(args.in[5], lane) * gain_absmax(args.in[6], lane);
        const float negM2b = -(SQRT_HD * LOG2E) * gain_absmax(args.in[7], lane) * gain_absmax(args.in[8], lane);
        for (int u = vcu; u < 1024; u += G) {
            if (u < 768) {
                const int gi = u >> 8, rem = u & 255, b = rem >> 7, h = (rem >> 4) & 7, x = rem & 15;
                const int dlog = 2 * gi, d = 1 << dlog, r = x & (d - 1), blk = x >> dlog;
                const int L = SEQ >> dlog, i0 = blk * 256, a = i0 + 32 * wave;
                const int tlo = (i0 >> 6) - 1 < 0 ? 0 : (i0 >> 6) - 1, thi = (i0 >> 6) + 5 > (L >> 6) ? (L >> 6) : (i0 >> 6) + 5;
                const size_t tok0 = (size_t)b * SEQ + r;
                att::attn_unit<true, false, false>(lds, PROJ + (tok0 + (size_t)d * a) * DIN + OFF_QA + h * HD, (long)d * DIN,
                    PROJ + tok0 * DIN + OFF_KA + h * HD, PROJ + tok0 * DIN + OFF_VA + h * HD, (long)d * DIN, tlo, thi, a, 64, negM2a, 0.f,
                    OPART + (size_t)gi * TOK * 1024 + (tok0 + (size_t)d * a) * 1024 + h * HD, (long)d * 1024, LPART + (size_t)gi * TOK * 8 + (tok0 + (size_t)d * a) * 8 + h, (long)d * 8, nullptr);
            } else {
                const int ub = u - 768, b = ub >> 7, kvh = (ub >> 6) & 1, blk = ub & 63;
                const int i0 = blk * 64, a = i0 + 32 * (wave & 1), head = kvh * 4 + (wave >> 1);
                const int tlo = blk - 2 < 0 ? 0 : blk - 2, thi = blk + 3 > 64 ? 64 : blk + 3;
                const size_t tok0 = (size_t)b * SEQ;
                const float lx = __builtin_amdgcn_exp2f(args.in[9][head] * LOG2E + negM2b);
                att::attn_unit<true, false, true>(lds, PROJ + (tok0 + a) * DIN + OFF_QB + head * HD, (long)DIN,
                    PROJ + tok0 * DIN + OFF_KB + kvh * HD, PROJ + tok0 * DIN + OFF_VB + kvh * HD, (long)DIN, tlo, thi, a, 128, negM2b, lx,
                    OB + (tok0 + a) * 1024 + head * HD, 1024L, nullptr, 0L, nullptr);
            }
        }
    }
    SEAM(3);
    PH_BEGIN(4)
        for (int m = gw; m < TOK; m += NGW) {
            const int hd = lane >> 3; float oa[16], ob[16];
            float l = 0.f;
#pragma unroll
            for (int k = 0; k < 16; ++k) oa[k] = 0.f;
#pragma unroll
            for (int gi = 0; gi < 3; ++gi) { l += LPART[(size_t)gi * TOK * 8 + (size_t)m * 8 + hd];
                const GAS v4u* p = (const GAS v4u*)(OPART + (size_t)gi * TOK * 1024 + (size_t)m * 1024 + lane * 16);
#pragma unroll
                for (int q = 0; q < 2; ++q) { const v4u w = p[q]; oa[8 * q + 0] += bflo(w.x); oa[8 * q + 1] += bfhi(w.x); oa[8 * q + 2] += bflo(w.y); oa[8 * q + 3] += bfhi(w.y);
                    oa[8 * q + 4] += bflo(w.z); oa[8 * q + 5] += bfhi(w.z); oa[8 * q + 6] += bflo(w.w); oa[8 * q + 7] += bfhi(w.w); } }
            const float il = 1.0f / l; float ssa = 0.f, ssb = 0.f;
#pragma unroll
            for (int k = 0; k < 16; ++k) { oa[k] *= il; ssa += oa[k] * oa[k]; }
            { const GAS v4u* p = (const GAS v4u*)(OB + (size_t)m * 1024 + lane * 16);
#pragma unroll
              for (int q = 0; q < 2; ++q) { const v4u w = p[q]; ob[8 * q + 0] = bflo(w.x); ob[8 * q + 1] = bfhi(w.x); ob[8 * q + 2] = bflo(w.y); ob[8 * q + 3] = bfhi(w.y);
                  ob[8 * q + 4] = bflo(w.z); ob[8 * q + 5] = bfhi(w.z); ob[8 * q + 6] = bflo(w.w); ob[8 * q + 7] = bfhi(w.w); } }
#pragma unroll
            for (int k = 0; k < 16; ++k) ssb += ob[k] * ob[k];
            const float ra = 1.0f / sqrtf(wave_sum(ssa) * (1.0f / 1024.0f) + EPS), rb = 1.0f / sqrtf(wave_sum(ssb) * (1.0f / 1024.0f) + EPS);
            const float* ga = args.in[10] + lane * 16; const float* gb = args.in[11] + lane * 16;
            v4u wa[2], wb[2];
#pragma unroll
            for (int q = 0; q < 2; ++q) {
                wa[q] = (v4u){cvtpk(oa[8 * q] * ra * ga[8 * q], oa[8 * q + 1] * ra * ga[8 * q + 1]), cvtpk(oa[8 * q + 2] * ra * ga[8 * q + 2], oa[8 * q + 3] * ra * ga[8 * q + 3]),
                              cvtpk(oa[8 * q + 4] * ra * ga[8 * q + 4], oa[8 * q + 5] * ra * ga[8 * q + 5]), cvtpk(oa[8 * q + 6] * ra * ga[8 * q + 6], oa[8 * q + 7] * ra * ga[8 * q + 7])};
                wb[q] = (v4u){cvtpk(ob[8 * q] * rb * gb[8 * q], ob[8 * q + 1] * rb * gb[8 * q + 1]), cvtpk(ob[8 * q + 2] * rb * gb[8 * q + 2], ob[8 * q + 3] * rb * gb[8 * q + 3]),
                              cvtpk(ob[8 * q + 4] * rb * gb[8 * q + 4], ob[8 * q + 5] * rb * gb[8 * q + 5]), cvtpk(ob[8 * q + 6] * rb * gb[8 * q + 6], ob[8 * q + 7] * rb * gb[8 * q + 7])}; }
            GAS v4u* pa = (GAS v4u*)(MIXED + (size_t)m * DM + lane * 16); GAS v4u* pb = (GAS v4u*)(MIXED + (size_t)m * DM + 1024 + lane * 16);
            pa[0] = wa[0]; pa[1] = wa[1]; pb[0] = wb[0]; pb[1] = wb[1];
        }
    }
    SEAM(4);
    PH_BEGIN(5)
        OrderPlain S{G, bx, 32, 8, DM, (const char*)MIXED, (const char*)WOUT};
        pg8::EpiResidX E{args.in[0], X1, XN, SS1, DM};
        pg8::gemm_phase<pg8::EpiResidX, OrderPlain>(lds, DM, DM, S, E);
    }
    SEAM(5);
    PH_BEGIN(7)
        OrderPlain S{G, bx, 32, 2, DM, (const char*)XN, (const char*)WQM};
        pg8::EpiBf16 E{QM, WMEM, QM, WMEM};
        pg8::gemm_phase<pg8::EpiBf16, OrderPlain>(lds, DM, DM, S, E);
    }
    SEAM(7);
    PH_BEGIN(8)
        const float gg = wave_max(fmaxf(fabsf(args.in[17][lane] * args.in[18][lane]), fabsf(args.in[17][lane + 64] * args.in[18][lane + 64])));
        const float negM2c = -(SQRT_HD * LOG2E) * gg;
        for (int u = vcu; u < 128; u += G) {
            const int b = u >> 6, h = (u >> 4) & 3, blk = u & 15, a = blk * 256 + 32 * wave;
            const size_t tok0 = (size_t)b * SEQ;
            att::attn_unit<false, true, true>(lds, QM + (tok0 + a) * WMEM + h * HD, (long)WMEM, KVM + (size_t)b * NMEM * 2 * WMEM + h * HD, KVM + (size_t)b * NMEM * 2 * WMEM + WMEM + h * HD, 2L * WMEM,
                0, 4, a, 1 << 20, negM2c, 0.f, OM + (tok0 + a) * WMEM + h * HD, (long)WMEM, nullptr, 0L, SS1 + tok0 + a);
        }
    }
    SEAM(8);
    PH_BEGIN(9)
        OrderPlain S{G, bx, 32, 8, WMEM, (const char*)OM, (const char*)WOM};
        pg8::EpiResidX E{X1, X2, XN, SS2, DM};
        pg8::gemm_phase<pg8::EpiResidX, OrderPlain>(lds, WMEM, WMEM, S, E);
    }
    SEAM(9);
    PH_BEGIN(10)
        LAS float* wrT = (LAS float*)lds;
        for (int i = tid; i < DM * NEXP / 4; i += NTHREADS) { const f32x4 w = *(const GAS f32x4*)(args.in[21] + 4 * i); const int k = i >> 2, e0 = (i & 3) * 4;
            wrT[(e0 + 0) * DM + k] = w.x; wrT[(e0 + 1) * DM + k] = w.y; wrT[(e0 + 2) * DM + k] = w.z; wrT[(e0 + 3) * DM + k] = w.w; }
        LDS_WAIT(); __syncthreads();
        for (int m = gw; m < TOK; m += NGW) {
            const float* xrow = X2 + (size_t)m * DM; f32x4 v[8]; float ss = 0.f;
#pragma unroll
            for (int j = 0; j < 8; ++j) { v[j] = *(const GAS f32x4*)(xrow + lane * 4 + 256 * j); ss += (v[j].x * v[j].x + v[j].y * v[j].y) + (v[j].z * v[j].z + v[j].w * v[j].w); }
            const float rstd = 1.0f / sqrtf(wave_sum(ss) * (1.0f / DM) + EPS);
#pragma unroll
            for (int j = 0; j < 8; ++j) { const f32x4 gg = *(const GAS f32x4*)(args.in[20] + lane * 4 + 256 * j); v[j].x *= rstd * gg.x; v[j].y *= rstd * gg.y; v[j].z *= rstd * gg.z; v[j].w *= rstd * gg.w; }
            float lg[16];
#pragma unroll
            for (int e = 0; e < 16; ++e) { float s = 0.f;
#pragma unroll
                for (int j = 0; j < 8; ++j) { const f32x4 w = *(const LAS f32x4*)(wrT + e * DM + lane * 4 + 256 * j); s += (v[j].x * w.x + v[j].y * w.y) + (v[j].z * w.z + v[j].w * w.w); }
                lg[e] = wave_sum(s); asm volatile("" ::: "memory"); }
            float mx = lg[0];
#pragma unroll
            for (int e = 1; e < 16; ++e) mx = fmaxf(mx, lg[e]);
            float den = 0.f, mine = 0.f;
#pragma unroll
            for (int e = 0; e < 16; ++e) { const float ex = expf(lg[e] - mx); den += ex; if (lane == e) mine = ex; }
            if (lane < 16) AFF[((size_t)(m >> 12) * NEXP + lane) * SEQ + (m & (SEQ - 1))] = mine / den;
        }
    }
    SEAM(10);
    PH_BEGIN(11)
        LAS unsigned* hist = (LAS unsigned*)lds; LAS unsigned* misc = hist + 256; LAS unsigned* wtot = hist + 272;
        for (int u = vcu; u < BATCH * NEXP; u += G) {
            const int b = u >> 4, e = u & 15; const float* aff = AFF + (size_t)u * SEQ;
            const f32x4 a0 = *(const GAS f32x4*)(aff + tid * 8), a1 = *(const GAS f32x4*)(aff + tid * 8 + 4);
            unsigned bits[8] = {__float_as_uint(a0.x), __float_as_uint(a0.y), __float_as_uint(a0.z), __float_as_uint(a0.w), __float_as_uint(a1.x), __float_as_uint(a1.y), __float_as_uint(a1.z), __float_as_uint(a1.w)};
            unsigned prefix = 0u, krem = CAP;
#pragma unroll 1
            for (int pass = 0; pass < 4; ++pass) { const int shift = 24 - 8 * pass;
                __syncthreads();
                if (tid < 256) hist[tid] = 0u;
                __syncthreads();
#pragma unroll
                for (int i = 0; i < 8; ++i) if (pass == 0 || (bits[i] >> (shift + 8)) == prefix) __hip_atomic_fetch_add(&hist[(bits[i] >> shift) & 255u], 1u, __ATOMIC_RELAXED, __HIP_MEMORY_SCOPE_WORKGROUP);
                __syncthreads();
                if (wave == 0) {
                    const unsigned h0 = hist[255 - 4 * lane], h1 = hist[254 - 4 * lane], h2 = hist[253 - 4 * lane], h3 = hist[252 - 4 * lane];
                    const unsigned s = h0 + h1 + h2 + h3; unsigned incl = s;
#pragma unroll
                    for (int o = 1; o < 64; o <<= 1) { const unsigned t = __shfl_up(incl, o); if (lane >= o) incl += t; }
                    const unsigned excl = incl - s;
                    if (excl < krem && krem <= incl) { unsigned rem = krem - excl; unsigned bin;
                        if (rem <= h0) bin = 255 - 4 * lane; else { rem -= h0; if (rem <= h1) bin = 254 - 4 * lane; else { rem -= h1; if (rem <= h2) bin = 253 - 4 * lane; else { rem -= h2; bin = 252 - 4 * lane; } } }
                        misc[0] = (prefix << 8) | bin; misc[1] = rem; }
                }
                __syncthreads();
                prefix = misc[0]; krem = misc[1];
            }
            unsigned ngt = 0u, neq = 0u;
#pragma unroll
            for (int i = 0; i < 8; ++i) { ngt += bits[i] > prefix; neq += bits[i] == prefix; }
            unsigned cnt = ngt | (neq << 16), incl = cnt;
#pragma unroll
            for (int o = 1; o < 64; o <<= 1) { const unsigned t = __shfl_up(incl, o); if (lane >= o) incl += t; }
            if (lane == 63) wtot[wave] = incl;
            __syncthreads();
            unsigned base = 0u;
#pragma unroll
            for (int w = 0; w < 8; ++w) if (w < wave) base += wtot[w];
            const unsigned excl = base + incl - cnt; unsigned gtb = excl & 0xffffu, eqb = excl >> 16;
            const int rowbase = (e * BATCH + b) * CAP;
            const float vals[8] = {a0.x, a0.y, a0.z, a0.w, a1.x, a1.y, a1.z, a1.w};
#pragma unroll
            for (int i = 0; i < 8; ++i) { const bool gt = bits[i] > prefix, eq = bits[i] == prefix; const bool sel = gt || (eq && eqb < krem);
                const int slot = (int)(gtb + (eqb < krem ? eqb : krem)); const int s = tid * 8 + i;
                if (sel) { IDX[rowbase + slot] = s; GATE[rowbase + slot] = vals[i]; RS[rowbase + slot] = 1.0f / sqrtf(SS2[(size_t)b * SEQ + s] * (1.0f / DM) + EPS); }
                INV[((size_t)b * SEQ + s) * NEXP + e] = sel ? rowbase + slot : -1;
                gtb += gt; eqb += eq; }
            __syncthreads();
        }
    }
    SEAM(11);
    PH_BEGIN(13)
        OrderMoeG S{G, bx, (const char*)XN, (const char*)WGU, IDX};
        pg8::EpiSwiGlu E{ACT, DFF, RS};
        pg8::gemm_phase<pg8::EpiSwiGlu, OrderMoeG>(lds, DM, DM, S, E);
    }
    SEAM(13);
    PH_BEGIN(14)
        OrderMoe S{G, bx, 8, DFF, (const char*)ACT, (const char*)WD};
        pg8::EpiScaleBf16 E{YS, DM, GATE};
        pg8::gemm_phase<pg8::EpiScaleBf16, OrderMoe>(lds, DFF, DFF, S, E);
    }
    SEAM(14);
    PH_BEGIN(15)
        for (int m = gw; m < TOK; m += NGW) {
            const float* xrow = X2 + (size_t)m * DM + lane * 4; float* orow = OUT + (size_t)m * DM + lane * 4; f32x4 acc[8];
#pragma unroll
            for (int j = 0; j < 8; ++j) acc[j] = *(const GAS f32x4*)(xrow + 256 * j);
            const int myr = (lane < NEXP) ? INV[(size_t)m * NEXP + lane] : -1;
            unsigned long long mask = __ballot(myr >= 0);
            while (mask) { const int e = __builtin_ctzll(mask); mask &= mask - 1; const int r = __builtin_amdgcn_readlane(myr, e);
                const GAS v2u* p = (const GAS v2u*)(YS + (size_t)r * DM + lane * 4);
#pragma unroll
                for (int j = 0; j < 8; ++j) { const v2u w = p[64 * j]; acc[j].x += bflo(w.x); acc[j].y += bfhi(w.x); acc[j].z += bflo(w.y); acc[j].w += bfhi(w.y); } }
#pragma unroll
            for (int j = 0; j < 8; ++j) *(GAS f32x4*)(orow + 256 * j) = acc[j];
        }
    }
#ifdef PROBE_XBAR
    for (int i_ = 0; i_ < PROBE_XBAR; ++i_) xcd_barrier(bar);
#endif
#undef IN
#undef SEAM
}

extern "C" void kernel_launch(void* const* d_in, const int* in_sizes, int n_in, void* d_out, int out_size, void* d_ws, size_t ws_size, hipStream_t stream) {
    static int grid = 0;
    if (grid == 0) {
        if (n_in != 25 || out_size != TOK * DM || ws_size < WS_END) { fprintf(stderr, "kernel_launch: unexpected problem (n_in %d out %d ws %zu)\n", n_in, out_size, ws_size); grid = -1; return; }
        int dev = 0, cus = 0;
        if (hipGetDevice(&dev) != hipSuccess || hipDeviceGetAttribute(&cus, hipDeviceAttributeMultiprocessorCount, dev) != hipSuccess) { grid = -1; return; }
        if (hipFuncSetAttribute((const void*)fwd_kernel, hipFuncAttributeMaxDynamicSharedMemorySize, LDS_BYTES) != hipSuccess) { fprintf(stderr, "kernel_launch: hipFuncSetAttribute failed\n"); grid = -1; return; }
        int per_cu = 0; (void)hipOccupancyMaxActiveBlocksPerMultiprocessor(&per_cu, (const void*)fwd_kernel, NTHREADS, LDS_BYTES); (void)hipGetLastError();
        grid = cus;
    }
    if (grid < 0) return;
    (void)hipMemsetAsync((char*)d_ws + WS_CTL, 0, CTL_ZERO_BYTES, stream);
    Args a{};
    for (int i = 0; i < 25; ++i) a.in[i] = (const float*)d_in[i];
    a.out = (float*)d_out; a.ws = (unsigned char*)d_ws;
#if MK_ONE_LAUNCH
    a.ph_lo = 0; a.ph_hi = NPHASE;
    hipLaunchKernelGGL(fwd_kernel, dim3(grid), dim3(NTHREADS), LDS_BYTES, stream, a);
#ifdef PROBE_RELAUNCH
    for (int p = 0; p < NPHASE; ++p) if ((PROBE_RELAUNCH >> p) & 1) { a.ph_lo = p; a.ph_hi = p + 1; hipLaunchKernelGGL(fwd_kernel, dim3(grid), dim3(NTHREADS), LDS_BYTES, stream, a); }
#endif
#else
    for (int p = 0; p < NPHASE; ++p) { a.ph_lo = p; a.ph_hi = p + 1; hipLaunchKernelGGL(fwd_kernel, dim3(grid), dim3(NTHREADS), LDS_BYTES, stream, a); }
#endif
}
```

```cpp
#include <hip/hip_runtime.h>
#include <hip/hip_bf16.h>
#include <cstdio>
#include <cstdint>

#ifndef MK_ONE_LAUNCH
#define MK_ONE_LAUNCH 1
#endif

constexpr int BATCH = 2, SEQ = 4096, DM = 2048, TOK = BATCH * SEQ, HD = 128;
constexpr int DIN = 4608, NMEM = 256, WMEM = 512, NEXP = 16, CAP = 512, DFF = 2048;
constexpr int OFF_QA = 0, OFF_KA = 1024, OFF_VA = 2048, OFF_QB = 3072, OFF_KB = 4096, OFF_VB = 4352;
constexpr float EPS = 1e-6f;
constexpr float LOG2E = 1.4426950408889634f;
constexpr float QSCALE = 0.08838834764831845f * LOG2E;
constexpr float SQRT_HD = 11.313708498984761f;
constexpr float FP8_SW = 256.f, FP8_SX = 16.f, FP8_SA = 8.f;

namespace pg8 {
#define PG8_LAS __attribute__((address_space(3)))
typedef unsigned short bf16_t;
typedef short bf16x8 __attribute__((ext_vector_type(8)));
typedef float f32x4 __attribute__((ext_vector_type(4)));
typedef unsigned u32x4 __attribute__((ext_vector_type(4)));
typedef int i32x4 __attribute__((ext_vector_type(4)));
typedef int i32x8 __attribute__((ext_vector_type(8)));
typedef int i32x16 __attribute__((ext_vector_type(16)));
typedef int i32x32 __attribute__((ext_vector_type(32)));
constexpr int BM = 256, BK = 64, HALF = 128, HTB = HALF * BK * 2  , STAGE_BYTES = 8 * HTB, NXCD = 8, WGM = 8;

__host__ __device__ __forceinline__ int lds_byte(int r, int c) { const int st = (r >> 4) * 2 + (c >> 5), rr = r & 15, cc = c & 31, ob = rr * 64 + cc * 2; return st * 1024 + (ob ^ (((ob >> 9) & 1) << 5)); }
__host__ __device__ __forceinline__ void stage_rc(int b, int& R, int& C) { const int st = b / 1024, sb = b % 1024, swz = sb ^ (((sb >> 9) & 1) << 5); R = (st >> 1) * 16 + swz / 64; C = (st & 1) * 32 + (swz % 64) / 2; }
__host__ __device__ __forceinline__ int perm32(int rho) { const int n = rho >> 4, i = rho & 15; return 8 * (i >> 2) + 4 * n + (i & 3); }

struct Unit { int pm, pn, kind; const char* A; const char* B; const int* rows; };

__device__ __forceinline__ bool static_order(int i, int G, int c, int nM, int nN, int& pm, int& pn) {
    const int nwg = nM * nN; const long L = (long)i * G + c; if (L >= nwg) return false;
    int wgid = (int)L; { const int q = nwg / NXCD, r = nwg % NXCD, xcd = wgid % NXCD, off = wgid / NXCD; wgid = (xcd < r ? xcd * (q + 1) : r * (q + 1) + (xcd - r) * q) + off; }
    const int nig = WGM * nN, gid = wgid / nig, fm = gid * WGM, gsz = (nM - fm) < WGM ? (nM - fm) : WGM;
    pm = fm + ((wgid % nig) % gsz); pn = (wgid % nig) / gsz; return true;
}

__device__ __forceinline__ float clamp8(float x) { return __builtin_amdgcn_fmed3f(x, -448.f, 448.f); }
__device__ __forceinline__ int cvt_fp8x4(float a, float b, float c, float d) { int w = 0; w = __builtin_amdgcn_cvt_pk_fp8_f32(clamp8(a), clamp8(b), w, false); return __builtin_amdgcn_cvt_pk_fp8_f32(clamp8(c), clamp8(d), w, true); }
__device__ __forceinline__ unsigned cvt_pk_bf16(float lo, float hi) { unsigned r; asm volatile("v_cvt_pk_bf16_f32 %0, %1, %2" : "=v"(r) : "v"(lo), "v"(hi)); return r; }

#define PG8_ZERO_INIT __device__ __forceinline__ void init(f32x4 (&acc)[2][2][4][2], const Unit&, int, int, int, int) const { \
        _Pragma("unroll") for (int a = 0; a < 2; ++a) _Pragma("unroll") for (int b = 0; b < 2; ++b) _Pragma("unroll") for (int m = 0; m < 4; ++m) _Pragma("unroll") for (int n = 0; n < 2; ++n) acc[a][b][m][n] = (f32x4){0.f, 0.f, 0.f, 0.f}; }
struct EpiBf16 {
    static constexpr bool PERM = true, AFTER_DRAIN = false;
    bf16_t* O0; int ldc0; bf16_t* O1; int ldc1;
    PG8_ZERO_INIT
    __device__ __forceinline__ void operator()(const f32x4 (&acc)[2][2][4][2], const Unit& u, int wr, int wc, int fr, int fq) const {
        bf16_t* base = u.kind ? O1 : O0; const int ldc = u.kind ? ldc1 : ldc0;
        const int row0 = u.pm * BM + wr * 64 + fr, col0 = u.pn * BM + wc * 32 + 8 * fq;
#pragma unroll
        for (int ai = 0; ai < 2; ++ai)
#pragma unroll
            for (int m = 0; m < 4; ++m) { bf16_t* rowp = base + (size_t)(row0 + ai * HALF + m * 16) * ldc + col0;
#pragma unroll
                for (int bj = 0; bj < 2; ++bj) { const f32x4 v0 = acc[ai][bj][m][0], v1 = acc[ai][bj][m][1];
                    u32x4 w; w.x = cvt_pk_bf16(v0[0], v0[1]); w.y = cvt_pk_bf16(v0[2], v0[3]); w.z = cvt_pk_bf16(v1[0], v1[1]); w.w = cvt_pk_bf16(v1[2], v1[3]);
                    *(u32x4*)(rowp + bj * HALF) = w; } }
    }
};
struct EpiResidX {
    static constexpr bool PERM = false, AFTER_DRAIN = false;
    const float* base; float* out; bf16_t* xb; unsigned char* x8; float* ss; int ldc;
    __device__ __forceinline__ void init(f32x4 (&acc)[2][2][4][2], const Unit& u, int wr, int wc, int fr, int fq) const {
        const int row0 = u.pm * BM + wr * 64 + fr, col0 = u.pn * BM + wc * 32 + 4 * fq;
#pragma unroll
        for (int ai = 0; ai < 2; ++ai)
#pragma unroll
            for (int m = 0; m < 4; ++m) { const size_t off = (size_t)(row0 + ai * HALF + m * 16) * ldc + col0;
#pragma unroll
                for (int bj = 0; bj < 2; ++bj)
#pragma unroll
                    for (int n = 0; n < 2; ++n) acc[ai][bj][m][n] = *(const f32x4*)(base + off + bj * HALF + n * 16); }
    }
    __device__ __forceinline__ void operator()(const f32x4 (&acc)[2][2][4][2], const Unit& u, int wr, int wc, int fr, int fq) const {
        const int row0 = u.pm * BM + wr * 64 + fr, col0 = u.pn * BM + wc * 32 + 4 * fq;
#pragma unroll
        for (int ai = 0; ai < 2; ++ai)
#pragma unroll
            for (int m = 0; m < 4; ++m) { const int row = row0 + ai * HALF + m * 16; const size_t off = (size_t)row * ldc + col0; float sq = 0.f;
#pragma unroll
                for (int bj = 0; bj < 2; ++bj)
#pragma unroll
                    for (int n = 0; n < 2; ++n) { const f32x4 v = acc[ai][bj][m][n]; *(f32x4*)(out + off + bj * HALF + n * 16) = v;
                        sq += (v[0] * v[0] + v[1] * v[1]) + (v[2] * v[2] + v[3] * v[3]);
                        if (xb) { typedef unsigned u32x2 __attribute__((ext_vector_type(2))); u32x2 w; w.x = cvt_pk_bf16(v[0], v[1]); w.y = cvt_pk_bf16(v[2], v[3]); *(u32x2*)(xb + off + bj * HALF + n * 16) = w; }
                        if (x8) *(int*)(x8 + off + bj * HALF + n * 16) = cvt_fp8x4(v[0] * FP8_SX, v[1] * FP8_SX, v[2] * FP8_SX, v[3] * FP8_SX); }
                sq += __shfl_xor(sq, 16); sq += __shfl_xor(sq, 32);
                if (fq == 0) atomicAdd(ss + row, sq); }
    }
};
struct EpiSwiGlu8 {
    static constexpr bool PERM = true, AFTER_DRAIN = false;
    unsigned char* O; int ldc; const float* rs; float si, so;
    PG8_ZERO_INIT
    __device__ __forceinline__ float sw(float g, float u) const { return g * u * __builtin_amdgcn_rcpf(1.0f + __builtin_amdgcn_exp2f(-g * LOG2E)); }
    __device__ __forceinline__ void operator()(const f32x4 (&acc)[2][2][4][2], const Unit& u, int wr, int wc, int fr, int fq) const {
        const int row0 = u.pm * BM + wr * 64 + fr, col0 = u.pn * HALF + wc * 32 + 8 * fq;
#pragma unroll
        for (int ai = 0; ai < 2; ++ai)
#pragma unroll
            for (int m = 0; m < 4; ++m) { const int row = row0 + ai * HALF + m * 16; const float r = rs[row] * si; unsigned char* rowp = O + (size_t)row * ldc + col0;
                const f32x4 g0 = acc[ai][0][m][0] * r, g1 = acc[ai][0][m][1] * r, u0 = acc[ai][1][m][0] * r, u1 = acc[ai][1][m][1] * r;
                const int w0 = cvt_fp8x4(so * sw(g0[0], u0[0]), so * sw(g0[1], u0[1]), so * sw(g0[2], u0[2]), so * sw(g0[3], u0[3]));
                const int w1 = cvt_fp8x4(so * sw(g1[0], u1[0]), so * sw(g1[1], u1[1]), so * sw(g1[2], u1[2]), so * sw(g1[3], u1[3]));
                typedef int i32x2 __attribute__((ext_vector_type(2))); *(i32x2*)rowp = (i32x2){w0, w1}; }
    }
};
struct EpiScaleBf16 {
    static constexpr bool PERM = true, AFTER_DRAIN = false;
    bf16_t* O; int ldc; const float* rowscale; float cs;
    PG8_ZERO_INIT
    __device__ __forceinline__ void operator()(const f32x4 (&acc)[2][2][4][2], const Unit& u, int wr, int wc, int fr, int fq) const {
        const int row0 = u.pm * BM + wr * 64 + fr, col0 = u.pn * BM + wc * 32 + 8 * fq;
#pragma unroll
        for (int ai = 0; ai < 2; ++ai)
#pragma unroll
            for (int m = 0; m < 4; ++m) { const int row = row0 + ai * HALF + m * 16; const float s = rowscale[row] * cs; bf16_t* rowp = O + (size_t)row * ldc + col0;
#pragma unroll
                for (int bj = 0; bj < 2; ++bj) { const f32x4 v0 = acc[ai][bj][m][0] * s, v1 = acc[ai][bj][m][1] * s;
                    u32x4 w; w.x = cvt_pk_bf16(v0[0], v0[1]); w.y = cvt_pk_bf16(v0[2], v0[3]); w.z = cvt_pk_bf16(v1[0], v1[1]); w.w = cvt_pk_bf16(v1[2], v1[3]);
                    *(u32x4*)(rowp + bj * HALF) = w; } }
    }
};

template <class Epi, class Sched, bool FP8 = false, bool ALIGN_EPI = true>
__device__ __forceinline__ void gemm_phase(PG8_LAS unsigned char* lds, const int KB, const int ldbB, const Sched& S, const Epi& E) {
    const int tid = threadIdx.x, wid = __builtin_amdgcn_readfirstlane(tid >> 6), lane = tid & 63, wr = wid >> 2, wc = wid & 3, fr = lane & 15, fq = lane >> 4;
    const int nt = KB / (BK * 2);
    int RA[2], CA[2]; unsigned voffB[2];
#pragma unroll
    for (int i = 0; i < 2; ++i) { int R, C; stage_rc(tid * 16 + i * 8192, R, C); const int Rb = Epi::PERM ? ((R & ~31) + perm32(R & 31)) : R;
        RA[i] = R; CA[i] = C; voffB[i] = (unsigned)(Rb * ldbB + C * 2); }
    const size_t kstep = (size_t)(BK * 2);
    const size_t hstep = (size_t)HALF * ldbB;
    const unsigned ldsw = (unsigned)wid * 1024u;
    const int aoff = lds_byte(wr * 64 + fr, fq * 8), boff = lds_byte(wc * 32 + fr, fq * 8);
#define PG8_SA(b, h) (((b) * 2 + (h)) * HTB)
#define PG8_SB(b, h) ((4 + (b) * 2 + (h)) * HTB)
#define PG8_STAGE(bufoff, gbase, voff) do { _Pragma("unroll") for (int _i = 0; _i < 2; ++_i) \
        __builtin_amdgcn_global_load_lds((const unsigned*)((const char*)(gbase) + (voff)[_i]), (PG8_LAS unsigned*)(lds + (bufoff) + ldsw + _i * 8192), 16, 0, 0); } while (0)
#define PG8_RD(off_) (*(const PG8_LAS i32x4*)(lds + (off_)))
#define PG8_LDA(dst, b, h) do { _Pragma("unroll") for (int m = 0; m < 4; ++m) { \
        if constexpr (FP8) { const i32x4 lo_ = PG8_RD(PG8_SA(b, h) + aoff + m * 2048), hi_ = PG8_RD(PG8_SA(b, h) + aoff + m * 2048 + 1024); _Pragma("unroll") for (int e_ = 0; e_ < 4; ++e_) { dst##8[8 * m + e_] = lo_[e_]; dst##8[8 * m + 4 + e_] = hi_[e_]; } } \
        else { _Pragma("unroll") for (int k = 0; k < 2; ++k) dst[m][k] = *(const PG8_LAS bf16x8*)(lds + PG8_SA(b, h) + aoff + m * 2048 + k * 1024); } } } while (0)
#define PG8_LDB(dst, b, h) do { _Pragma("unroll") for (int n = 0; n < 2; ++n) { \
        if constexpr (FP8) { const i32x4 lo_ = PG8_RD(PG8_SB(b, h) + boff + n * 2048), hi_ = PG8_RD(PG8_SB(b, h) + boff + n * 2048 + 1024); _Pragma("unroll") for (int e_ = 0; e_ < 4; ++e_) { dst##8[8 * n + e_] = lo_[e_]; dst##8[8 * n + 4 + e_] = hi_[e_]; } } \
        else { _Pragma("unroll") for (int k = 0; k < 2; ++k) dst[n][k] = *(const PG8_LAS bf16x8*)(lds + PG8_SB(b, h) + boff + n * 2048 + k * 1024); } } } while (0)
#define PG8_SUB8(v, i) ((i32x8){v[8 * (i)], v[8 * (i) + 1], v[8 * (i) + 2], v[8 * (i) + 3], v[8 * (i) + 4], v[8 * (i) + 5], v[8 * (i) + 6], v[8 * (i) + 7]})
#define PG8_MMA(ai, bj, At, Bt) do { __builtin_amdgcn_s_setprio(1); _Pragma("unroll") for (int m = 0; m < 4; ++m) _Pragma("unroll") for (int n = 0; n < 2; ++n) { \
        if constexpr (FP8) asm volatile("s_nop 1\n\tv_mfma_scale_f32_16x16x128_f8f6f4 %0, %1, %2, %0, %3, %3 op_sel_hi:[0,0,0]" : "+v"(acc[ai][bj][m][n]) : "v"(PG8_SUB8(Bt##8, n)), "v"(PG8_SUB8(At##8, m)), "v"(sc1)); \
        else { _Pragma("unroll") for (int k = 0; k < 2; ++k) acc[ai][bj][m][n] = __builtin_amdgcn_mfma_f32_16x16x32_bf16(Bt[n][k], At[m][k], acc[ai][bj][m][n], 0, 0, 0); } } \
        __builtin_amdgcn_s_setprio(0); } while (0)
#define PG8_WAIT_V(n) asm volatile("s_waitcnt vmcnt(" #n ")" ::: "memory")
#define PG8_WAIT_L(n) asm volatile("s_waitcnt lgkmcnt(" #n ")" ::: "memory")
#define PG8_BAR __builtin_amdgcn_s_barrier()
#define PG8_SCHED __builtin_amdgcn_sched_barrier(0)
    Unit cur, nxt; int ui = 0;
    if (!S.next(0, cur)) return;
    unsigned vAc[2][2], vAn[2][2];
    S.a_offs(cur, RA, CA, vAc);
    f32x4 acc[2][2][4][2];
    E.init(acc, cur, wr, wc, fr, fq);
    const int sc1 = 0x7F7F7F7F;
    bf16x8 At[4][2], B0[2][2], B1[2][2]; i32x32 At8; i32x16 B08, B18;
    const char* cA = cur.A; const char* cB = cur.B;
    PG8_STAGE(PG8_SB(0, 0), cB, voffB); PG8_STAGE(PG8_SB(0, 1), cB + hstep, voffB); PG8_STAGE(PG8_SA(0, 0), cA, vAc[0]); PG8_STAGE(PG8_SA(0, 1), cA, vAc[1]);
    if (wr == 1) PG8_BAR;
    PG8_WAIT_V(2); PG8_BAR;
    PG8_STAGE(PG8_SB(1, 0), cB + kstep, voffB); PG8_STAGE(PG8_SA(1, 0), cA + kstep, vAc[0]); PG8_STAGE(PG8_SB(1, 1), cB + hstep + kstep, voffB);
    PG8_WAIT_V(6); PG8_BAR;
    for (;;) {
        const bool has_next = S.next(ui + 1, nxt);
        const char* nA = has_next ? nxt.A : cA; const char* nB = has_next ? nxt.B : cB;
        if (Sched::GATHER && has_next) S.a_offs(nxt, RA, CA, vAn);
        else {
#pragma unroll
            for (int h = 0; h < 2; ++h)
#pragma unroll
                for (int i = 0; i < 2; ++i) vAn[h][i] = vAc[h][i]; }
        for (int t = 0; t < nt; t += 2) {
            const bool last = (t == nt - 2);
            const char* a1 = cA + (size_t)(t + 1) * kstep;
            const char* a2 = last ? nA : cA + (size_t)(t + 2) * kstep; const char* b2 = last ? nB : cB + (size_t)(t + 2) * kstep;
            const char* a3 = a2 + kstep; const char* b3 = b2 + kstep;
            unsigned o2[2][2];
#pragma unroll
            for (int h = 0; h < 2; ++h)
#pragma unroll
                for (int i = 0; i < 2; ++i) o2[h][i] = (Sched::GATHER && last) ? vAn[h][i] : vAc[h][i];
            if (last && has_next) S.a_ready(nxt);
            PG8_LDB(B0, 0, 0); PG8_LDB(B1, 0, 1); PG8_SCHED; PG8_LDA(At, 0, 0); PG8_STAGE(PG8_SA(1, 1), a1, vAc[1]);
            PG8_WAIT_V(8); PG8_WAIT_L(0); PG8_BAR; PG8_MMA(0, 0, At, B0); PG8_MMA(0, 1, At, B1); PG8_BAR; PG8_SCHED;
            PG8_LDA(At, 0, 1); PG8_STAGE(PG8_SB(0, 0), b2, voffB); PG8_STAGE(PG8_SB(0, 1), b2 + hstep, voffB); PG8_STAGE(PG8_SA(0, 0), a2, o2[0]);
            PG8_WAIT_V(8); PG8_WAIT_L(0); PG8_BAR; PG8_MMA(1, 0, At, B0); PG8_MMA(1, 1, At, B1); PG8_BAR; PG8_SCHED;
            PG8_LDB(B0, 1, 0); PG8_LDB(B1, 1, 1); PG8_SCHED; PG8_LDA(At, 1, 0); PG8_STAGE(PG8_SA(0, 1), a2, o2[1]);
            PG8_WAIT_V(8); PG8_WAIT_L(0); PG8_BAR; PG8_MMA(0, 0, At, B0); PG8_MMA(0, 1, At, B1); PG8_BAR; PG8_SCHED;
            PG8_LDA(At, 1, 1); PG8_STAGE(PG8_SB(1, 0), b3, voffB); PG8_STAGE(PG8_SB(1, 1), b3 + hstep, voffB); PG8_STAGE(PG8_SA(1, 0), a3, o2[0]);
            PG8_WAIT_V(8); PG8_WAIT_L(0); PG8_BAR; PG8_MMA(1, 0, At, B0); PG8_MMA(1, 1, At, B1); PG8_BAR; PG8_SCHED;
        }
        if constexpr (ALIGN_EPI) { if (wr == 0) PG8_BAR; }
        if constexpr (FP8) asm volatile("s_nop 15\n\ts_nop 15" ::: "memory");
        E(acc, cur, wr, wc, fr, fq); S.done(cur);
        if (!has_next) break;
        E.init(acc, nxt, wr, wc, fr, fq);
        cur = nxt; cA = nA; cB = nB; ++ui;
#pragma unroll
        for (int h = 0; h < 2; ++h)
#pragma unroll
            for (int i = 0; i < 2; ++i) vAc[h][i] = vAn[h][i];
        if constexpr (ALIGN_EPI) { if (wr == 1) PG8_BAR; }
    }
    PG8_WAIT_V(0);
    if constexpr (!ALIGN_EPI) { if (wr == 0) PG8_BAR; }
    PG8_BAR;
#undef PG8_SA
#undef PG8_SB
#undef PG8_STAGE
#undef PG8_LDA
#undef PG8_LDB
#undef PG8_MMA
#undef PG8_WAIT_V
#undef PG8_WAIT_L
#undef PG8_BAR
#undef PG8_SCHED
}
}

#define GAS __attribute__((address_space(1)))
#define LAS __attribute__((address_space(3)))
typedef unsigned short bf16;
typedef unsigned v4u __attribute__((ext_vector_type(4)));
typedef float f32x4 __attribute__((ext_vector_type(4)));
typedef short bf16x8 __attribute__((ext_vector_type(8)));
typedef GAS unsigned gu32;
typedef GAS unsigned long long gu64;
#define RLX_AGENT __ATOMIC_RELAXED, __HIP_MEMORY_SCOPE_AGENT
#define LDS_WAIT() asm volatile("s_waitcnt lgkmcnt(0)" ::: "memory")
#define VM_WAIT() asm volatile("s_waitcnt vmcnt(0)" ::: "memory")
__device__ __forceinline__ unsigned long long rt() { return __builtin_amdgcn_s_memrealtime(); }
__device__ __forceinline__ unsigned f2bf(float f) { unsigned u = __builtin_bit_cast(unsigned, f); return (u + 0x7fffu + ((u >> 16) & 1u)) >> 16; }
__device__ __forceinline__ unsigned pk2(float lo, float hi) { return f2bf(lo) | (f2bf(hi) << 16); }

#define XB_TMO      128
#define XB_XCNT(j)  (256  + 64 * (j))
#define XB_XSUB(j)  (1280 + 64 * (j))
#define XB_XGEN(j)  (2304 + 64 * (j))
#define XB_TOP      3328
#define XB_TOPGEN   3392
#define XCD_BAR_WORDS 3456
#define XB_SPIN_CAP (1u << 18)

__device__ __forceinline__ unsigned xb_ld(unsigned* p)              { return __hip_atomic_load(p, __ATOMIC_RELAXED, __HIP_MEMORY_SCOPE_AGENT); }
__device__ __forceinline__ unsigned xb_add(unsigned* p, unsigned v) { return __hip_atomic_fetch_add(p, v, __ATOMIC_RELAXED, __HIP_MEMORY_SCOPE_AGENT); }
__device__ __forceinline__ unsigned xb_xcc_id() { return (unsigned)__builtin_amdgcn_s_getreg((3 << 11) | 20) & 0xFu; }
#define XB_SPIN(cond, bar) do { unsigned _sp = 0; while (cond) { __builtin_amdgcn_s_sleep(1); \
    if ((++_sp & 255u) == 0u) { if (xb_ld(&(bar)[XB_TMO])) break; if (_sp > XB_SPIN_CAP) { atomicAdd(&(bar)[XB_TMO], 1u); break; } } } } while (0)

struct XcdBarrier {
    unsigned* bar; unsigned x;
    volatile LAS unsigned* st;
};

__device__ __forceinline__ XcdBarrier xcd_barrier_post(unsigned* bar, volatile LAS unsigned* st) {
    XcdBarrier b; b.bar = bar; b.x = xb_xcc_id(); b.st = st;
    if (threadIdx.x == 0) (void)xb_add(&bar[XB_XCNT(b.x)], 1u);
    return b;
}
__device__ __forceinline__ void xcd_barrier_complete(unsigned* bar, unsigned x, unsigned& nloc, unsigned& nx) {
    const unsigned G = gridDim.x * gridDim.y * gridDim.z;
    unsigned sum, cnt, mine, sp = 0u;
    for (;;) {
        sum = 0u; cnt = 0u; mine = 0u;
#pragma unroll
        for (unsigned j = 0; j < 16; ++j) { const unsigned c = xb_ld(&bar[XB_XCNT(j)]); sum += c; cnt += (c > 0u) ? 1u : 0u; mine = (j == x) ? c : mine; }
        if (sum == G) break;
        __builtin_amdgcn_s_sleep(1);
        if ((++sp & 255u) == 0u) { if (xb_ld(&bar[XB_TMO])) break; if (sp > XB_SPIN_CAP) { atomicAdd(&bar[XB_TMO], 1u); break; } }
    }
    nloc = mine > 0u ? mine : 1u; nx = cnt > 0u ? cnt : 1u;
}

__device__ __forceinline__ void xcd_barrier(const XcdBarrier& b) {
    asm volatile("s_waitcnt vmcnt(0)" ::: "memory");
    __syncthreads();
    if (threadIdx.x == 0) {
        unsigned* bar = b.bar;
        __builtin_amdgcn_s_waitcnt(0);
        unsigned nloc = b.st[0], nx = b.st[1];
        if (nloc == 0u) { xcd_barrier_complete(bar, b.x, nloc, nx); b.st[0] = nloc; b.st[1] = nx; }
        const unsigned old = xb_add(&bar[XB_XSUB(b.x)], 1u);
        const unsigned gen = old / nloc;
        if (old + 1u == (gen + 1u) * nloc) {
            __builtin_amdgcn_fence(__ATOMIC_RELEASE, "agent");
            asm volatile("s_waitcnt vmcnt(0)" ::: "memory");
            const unsigned og = xb_add(&bar[XB_TOP], 1u);
            const unsigned tg = og / nx;
            if (og + 1u == (tg + 1u) * nx) xb_add(&bar[XB_TOPGEN], 1u);
            else XB_SPIN(xb_ld(&bar[XB_TOPGEN]) == tg, bar);
            __builtin_amdgcn_fence(__ATOMIC_ACQUIRE, "agent");
            xb_add(&bar[XB_XGEN(b.x)], 1u);
            asm volatile("s_waitcnt vmcnt(0)" ::: "memory");
        } else {
            XB_SPIN(xb_ld(&bar[XB_XGEN(b.x)]) == gen, bar);
            __builtin_amdgcn_fence(__ATOMIC_ACQUIRE, "agent");
            asm volatile("s_waitcnt vmcnt(0)" ::: "memory");
        }
    }
    __syncthreads();
}


constexpr size_t MiB = 1u << 20;
constexpr size_t WS_CTL = 0, CTL_ZERO_BYTES = 1 * MiB;
constexpr size_t WS_WIN = 1 * MiB;
constexpr size_t WS_WOUT = 19 * MiB;
constexpr size_t WS_WQM = 27 * MiB;
constexpr size_t WS_WKV = 29 * MiB;
constexpr size_t WS_WOM = 33 * MiB;
constexpr size_t WS_WGU = 35 * MiB;
constexpr size_t WS_WD = 291 * MiB;
constexpr size_t WS_XN = 419 * MiB;
constexpr size_t WS_MEMN = 451 * MiB;
constexpr size_t WS_PROJ = 453 * MiB;
constexpr size_t WS_KVM = 525 * MiB;
constexpr size_t WS_OPART = 526 * MiB;
constexpr size_t WS_OB = 574 * MiB;
constexpr size_t WS_LPART = 590 * MiB;
constexpr size_t WS_MIXED = 591 * MiB;
constexpr size_t WS_X1 = 623 * MiB;
constexpr size_t WS_QM = 687 * MiB;
constexpr size_t WS_OM = 695 * MiB;
constexpr size_t WS_AFF = 703 * MiB;
constexpr size_t WS_IDX = 704 * MiB;
constexpr size_t WS_GATE = 704 * MiB + 65536;
constexpr size_t WS_INV = 704 * MiB + 131072;
constexpr size_t WS_RS = 704 * MiB + 655360;
constexpr size_t WS_SS1 = 65536, WS_SS2 = 131072;
constexpr size_t WS_XE = 705 * MiB;
constexpr size_t WS_ACT = 769 * MiB;
constexpr size_t WS_YS = 833 * MiB;
constexpr size_t WS_X2 = 897 * MiB;
constexpr size_t WS_END = 961 * MiB;
constexpr int CW_BAR = 4096;

constexpr int RING_BYTES = 131072;
constexpr int LDSCTL_OFF = RING_BYTES, MISC_OFF = LDSCTL_OFF + 320;
constexpr int LDS_BYTES = 147456;
constexpr int NWAVES = 8, NTHREADS = 512;

typedef unsigned v2u __attribute__((ext_vector_type(2)));
typedef float f32x2 __attribute__((ext_vector_type(2)));
typedef __bf16 bf16x2_t __attribute__((ext_vector_type(2)));
__device__ __forceinline__ unsigned cvtpk(float lo, float hi) { f32x2 v = {lo, hi}; bf16x2_t b = __builtin_convertvector(v, bf16x2_t); return __builtin_bit_cast(unsigned, b); }
__device__ __forceinline__ float bflo(unsigned w) { return __uint_as_float(w << 16); }
__device__ __forceinline__ float bfhi(unsigned w) { return __uint_as_float(w & 0xffff0000u); }
__device__ __forceinline__ float bf2f(unsigned short h) { return __uint_as_float((unsigned)h << 16); }
__device__ __forceinline__ float wave_sum(float v) {
#pragma unroll
    for (int o = 1; o < 64; o <<= 1) v += __shfl_xor(v, o);
    return v;
}
__device__ __forceinline__ float wave_max(float v) {
#pragma unroll
    for (int o = 1; o < 64; o <<= 1) v = fmaxf(v, __shfl_xor(v, o));
    return v;
}
__device__ __forceinline__ float gain_absmax(const float* g, int lane) { return wave_max(fmaxf(fabsf(g[lane]), fabsf(g[lane + 64]))); }

struct CvtTile { const float* src; bf16* dst; const float* gk; int N, K, mode, k0, n0, fp8; };
constexpr int T_IN = 16 * 18, T_OUT = 16 * 8, T_QM = 16 * 2, T_KV = 16 * 4, T_OM = 4 * 8, T_EXP = 16 * 128;
constexpr int T_TOTAL = T_IN + T_OUT + T_QM + T_KV + T_OM + 3 * T_EXP;
template <class A_> __device__ __forceinline__ CvtTile cvt_decode(int it, const A_& args, unsigned char* ws) {
    CvtTile t; int r = it; t.gk = nullptr; t.fp8 = 0;
    if (r < T_IN) { t.src = args.in[4]; t.dst = (bf16*)(ws + WS_WIN); t.N = DIN; t.K = DM; t.mode = 0; t.k0 = (r / 18) * 128; t.n0 = (r % 18) * 256; return t; } r -= T_IN;
    if (r < T_KV) { t.src = args.in[16]; t.dst = (bf16*)(ws + WS_WKV); t.N = 2 * WMEM; t.K = DM; t.mode = 0; t.k0 = (r / 4) * 128; t.n0 = (r % 4) * 256; return t; } r -= T_KV;
    if (r < T_OUT) { t.src = args.in[12]; t.dst = (bf16*)(ws + WS_WOUT); t.N = DM; t.K = DM; t.mode = 0; t.k0 = (r / 8) * 128; t.n0 = (r % 8) * 256; return t; } r -= T_OUT;
    if (r < T_QM) { t.src = args.in[15]; t.gk = args.in[13]; t.dst = (bf16*)(ws + WS_WQM); t.N = WMEM; t.K = DM; t.mode = 0; t.k0 = (r / 2) * 128; t.n0 = (r % 2) * 256; return t; } r -= T_QM;
    if (r < T_OM) { t.src = args.in[19]; t.dst = (bf16*)(ws + WS_WOM); t.N = DM; t.K = WMEM; t.mode = 0; t.k0 = (r / 8) * 128; t.n0 = (r % 8) * 256; return t; } r -= T_OM;
    const int which = r / T_EXP; r -= which * T_EXP; const int e = r / 128, rr = r % 128; t.fp8 = 1;
    t.N = DM; t.K = DM; t.k0 = (rr / 8) * 128; t.n0 = (rr % 8) * 256;
    if (which < 2) t.gk = args.in[20];
    if (which == 0) { t.src = args.in[22] + (size_t)e * DM * DFF; t.dst = (bf16*)(ws + WS_WGU + (size_t)e * 2 * DFF * DM); t.mode = 1; }
    else if (which == 1) { t.src = args.in[23] + (size_t)e * DM * DFF; t.dst = (bf16*)(ws + WS_WGU + (size_t)e * 2 * DFF * DM); t.mode = 2; }
    else { t.src = args.in[24] + (size_t)e * DFF * DM; t.dst = (bf16*)(ws + WS_WD + (size_t)e * DM * DFF); t.mode = 0; }
    return t;
}
#define CVT_ISSUE(v, t) do { const float* p_ = (t).src + (size_t)((t).k0 + 4 * (tid >> 6)) * (t).N + (t).n0 + 4 * (tid & 63); \
    _Pragma("unroll") for (int ps_ = 0; ps_ < 4; ++ps_) _Pragma("unroll") for (int r_ = 0; r_ < 4; ++r_) v[ps_ * 4 + r_] = *(const GAS f32x4*)(p_ + (size_t)(32 * ps_ + r_) * (t).N); } while (0)
__device__ __forceinline__ void cvt_to_lds(const f32x4 (&v)[16], const float* gk, int k0, LAS unsigned char* lds, int tid) {
    const int c = tid & 63, kg = tid >> 6, f = c & 15;
#pragma unroll
    for (int ps = 0; ps < 4; ++ps) { const int kch = 8 * ps + kg;
        f32x4 gq = (f32x4){1.f, 1.f, 1.f, 1.f}; if (gk) gq = *(const GAS f32x4*)(gk + k0 + 32 * ps + 4 * kg);
#pragma unroll
        for (int j = 0; j < 4; ++j) { v2u w; w.x = cvtpk(v[ps * 4 + 0][j] * gq.x, v[ps * 4 + 1][j] * gq.y); w.y = cvtpk(v[ps * 4 + 2][j] * gq.z, v[ps * 4 + 3][j] * gq.w);
            *(LAS v2u*)(lds + (4 * c + j) * 256 + ((kch ^ f) * 8)) = w; } }
}
__device__ __forceinline__ void cvt_to_lds8(const f32x4 (&v)[16], const float* gk, int k0, LAS unsigned char* lds, int tid) {
    const int c = tid & 63, kg = tid >> 6, f = c & 7;
#pragma unroll
    for (int ps = 0; ps < 4; ++ps) { const int kch = 8 * ps + kg;
        f32x4 gq = (f32x4){FP8_SW, FP8_SW, FP8_SW, FP8_SW}; if (gk) gq = *(const GAS f32x4*)(gk + k0 + 32 * ps + 4 * kg) * FP8_SW;
#pragma unroll
        for (int j = 0; j < 4; ++j) { const int w = pg8::cvt_fp8x4(v[ps * 4 + 0][j] * gq.x, v[ps * 4 + 1][j] * gq.y, v[ps * 4 + 2][j] * gq.z, v[ps * 4 + 3][j] * gq.w);
            *(LAS int*)(lds + (4 * c + j) * 128 + (((kch >> 2) ^ f) * 16) + (kch & 3) * 4) = w; } }
}
__device__ __forceinline__ void cvt_store8(const CvtTile& t, LAS unsigned char* lds, int tid) {
    const int q = tid & 7;
#pragma unroll
    for (int ps = 0; ps < 4; ++ps) { const int n = (tid >> 3) + 64 * ps, f = (n >> 2) & 7; const v4u w = *(LAS v4u*)(lds + n * 128 + ((q ^ f) * 16));
        const int nn = t.n0 + n; const int drow = t.mode == 0 ? nn : ((nn >> 7) * 256 + (nn & 127) + (t.mode == 2 ? 128 : 0));
        *(GAS v4u*)((unsigned char*)t.dst + (size_t)drow * t.K + t.k0 + 16 * q) = w; }
}
__device__ __forceinline__ void cvt_store(const CvtTile& t, LAS unsigned char* lds, int tid) {
    const int q = tid & 15;
#pragma unroll
    for (int ps = 0; ps < 8; ++ps) { const int n = (tid >> 4) + 32 * ps, f = (n >> 2) & 15; v4u w = *(LAS v4u*)(lds + n * 256 + ((q ^ (f >> 1)) * 16));
        if (f & 1) { const unsigned a = w.x, b = w.y; w.x = w.z; w.y = w.w; w.z = a; w.w = b; }
        const int nn = t.n0 + n; const int drow = t.mode == 0 ? nn : ((nn >> 7) * 256 + (nn & 127) + (t.mode == 2 ? 128 : 0));
        *(GAS v4u*)(t.dst + (size_t)drow * t.K + t.k0 + 8 * q) = w; }
}
#define CONVERT_RANGE(t0_, t1_, j_, n_) do { f32x4 v_[16]; int it_ = (t0_) + (j_); bool have_ = it_ < (t1_); CvtTile cur_ = cvt_decode(have_ ? it_ : 0, args, ws); \
        if (have_) CVT_ISSUE(v_, cur_); \
        while (have_) { __syncthreads(); if (cur_.fp8) cvt_to_lds8(v_, cur_.gk, cur_.k0, lds, tid); else cvt_to_lds(v_, cur_.gk, cur_.k0, lds, tid); \
            it_ += (n_); const bool hn_ = it_ < (t1_); const CvtTile nxt_ = cvt_decode(hn_ ? it_ : 0, args, ws); \
            if (hn_) CVT_ISSUE(v_, nxt_); \
            LDS_WAIT(); __syncthreads(); if (cur_.fp8) cvt_store8(cur_, lds, tid); else cvt_store(cur_, lds, tid); cur_ = nxt_; have_ = hn_; } \
        __syncthreads(); } while (0)
__device__ __forceinline__ void norm_row_bf16(const float* xrow, const float* g, bf16* orow, int lane) {
    f32x4 v[8]; float ss = 0.f;
#pragma unroll
    for (int j = 0; j < 8; ++j) { v[j] = *(const GAS f32x4*)(xrow + lane * 4 + 256 * j); ss += (v[j].x * v[j].x + v[j].y * v[j].y) + (v[j].z * v[j].z + v[j].w * v[j].w); }
    const float rstd = 1.0f / sqrtf(wave_sum(ss) * (1.0f / DM) + EPS);
#pragma unroll
    for (int j = 0; j < 8; ++j) { const f32x4 gg = *(const GAS f32x4*)(g + lane * 4 + 256 * j); v2u w; w.x = cvtpk(v[j].x * rstd * gg.x, v[j].y * rstd * gg.y); w.y = cvtpk(v[j].z * rstd * gg.z, v[j].w * rstd * gg.w);
        *(GAS v2u*)(orow + lane * 4 + 256 * j) = w; }
}

namespace att {
typedef short s16x4 __attribute__((ext_vector_type(4)));
typedef float f32x16 __attribute__((ext_vector_type(16)));
constexpr int VBUF = 32768, TILEB = 16384, STG_PITCH = 272, STG_W = 32 * STG_PITCH, WSF = 8 * STG_W;
__device__ __forceinline__ int crow(int r, int hi) { return (r & 3) + 8 * (r >> 2) + 4 * hi; }
__device__ __forceinline__ s16x4 vtr(const LAS unsigned char* p) { return __builtin_bit_cast(s16x4, __builtin_amdgcn_ds_read_tr16_b64_v4i16((LAS s16x4*)p)); }
template <bool MASK, bool QNORM, bool NORMALIZE>
__device__ __forceinline__ void attn_unit(LAS unsigned char* lds, const bf16* qw, long q_stride, const bf16* k0, const bf16* v0, long kv_stride,
                                          int tlo, int thi, int a, int half, float negM2, float l_extra, bf16* ow, long o_stride, float* lw, long l_stride, const float* ssrow) {
    int tid_ = threadIdx.x; asm volatile("" : "+v"(tid_));
    const int tid = tid_, lane = tid & 63, c = lane & 31, hi = lane >> 5, wid = __builtin_amdgcn_readfirstlane(tid >> 6);
    bf16x8 qf[8];
    { const bf16* qp = qw + (long)c * q_stride + 8 * hi;
#pragma unroll
      for (int ks = 0; ks < 8; ++ks) qf[ks] = *(const GAS bf16x8*)(qp + 16 * ks); }
    float qs = 1.f;
    if (QNORM) { float ss = 0.f;
#pragma unroll
        for (int ks = 0; ks < 8; ++ks)
#pragma unroll
            for (int j = 0; j < 8; ++j) { const float f = bf2f((unsigned short)qf[ks][j]); ss += f * f; }
        ss += __shfl_xor(ss, 32); const float r1 = 1.0f / sqrtf(ssrow[c] * (1.0f / DM) + EPS);
        qs = QSCALE * r1 / sqrtf(r1 * r1 * ss * (1.0f / HD) + EPS); }
    const int srow = tid >> 4, sch = tid & 15;
    const bf16* kg = k0 + (long)srow * kv_stride + (sch ^ (srow & 15)) * 8; const bf16* vg = v0 + (long)srow * kv_stride + (sch ^ (((srow & 3) << 2) | ((srow >> 2) & 3))) * 8;
    const unsigned ldsw = (unsigned)wid * 1024u;
    const unsigned kbase = c * 256; const int cx = c & 15;
    const int q4 = (lane & 15) >> 2, p = lane & 3, g = (lane >> 4) & 1;
    unsigned vb[4][2];
#pragma unroll
    for (int db = 0; db < 4; ++db)
#pragma unroll
        for (int u = 0; u < 2; ++u) vb[db][u] = VBUF + 256 * (4 * hi + 8 * u + q4) + 16 * ((((db ^ q4)) << 2) | ((g ^ u) << 1) | ((p >> 1) ^ hi)) + 8 * (p & 1);
    f32x16 o[4];
#pragma unroll
    for (int db = 0; db < 4; ++db)
#pragma unroll
        for (int r = 0; r < 16; ++r) o[db][r] = 0.f;
    float lsum = 0.f;
#define AT_ISSUE(t, bw) do { const long r_ = (long)(t) * 64; \
        __builtin_amdgcn_global_load_lds((const unsigned*)(kg + r_ * kv_stride), (LAS unsigned*)(lds + (bw) * TILEB + ldsw), 16, 0, 0); \
        __builtin_amdgcn_global_load_lds((const unsigned*)(kg + (r_ + 32) * kv_stride), (LAS unsigned*)(lds + (bw) * TILEB + 8192 + ldsw), 16, 0, 0); \
        __builtin_amdgcn_global_load_lds((const unsigned*)(vg + r_ * kv_stride), (LAS unsigned*)(lds + VBUF + (bw) * TILEB + ldsw), 16, 0, 0); \
        __builtin_amdgcn_global_load_lds((const unsigned*)(vg + (r_ + 32) * kv_stride), (LAS unsigned*)(lds + VBUF + (bw) * TILEB + 8192 + ldsw), 16, 0, 0); } while (0)
    AT_ISSUE(tlo, 0); VM_WAIT(); __syncthreads();
    for (int t = tlo; t < thi; ++t) {
        const int buf = (t - tlo) & 1; const bool more = (t + 1 < thi);
        if (more) AT_ISSUE(t + 1, buf ^ 1);
        const bool need = !MASK || ((64 * t + 63 >= a - half) && (64 * t <= a + 31 + half));
        if (need) {
            const LAS unsigned char* kt = lds + buf * TILEB + kbase; const LAS unsigned char* vt = lds + buf * TILEB;
            const float ini = QNORM ? 0.f : negM2;
            const int jb = 64 * t + 4 * hi - (a + c);
            v4u pw[4];
#pragma unroll
            for (int kb = 0; kb < 2; ++kb) {
                f32x16 pp;
#pragma unroll
                for (int r = 0; r < 16; ++r) pp[r] = ini;
#pragma unroll
                for (int ks = 0; ks < 8; ++ks) { const int off = 16 * ((2 * ks + hi) ^ cx) + 8192 * kb;
                    const bf16x8 ka = *(const LAS bf16x8*)(kt + off);
                    pp = __builtin_amdgcn_mfma_f32_32x32x16_bf16(ka, qf[ks], pp, 0, 0, 0); }
#pragma unroll
                for (int r = 0; r < 16; ++r) {
                    float e0 = QNORM ? __builtin_amdgcn_exp2f(__builtin_fmaf(pp[r], qs, negM2)) : __builtin_amdgcn_exp2f(pp[r]);
                    if (MASK) { const int d0 = jb + 32 * kb + (r & 3) + 8 * (r >> 2); if ((unsigned)(d0 + half) > (unsigned)(2 * half)) e0 = 0.f; }
                    pp[r] = e0; lsum += e0; }
                pw[2 * kb] = (v4u){cvtpk(pp[0], pp[1]), cvtpk(pp[2], pp[3]), cvtpk(pp[4], pp[5]), cvtpk(pp[6], pp[7])};
                pw[2 * kb + 1] = (v4u){cvtpk(pp[8], pp[9]), cvtpk(pp[10], pp[11]), cvtpk(pp[12], pp[13]), cvtpk(pp[14], pp[15])};
            }
#pragma unroll
            for (int db = 0; db < 4; ++db)
#pragma unroll
                for (int sp = 0; sp < 4; ++sp) { const int imm = 8192 * (sp >> 1) + 4096 * (sp & 1);
                    const s16x4 lo = vtr(vt + vb[db][0] + imm), hv = vtr(vt + vb[db][1] + imm);
                    const bf16x8 vf = (bf16x8){lo[0], lo[1], lo[2], lo[3], hv[0], hv[1], hv[2], hv[3]};
                    o[db] = __builtin_amdgcn_mfma_f32_32x32x16_bf16(__builtin_bit_cast(bf16x8, pw[sp]), vf, o[db], 0, 0, 0); }
        }
        VM_WAIT(); __syncthreads();
    }
#undef AT_ISSUE
    lsum += __shfl_xor(lsum, 32); lsum += l_extra;
    LAS float* wsf = (LAS float*)(lds + WSF + wid * 256);
    if (NORMALIZE) { if (hi == 0) wsf[c] = 1.0f / lsum; } else { if (hi == 0) lw[(long)c * l_stride] = lsum; }
    LDS_WAIT();
    LAS unsigned char* stg = lds + wid * STG_W;
#pragma unroll
    for (int r = 0; r < 16; ++r) { const int row = crow(r, hi); const float sc = NORMALIZE ? wsf[row] : 1.0f;
#pragma unroll
        for (int db = 0; db < 4; ++db) *(LAS unsigned short*)(stg + row * STG_PITCH + (32 * db + c) * 2) = (unsigned short)f2bf(o[db][r] * sc); }
    LDS_WAIT();
#pragma unroll
    for (int i = 0; i < 8; ++i) { const int row = 4 * i + (lane >> 4), ch = lane & 15; const v4u w = *(const LAS v4u*)(stg + row * STG_PITCH + ch * 16);
        *(GAS v4u*)(ow + (long)row * o_stride + ch * 8) = w; }
    LDS_WAIT();
    __syncthreads();
}
}

#define PLAIN_A_OFFS(lda_) static constexpr bool GATHER = false; __device__ __forceinline__ void a_offs(const pg8::Unit&, const int (&RA)[2], const int (&CA)[2], unsigned (&vA)[2][2]) const { \
        _Pragma("unroll") for (int h = 0; h < 2; ++h) _Pragma("unroll") for (int i = 0; i < 2; ++i) vA[h][i] = (unsigned)((h * 128 + RA[i]) * (lda_) + CA[i] * 2); }
struct OrderP1 {
    int G, c; const char* XN; const char* WIN; const char* MEMN; const char* WKV;
    __device__ __forceinline__ bool next(int i, pg8::Unit& u) const {
        int pm, pn; u.rows = nullptr;
        if (pg8::static_order(i, G, c, 32, 18, pm, pn)) { u.pm = pm; u.pn = pn; u.kind = 0; u.A = XN + (size_t)pm * 256 * DM * 2; u.B = WIN + (size_t)pn * 256 * DM * 2; return true; }
        const long L = (long)i * G + c - 576; if (L < 0 || L >= 8) return false;
        u.pm = (int)L >> 2; u.pn = (int)L & 3; u.kind = 1; u.A = MEMN + (size_t)u.pm * 256 * DM * 2; u.B = WKV + (size_t)u.pn * 256 * DM * 2; return true;
    }
    PLAIN_A_OFFS(DM * 2)
    __device__ __forceinline__ void a_ready(const pg8::Unit&) const {}
    __device__ __forceinline__ void done(const pg8::Unit&) const {}
};
struct OrderPlain {
    int G, c, nM, nN, KB; const char* A; const char* B;
    __device__ __forceinline__ bool next(int i, pg8::Unit& u) const {
        int pm, pn; if (!pg8::static_order(i, G, c, nM, nN, pm, pn)) return false;
        u.pm = pm; u.pn = pn; u.kind = 0; u.rows = nullptr; u.A = A + (size_t)pm * 256 * KB; u.B = B + (size_t)pn * 256 * KB; return true;
    }
    PLAIN_A_OFFS(KB)
    __device__ __forceinline__ void a_ready(const pg8::Unit&) const {}
    __device__ __forceinline__ void done(const pg8::Unit&) const {}
};
struct OrderMoe {
    int G, c, nN, KB; const char* A; const char* B;
    __device__ __forceinline__ bool next(int i, pg8::Unit& u) const {
        int pm, pn; if (!pg8::static_order(i, G, c, 64, nN, pm, pn)) return false;
        u.pm = pm; u.pn = pn; u.kind = 0; u.rows = nullptr; u.A = A + (size_t)pm * 256 * KB; u.B = B + ((size_t)(pm >> 2) * nN + pn) * 256 * KB; return true;
    }
    PLAIN_A_OFFS(KB)
    __device__ __forceinline__ void a_ready(const pg8::Unit&) const {}
    __device__ __forceinline__ void done(const pg8::Unit&) const {}
};
struct OrderMoeG {
    static constexpr bool GATHER = true; int G, c; const char* X; const char* B; const int* idx;
    __device__ __forceinline__ bool next(int i, pg8::Unit& u) const {
        int pm, pn; if (!pg8::static_order(i, G, c, 64, 16, pm, pn)) return false;
        u.pm = pm; u.pn = pn; u.kind = 0; u.rows = idx + pm * 256; u.A = X + (size_t)((pm >> 1) & 1) * SEQ * DM; u.B = B + ((size_t)(pm >> 2) * 16 + pn) * 256 * DM; return true;
    }
    __device__ __forceinline__ void a_offs(const pg8::Unit& u, const int (&RA)[2], const int (&CA)[2], unsigned (&vA)[2][2]) const {
#pragma unroll
        for (int h = 0; h < 2; ++h)
#pragma unroll
            for (int i = 0; i < 2; ++i) vA[h][i] = (unsigned)(u.rows[h * 128 + RA[i]] * DM + CA[i] * 2); }
    __device__ __forceinline__ void a_ready(const pg8::Unit&) const {}
    __device__ __forceinline__ void done(const pg8::Unit&) const {}
};

constexpr int NPHASE = 16;
struct Args { const float* in[25]; float* out; unsigned char* ws; int ph_lo, ph_hi; };
static_assert(sizeof(Args) == 25 * 8 + 8 + 8 + 8, "Args has no padding");

__global__ void __launch_bounds__(NTHREADS, 2) fwd_kernel(Args args) {
    extern __shared__ __attribute__((aligned(16))) unsigned char lds_raw[];
    LAS unsigned char* lds = (LAS unsigned char*)lds_raw;
    volatile LAS unsigned* MISC = (volatile LAS unsigned*)(lds + MISC_OFF);
    const int tid = threadIdx.x, lane = tid & 63, wave = __builtin_amdgcn_readfirstlane(tid >> 6);
    const int G = gridDim.x; const int bx = blockIdx.x; const int vcu = (G % 8 == 0) ? (bx % 8) * (G / 8) + bx / 8 : bx;
    unsigned char* ws = args.ws;
    gu32* ctl = (gu32*)(ws + WS_CTL);
    for (int u = tid; u < (LDS_BYTES - LDSCTL_OFF) / 4; u += NTHREADS) ((LAS unsigned*)(lds + LDSCTL_OFF))[u] = 0u;
    __syncthreads();
    XcdBarrier bar; bar.bar = (unsigned*)(ctl + CW_BAR); bar.x = 0; bar.st = nullptr;
    if (MK_ONE_LAUNCH) bar = xcd_barrier_post((unsigned*)(ctl + CW_BAR), MISC + 8);
    const int lo = args.ph_lo, hi = args.ph_hi;
#ifndef PH_MASK
#define PH_MASK 0xffff
#endif
#define IN(k) (((PH_MASK >> (k)) & 1) && lo <= (k) && (k) < hi)
#define SEAM(k) do { if (IN(k) && (k) + 1 < hi) xcd_barrier(bar); } while (0)
    const int gw = vcu * NWAVES + wave, NGW = G * NWAVES;
#define PH_BEGIN(k) if (IN(k)) { PHASE_IDS
#define PHASE_IDS int tid_p_ = threadIdx.x; asm volatile("" : "+v"(tid_p_)); const int tid = tid_p_, lane = tid_p_ & 63; (void)tid; (void)lane;

    bf16* const WIN = (bf16*)(ws + WS_WIN); bf16* const WOUT = (bf16*)(ws + WS_WOUT); bf16* const WQM = (bf16*)(ws + WS_WQM); bf16* const WKV = (bf16*)(ws + WS_WKV);
    bf16* const WOM = (bf16*)(ws + WS_WOM); bf16* const WGU = (bf16*)(ws + WS_WGU); bf16* const WD = (bf16*)(ws + WS_WD);
    bf16* const XN = (bf16*)(ws + WS_XN); bf16* const MEMN = (bf16*)(ws + WS_MEMN); bf16* const PROJ = (bf16*)(ws + WS_PROJ); bf16* const KVM = (bf16*)(ws + WS_KVM);
    bf16* const OPART = (bf16*)(ws + WS_OPART); bf16* const OB = (bf16*)(ws + WS_OB); float* const LPART = (float*)(ws + WS_LPART); bf16* const MIXED = (bf16*)(ws + WS_MIXED);
    float* const X1 = (float*)(ws + WS_X1); bf16* const QM = (bf16*)(ws + WS_QM); bf16* const OM = (bf16*)(ws + WS_OM); float* const AFF = (float*)(ws + WS_AFF);
    int* const IDX = (int*)(ws + WS_IDX); float* const GATE = (float*)(ws + WS_GATE); int* const INV = (int*)(ws + WS_INV);
    bf16* const XE = (bf16*)(ws + WS_XE); bf16* const ACT = (bf16*)(ws + WS_ACT); bf16* const YS = (bf16*)(ws + WS_YS);
    float* const OUT = args.out; float* const X2 = (float*)(ws + WS_X2);
    unsigned char* const XN8 = ws + WS_XE; unsigned char* const ACT8 = ws + WS_ACT;
    float* const SS1 = (float*)(ws + WS_SS1); float* const SS2 = (float*)(ws + WS_SS2); float* const RS = (float*)(ws + WS_RS);

    PH_BEGIN(0)
        CONVERT_RANGE(0, T_TOTAL, vcu, G);
        for (int m = gw; m < TOK + BATCH * NMEM; m += NGW) {
            if (m < TOK) norm_row_bf16(args.in[0] + (size_t)m * DM, args.in[3], XN + (size_t)m * DM, lane);
            else norm_row_bf16(args.in[1] + (size_t)(m - TOK) * DM, args.in[14], MEMN + (size_t)(m - TOK) * DM, lane);
        }
    }
    SEAM(0);
    PH_BEGIN(1)
        OrderP1 S{G, bx, (const char*)XN, (const char*)WIN, (const char*)MEMN, (const char*)WKV};
        pg8::EpiBf16 E{PROJ, DIN, KVM, 2 * WMEM};
        pg8::gemm_phase<pg8::EpiBf16, OrderP1>(lds, DM * 2, DM * 2, S, E);
    }
    SEAM(1);
    PH_BEGIN(2)
        const int* pos = (const int*)args.in[2];
        for (int m = gw; m < TOK + BATCH * NMEM; m += NGW) {
            if (m < TOK) {
                const float inv_freq = exp2f(-(float)lane * (13.287712379549449f / 64.0f));
                const float ang = (float)pos[m] * inv_freq;
                const double ad = (double)ang; const double nrev = rint(ad * 0.15915494309189535); const float rf = (float)(ad - nrev * 6.283185307179586);
                const float cs = cosf(rf), sn = sinf(rf);
                bf16* row = PROJ + (size_t)m * DIN;
                float t1[26], t2[26];
#pragma unroll
                for (int s = 0; s < 26; ++s) { const int col = (s < 8) ? OFF_QA + 128 * s : (s < 16) ? OFF_KA + 128 * (s - 8) : (s < 24) ? OFF_QB + 128 * (s - 16) : OFF_KB + 128 * (s - 24);
                    t1[s] = bf2f(row[col + lane]); t2[s] = bf2f(row[col + 64 + lane]); }
                const float gqa1 = args.in[5][lane], gqa2 = args.in[5][lane + 64], gka1 = args.in[6][lane], gka2 = args.in[6][lane + 64];
                const float gqb1 = args.in[7][lane], gqb2 = args.in[7][lane + 64], gkb1 = args.in[8][lane], gkb2 = args.in[8][lane + 64];
#pragma unroll
                for (int s = 0; s < 26; ++s) { const int col = (s < 8) ? OFF_QA + 128 * s : (s < 16) ? OFF_KA + 128 * (s - 8) : (s < 24) ? OFF_QB + 128 * (s - 16) : OFF_KB + 128 * (s - 24);
                    const float g1 = (s < 8) ? gqa1 : (s < 16) ? gka1 : (s < 24) ? gqb1 : gkb1, g2 = (s < 8) ? gqa2 : (s < 16) ? gka2 : (s < 24) ? gqb2 : gkb2;
                    const float sc = (s < 8 || (s >= 16 && s < 24)) ? QSCALE : 1.f;
                    const float rstd = 1.0f / sqrtf(wave_sum(t1[s] * t1[s] + t2[s] * t2[s]) * (1.0f / HD) + EPS);
                    const float n1 = t1[s] * rstd * g1, n2 = t2[s] * rstd * g2;
                    row[col + lane] = (bf16)f2bf((n1 * cs - n2 * sn) * sc); row[col + 64 + lane] = (bf16)f2bf((n2 * cs + n1 * sn) * sc); }
            } else {
                bf16* row = KVM + (size_t)(m - TOK) * (2 * WMEM);
#pragma unroll 1
                for (int s = 0; s < 4; ++s) { const int col = 128 * s;
                    const float t1 = bf2f(row[col + lane]), t2 = bf2f(row[col + 64 + lane]);
                    const float rstd = 1.0f / sqrtf(wave_sum(t1 * t1 + t2 * t2) * (1.0f / HD) + EPS);
                    row[col + lane] = (bf16)f2bf(t1 * rstd * args.in[18][lane] * args.in[17][lane]); row[col + 64 + lane] = (bf16)f2bf(t2 * rstd * args.in[18][lane + 64] * args.in[17][lane + 64]); }
            }
        }
    }
    SEAM(2);
    PH_BEGIN(3)
        const float negM2a = -(SQRT_HD * LOG2E) * gain_absmax(args.in[5], lane) * gain_absmax(args.in[6], lane);
        const float negM2b = -(SQRT_HD * LOG2E) * gain_absmax(args.in[7], lane) * gain_absmax(args.in[8], lane);
        for (int u = vcu; u < 1024; u += G) {
            if (u < 768) {
                const int gi = u >> 8, rem = u & 255, b = rem >> 7, h = (rem >> 4) & 7, x = rem & 15;
                const int dlog = 2 * gi, d = 1 << dlog, r = x & (d - 1), blk = x >> dlog;
                const int L = SEQ >> dlog, i0 = blk * 256, a = i0 + 32 * wave;
                const int tlo = (i0 >> 6) - 1 < 0 ? 0 : (i0 >> 6) - 1, thi = (i0 >> 6) + 5 > (L >> 6) ? (L >> 6) : (i0 >> 6) + 5;
                const size_t tok0 = (size_t)b * SEQ + r;
                att::attn_unit<true, false, false>(lds, PROJ + (tok0 + (size_t)d * a) * DIN + OFF_QA + h * HD, (long)d * DIN,
                    PROJ + tok0 * DIN + OFF_KA + h * HD, PROJ + tok0 * DIN + OFF_VA + h * HD, (long)d * DIN, tlo, thi, a, 64, negM2a, 0.f,
                    OPART + (size_t)gi * TOK * 1024 + (tok0 + (size_t)d * a) * 1024 + h * HD, (long)d * 1024, LPART + (size_t)gi * TOK * 8 + (tok0 + (size_t)d * a) * 8 + h, (long)d * 8, nullptr);
            } else {
                const int ub = u - 768, b = ub >> 7, kvh = (ub >> 6) & 1, blk = ub & 63;
                const int i0 = blk * 64, a = i0 + 32 * (wave & 1), head = kvh * 4 + (wave >> 1);
                const int tlo = blk - 2 < 0 ? 0 : blk - 2, thi = blk + 3 > 64 ? 64 : blk + 3;
                const size_t tok0 = (size_t)b * SEQ;
                const float lx = __builtin_amdgcn_exp2f(args.in[9][head] * LOG2E + negM2b);
                att::attn_unit<true, false, true>(lds, PROJ + (tok0 + a) * DIN + OFF_QB + head * HD, (long)DIN,
                    PROJ + tok0 * DIN + OFF_KB + kvh * HD, PROJ + tok0 * DIN + OFF_VB + kvh * HD, (long)DIN, tlo, thi, a, 128, negM2b, lx,
                    OB + (tok0 + a) * 1024 + head * HD, 1024L, nullptr, 0L, nullptr);
            }
        }
    }
    SEAM(3);
    PH_BEGIN(4)
        for (int m = gw; m < TOK; m += NGW) {
            const int hd = lane >> 3; float oa[16], ob[16];
            float l = 0.f;
#pragma unroll
            for (int k = 0; k < 16; ++k) oa[k] = 0.f;
#pragma unroll
            for (int gi = 0; gi < 3; ++gi) { l += LPART[(size_t)gi * TOK * 8 + (size_t)m * 8 + hd];
                const GAS v4u* p = (const GAS v4u*)(OPART + (size_t)gi * TOK * 1024 + (size_t)m * 1024 + lane * 16);
#pragma unroll
                for (int q = 0; q < 2; ++q) { const v4u w = p[q]; oa[8 * q + 0] += bflo(w.x); oa[8 * q + 1] += bfhi(w.x); oa[8 * q + 2] += bflo(w.y); oa[8 * q + 3] += bfhi(w.y);
                    oa[8 * q + 4] += bflo(w.z); oa[8 * q + 5] += bfhi(w.z); oa[8 * q + 6] += bflo(w.w); oa[8 * q + 7] += bfhi(w.w); } }
            const float il = 1.0f / l; float ssa = 0.f, ssb = 0.f;
#pragma unroll
            for (int k = 0; k < 16; ++k) { oa[k] *= il; ssa += oa[k] * oa[k]; }
            { const GAS v4u* p = (const GAS v4u*)(OB + (size_t)m * 1024 + lane * 16);
#pragma unroll
              for (int q = 0; q < 2; ++q) { const v4u w = p[q]; ob[8 * q + 0] = bflo(w.x); ob[8 * q + 1] = bfhi(w.x); ob[8 * q + 2] = bflo(w.y); ob[8 * q + 3] = bfhi(w.y);
                  ob[8 * q + 4] = bflo(w.z); ob[8 * q + 5] = bfhi(w.z); ob[8 * q + 6] = bflo(w.w); ob[8 * q + 7] = bfhi(w.w); } }
#pragma unroll
            for (int k = 0; k < 16; ++k) ssb += ob[k] * ob[k];
            const float ra = 1.0f / sqrtf(wave_sum(ssa) * (1.0f / 1024.0f) + EPS), rb = 1.0f / sqrtf(wave_sum(ssb) * (1.0f / 1024.0f) + EPS);
            const float* ga = args.in[10] + lane * 16; const float* gb = args.in[11] + lane * 16;
            v4u wa[2], wb[2];
#pragma unroll
            for (int q = 0; q < 2; ++q) {
                wa[q] = (v4u){cvtpk(oa[8 * q] * ra * ga[8 * q], oa[8 * q + 1] * ra * ga[8 * q + 1]), cvtpk(oa[8 * q + 2] * ra * ga[8 * q + 2], oa[8 * q + 3] * ra * ga[8 * q + 3]),
                              cvtpk(oa[8 * q + 4] * ra * ga[8 * q + 4], oa[8 * q + 5] * ra * ga[8 * q + 5]), cvtpk(oa[8 * q + 6] * ra * ga[8 * q + 6], oa[8 * q + 7] * ra * ga[8 * q + 7])};
                wb[q] = (v4u){cvtpk(ob[8 * q] * rb * gb[8 * q], ob[8 * q + 1] * rb * gb[8 * q + 1]), cvtpk(ob[8 * q + 2] * rb * gb[8 * q + 2], ob[8 * q + 3] * rb * gb[8 * q + 3]),
                              cvtpk(ob[8 * q + 4] * rb * gb[8 * q + 4], ob[8 * q + 5] * rb * gb[8 * q + 5]), cvtpk(ob[8 * q + 6] * rb * gb[8 * q + 6], ob[8 * q + 7] * rb * gb[8 * q + 7])}; }
            GAS v4u* pa = (GAS v4u*)(MIXED + (size_t)m * DM + lane * 16); GAS v4u* pb = (GAS v4u*)(MIXED + (size_t)m * DM + 1024 + lane * 16);
            pa[0] = wa[0]; pa[1] = wa[1]; pb[0] = wb[0]; pb[1] = wb[1];
        }
    }
    SEAM(4);
    PH_BEGIN(5)
        OrderPlain S{G, bx, 32, 8, DM * 2, (const char*)MIXED, (const char*)WOUT};
        pg8::EpiResidX E{args.in[0], X1, XN, nullptr, SS1, DM};
        pg8::gemm_phase<pg8::EpiResidX, OrderPlain>(lds, DM * 2, DM * 2, S, E);
    }
    SEAM(5);
    PH_BEGIN(7)
        OrderPlain S{G, bx, 32, 2, DM * 2, (const char*)XN, (const char*)WQM};
        pg8::EpiBf16 E{QM, WMEM, QM, WMEM};
        pg8::gemm_phase<pg8::EpiBf16, OrderPlain>(lds, DM * 2, DM * 2, S, E);
    }
    SEAM(7);
    PH_BEGIN(8)
        const float gg = wave_max(fmaxf(fabsf(args.in[17][lane] * args.in[18][lane]), fabsf(args.in[17][lane + 64] * args.in[18][lane + 64])));
        const float negM2c = -(SQRT_HD * LOG2E) * gg;
        for (int u = vcu; u < 128; u += G) {
            const int b = u >> 6, h = (u >> 4) & 3, blk = u & 15, a = blk * 256 + 32 * wave;
            const size_t tok0 = (size_t)b * SEQ;
            att::attn_unit<false, true, true>(lds, QM + (tok0 + a) * WMEM + h * HD, (long)WMEM, KVM + (size_t)b * NMEM * 2 * WMEM + h * HD, KVM + (size_t)b * NMEM * 2 * WMEM + WMEM + h * HD, 2L * WMEM,
                0, 4, a, 1 << 20, negM2c, 0.f, OM + (tok0 + a) * WMEM + h * HD, (long)WMEM, nullptr, 0L, SS1 + tok0 + a);
        }
    }
    SEAM(8);
    PH_BEGIN(9)
        OrderPlain S{G, bx, 32, 8, WMEM * 2, (const char*)OM, (const char*)WOM};
        pg8::EpiResidX E{X1, X2, nullptr, XN8, SS2, DM};
        pg8::gemm_phase<pg8::EpiResidX, OrderPlain>(lds, WMEM * 2, WMEM * 2, S, E);
    }
    SEAM(9);
    PH_BEGIN(10)
        LAS float* wrT = (LAS float*)lds;
        for (int i = tid; i < DM * NEXP / 4; i += NTHREADS) { const f32x4 w = *(const GAS f32x4*)(args.in[21] + 4 * i); const int k = i >> 2, e0 = (i & 3) * 4;
            wrT[(e0 + 0) * DM + k] = w.x; wrT[(e0 + 1) * DM + k] = w.y; wrT[(e0 + 2) * DM + k] = w.z; wrT[(e0 + 3) * DM + k] = w.w; }
        LDS_WAIT(); __syncthreads();
        for (int m = gw; m < TOK; m += NGW) {
            const float* xrow = X2 + (size_t)m * DM; f32x4 v[8]; float ss = 0.f;
#pragma unroll
            for (int j = 0; j < 8; ++j) { v[j] = *(const GAS f32x4*)(xrow + lane * 4 + 256 * j); ss += (v[j].x * v[j].x + v[j].y * v[j].y) + (v[j].z * v[j].z + v[j].w * v[j].w); }
            const float rstd = 1.0f / sqrtf(wave_sum(ss) * (1.0f / DM) + EPS);
#pragma unroll
            for (int j = 0; j < 8; ++j) { const f32x4 gg = *(const GAS f32x4*)(args.in[20] + lane * 4 + 256 * j); v[j].x *= rstd * gg.x; v[j].y *= rstd * gg.y; v[j].z *= rstd * gg.z; v[j].w *= rstd * gg.w; }
            float lg[16];
#pragma unroll
            for (int e = 0; e < 16; ++e) { float s = 0.f;
#pragma unroll
                for (int j = 0; j < 8; ++j) { const f32x4 w = *(const LAS f32x4*)(wrT + e * DM + lane * 4 + 256 * j); s += (v[j].x * w.x + v[j].y * w.y) + (v[j].z * w.z + v[j].w * w.w); }
                lg[e] = wave_sum(s); asm volatile("" ::: "memory"); }
            float mx = lg[0];
#pragma unroll
            for (int e = 1; e < 16; ++e) mx = fmaxf(mx, lg[e]);
            float den = 0.f, mine = 0.f;
#pragma unroll
            for (int e = 0; e < 16; ++e) { const float ex = expf(lg[e] - mx); den += ex; if (lane == e) mine = ex; }
            if (lane < 16) AFF[((size_t)(m >> 12) * NEXP + lane) * SEQ + (m & (SEQ - 1))] = mine / den;
        }
    }
    SEAM(10);
    PH_BEGIN(11)
        LAS unsigned* hist = (LAS unsigned*)lds; LAS unsigned* misc = hist + 256; LAS unsigned* wtot = hist + 272;
        for (int u = vcu; u < BATCH * NEXP; u += G) {
            const int b = u >> 4, e = u & 15; const float* aff = AFF + (size_t)u * SEQ;
            const f32x4 a0 = *(const GAS f32x4*)(aff + tid * 8), a1 = *(const GAS f32x4*)(aff + tid * 8 + 4);
            unsigned bits[8] = {__float_as_uint(a0.x), __float_as_uint(a0.y), __float_as_uint(a0.z), __float_as_uint(a0.w), __float_as_uint(a1.x), __float_as_uint(a1.y), __float_as_uint(a1.z), __float_as_uint(a1.w)};
            unsigned prefix = 0u, krem = CAP;
#pragma unroll 1
            for (int pass = 0; pass < 4; ++pass) { const int shift = 24 - 8 * pass;
                __syncthreads();
                if (tid < 256) hist[tid] = 0u;
                __syncthreads();
#pragma unroll
                for (int i = 0; i < 8; ++i) if (pass == 0 || (bits[i] >> (shift + 8)) == prefix) __hip_atomic_fetch_add(&hist[(bits[i] >> shift) & 255u], 1u, __ATOMIC_RELAXED, __HIP_MEMORY_SCOPE_WORKGROUP);
                __syncthreads();
                if (wave == 0) {
                    const unsigned h0 = hist[255 - 4 * lane], h1 = hist[254 - 4 * lane], h2 = hist[253 - 4 * lane], h3 = hist[252 - 4 * lane];
                    const unsigned s = h0 + h1 + h2 + h3; unsigned incl = s;
#pragma unroll
                    for (int o = 1; o < 64; o <<= 1) { const unsigned t = __shfl_up(incl, o); if (lane >= o) incl += t; }
                    const unsigned excl = incl - s;
                    if (excl < krem && krem <= incl) { unsigned rem = krem - excl; unsigned bin;
                        if (rem <= h0) bin = 255 - 4 * lane; else { rem -= h0; if (rem <= h1) bin = 254 - 4 * lane; else { rem -= h1; if (rem <= h2) bin = 253 - 4 * lane; else { rem -= h2; bin = 252 - 4 * lane; } } }
                        misc[0] = (prefix << 8) | bin; misc[1] = rem; }
                }
                __syncthreads();
                prefix = misc[0]; krem = misc[1];
            }
            unsigned ngt = 0u, neq = 0u;
#pragma unroll
            for (int i = 0; i < 8; ++i) { ngt += bits[i] > prefix; neq += bits[i] == prefix; }
            unsigned cnt = ngt | (neq << 16), incl = cnt;
#pragma unroll
            for (int o = 1; o < 64; o <<= 1) { const unsigned t = __shfl_up(incl, o); if (lane >= o) incl += t; }
            if (lane == 63) wtot[wave] = incl;
            __syncthreads();
            unsigned base = 0u;
#pragma unroll
            for (int w = 0; w < 8; ++w) if (w < wave) base += wtot[w];
            const unsigned excl = base + incl - cnt; unsigned gtb = excl & 0xffffu, eqb = excl >> 16;
            const int rowbase = (e * BATCH + b) * CAP;
            const float vals[8] = {a0.x, a0.y, a0.z, a0.w, a1.x, a1.y, a1.z, a1.w};
#pragma unroll
            for (int i = 0; i < 8; ++i) { const bool gt = bits[i] > prefix, eq = bits[i] == prefix; const bool sel = gt || (eq && eqb < krem);
                const int slot = (int)(gtb + (eqb < krem ? eqb : krem)); const int s = tid * 8 + i;
                if (sel) { IDX[rowbase + slot] = s; GATE[rowbase + slot] = vals[i]; RS[rowbase + slot] = 1.0f / sqrtf(SS2[(size_t)b * SEQ + s] * (1.0f / DM) + EPS); }
                INV[((size_t)b * SEQ + s) * NEXP + e] = sel ? rowbase + slot : -1;
                gtb += gt; eqb += eq; }
            __syncthreads();
        }
    }
    SEAM(11);
    PH_BEGIN(13)
        OrderMoeG S{G, bx, (const char*)XN8, (const char*)WGU, IDX};
        pg8::EpiSwiGlu8 E{ACT8, DFF, RS, 1.0f / (FP8_SX * FP8_SW), FP8_SA};
        pg8::gemm_phase<pg8::EpiSwiGlu8, OrderMoeG, true>(lds, DM, DM, S, E);
    }
    SEAM(13);
    PH_BEGIN(14)
        OrderMoe S{G, bx, 8, DFF, (const char*)ACT8, (const char*)WD};
        pg8::EpiScaleBf16 E{YS, DM, GATE, 1.0f / (FP8_SA * FP8_SW)};
        pg8::gemm_phase<pg8::EpiScaleBf16, OrderMoe, true>(lds, DFF, DFF, S, E);
    }
    SEAM(14);
    PH_BEGIN(15)
        for (int m = gw; m < TOK; m += NGW) {
            const float* xrow = X2 + (size_t)m * DM + lane * 4; float* orow = OUT + (size_t)m * DM + lane * 4; f32x4 acc[8];
#pragma unroll
            for (int j = 0; j < 8; ++j) acc[j] = *(const GAS f32x4*)(xrow + 256 * j);
            const int myr = (lane < NEXP) ? INV[(size_t)m * NEXP + lane] : -1;
            unsigned long long mask = __ballot(myr >= 0);
            while (mask) { const int e = __builtin_ctzll(mask); mask &= mask - 1; const int r = __builtin_amdgcn_readlane(myr, e);
                const GAS v2u* p = (const GAS v2u*)(YS + (size_t)r * DM + lane * 4);
#pragma unroll
                for (int j = 0; j < 8; ++j) { const v2u w = p[64 * j]; acc[j].x += bflo(w.x); acc[j].y += bfhi(w.x); acc[j].z += bflo(w.y); acc[j].w += bfhi(w.y); } }
#pragma unroll
            for (int j = 0; j < 8; ++j) *(GAS f32x4*)(orow + 256 * j) = acc[j];
        }
    }
#ifdef PROBE_XBAR
    for (int i_ = 0; i_ < PROBE_XBAR; ++i_) xcd_barrier(bar);
#endif
#undef IN
#undef SEAM
}

extern "C" void kernel_launch(void* const* d_in, const int* in_sizes, int n_in, void* d_out, int out_size, void* d_ws, size_t ws_size, hipStream_t stream) {
    static int grid = 0;
    if (grid == 0) {
        if (n_in != 25 || out_size != TOK * DM || ws_size < WS_END) { fprintf(stderr, "kernel_launch: unexpected problem (n_in %d out %d ws %zu)\n", n_in, out_size, ws_size); grid = -1; return; }
        int dev = 0, cus = 0;
        if (hipGetDevice(&dev) != hipSuccess || hipDeviceGetAttribute(&cus, hipDeviceAttributeMultiprocessorCount, dev) != hipSuccess) { grid = -1; return; }
        if (hipFuncSetAttribute((const void*)fwd_kernel, hipFuncAttributeMaxDynamicSharedMemorySize, LDS_BYTES) != hipSuccess) { fprintf(stderr, "kernel_launch: hipFuncSetAttribute failed\n"); grid = -1; return; }
        int per_cu = 0; (void)hipOccupancyMaxActiveBlocksPerMultiprocessor(&per_cu, (const void*)fwd_kernel, NTHREADS, LDS_BYTES); (void)hipGetLastError();
        grid = cus;
    }
    if (grid < 0) return;
    (void)hipMemsetAsync((char*)d_ws + WS_CTL, 0, CTL_ZERO_BYTES, stream);
    Args a{};
    for (int i = 0; i < 25; ++i) a.in[i] = (const float*)d_in[i];
    a.out = (float*)d_out; a.ws = (unsigned char*)d_ws;
#if MK_ONE_LAUNCH
    a.ph_lo = 0; a.ph_hi = NPHASE;
    hipLaunchKernelGGL(fwd_kernel, dim3(grid), dim3(NTHREADS), LDS_BYTES, stream, a);
#ifdef PROBE_RELAUNCH
    for (int p = 0; p < NPHASE; ++p) if ((PROBE_RELAUNCH >> p) & 1) { a.ph_lo = p; a.ph_hi = p + 1; hipLaunchKernelGGL(fwd_kernel, dim3(grid), dim3(NTHREADS), LDS_BYTES, stream, a); }
#endif
#else
    for (int p = 0; p < NPHASE; ++p) { a.ph_lo = p; a.ph_hi = p + 1; hipLaunchKernelGGL(fwd_kernel, dim3(grid), dim3(NTHREADS), LDS_BYTES, stream, a); }
#endif
}
```

```cpp
#include <hip/hip_runtime.h>
#include <hip/hip_bf16.h>
#include <cstdio>
#include <cstdint>

#ifndef MK_ONE_LAUNCH
#define MK_ONE_LAUNCH 1
#endif

constexpr int BATCH = 2, SEQ = 4096, DM = 2048, TOK = BATCH * SEQ, HD = 128;
constexpr int DIN = 4608, NMEM = 256, WMEM = 512, NEXP = 16, CAP = 512, DFF = 2048;
constexpr int OFF_QA = 0, OFF_KA = 1024, OFF_VA = 2048, OFF_QB = 3072, OFF_KB = 4096, OFF_VB = 4352;
constexpr float EPS = 1e-6f;
constexpr float LOG2E = 1.4426950408889634f;
constexpr float QSCALE = 0.08838834764831845f * LOG2E;
constexpr float SQRT_HD = 11.313708498984761f;
constexpr float FP8_SW = 256.f, FP8_SX = 16.f, FP8_SA = 8.f;

namespace pg8 {
#define PG8_LAS __attribute__((address_space(3)))
typedef unsigned short bf16_t;
typedef short bf16x8 __attribute__((ext_vector_type(8)));
typedef float f32x4 __attribute__((ext_vector_type(4)));
typedef unsigned u32x4 __attribute__((ext_vector_type(4)));
typedef int i32x4 __attribute__((ext_vector_type(4)));
typedef int i32x8 __attribute__((ext_vector_type(8)));
typedef int i32x16 __attribute__((ext_vector_type(16)));
typedef int i32x32 __attribute__((ext_vector_type(32)));
constexpr int BM = 256, BK = 64, HALF = 128, HTB = HALF * BK * 2  , STAGE_BYTES = 8 * HTB, NXCD = 8, WGM = 8;

__host__ __device__ __forceinline__ int lds_byte(int r, int c) { const int st = (r >> 4) * 2 + (c >> 5), rr = r & 15, cc = c & 31, ob = rr * 64 + cc * 2; return st * 1024 + (ob ^ (((ob >> 9) & 1) << 5)); }
__host__ __device__ __forceinline__ void stage_rc(int b, int& R, int& C) { const int st = b / 1024, sb = b % 1024, swz = sb ^ (((sb >> 9) & 1) << 5); R = (st >> 1) * 16 + swz / 64; C = (st & 1) * 32 + (swz % 64) / 2; }
__host__ __device__ __forceinline__ int perm32(int rho) { const int n = rho >> 4, i = rho & 15; return 8 * (i >> 2) + 4 * n + (i & 3); }

struct Unit { int pm, pn, kind; const char* A; const char* B; const int* rows; };

__device__ __forceinline__ bool static_order(int i, int G, int c, int nM, int nN, int& pm, int& pn) {
    const int nwg = nM * nN; const long L = (long)i * G + c; if (L >= nwg) return false;
    int wgid = (int)L; { const int q = nwg / NXCD, r = nwg % NXCD, xcd = wgid % NXCD, off = wgid / NXCD; wgid = (xcd < r ? xcd * (q + 1) : r * (q + 1) + (xcd - r) * q) + off; }
    const int nig = WGM * nN, gid = wgid / nig, fm = gid * WGM, gsz = (nM - fm) < WGM ? (nM - fm) : WGM;
    pm = fm + ((wgid % nig) % gsz); pn = (wgid % nig) / gsz; return true;
}

__device__ __forceinline__ float clamp8(float x) { return __builtin_amdgcn_fmed3f(x, -448.f, 448.f); }
__device__ __forceinline__ int cvt_fp8x4(float a, float b, float c, float d) { int w = 0; w = __builtin_amdgcn_cvt_pk_fp8_f32(clamp8(a), clamp8(b), w, false); return __builtin_amdgcn_cvt_pk_fp8_f32(clamp8(c), clamp8(d), w, true); }
__device__ __forceinline__ unsigned cvt_pk_bf16(float lo, float hi) { unsigned r; asm volatile("v_cvt_pk_bf16_f32 %0, %1, %2" : "=v"(r) : "v"(lo), "v"(hi)); return r; }

#define PG8_ZERO_INIT __device__ __forceinline__ void init(f32x4 (&acc)[2][2][4][2], const Unit&, int, int, int, int) const { \
        _Pragma("unroll") for (int a = 0; a < 2; ++a) _Pragma("unroll") for (int b = 0; b < 2; ++b) _Pragma("unroll") for (int m = 0; m < 4; ++m) _Pragma("unroll") for (int n = 0; n < 2; ++n) acc[a][b][m][n] = (f32x4){0.f, 0.f, 0.f, 0.f}; }
struct EpiBf16 {
    static constexpr bool PERM = true, AFTER_DRAIN = false;
    bf16_t* O0; int ldc0; bf16_t* O1; int ldc1; int hm_rows;
    PG8_ZERO_INIT
    __device__ __forceinline__ void operator()(const f32x4 (&acc)[2][2][4][2], const Unit& u, int wr, int wc, int fr, int fq) const {
        const bool hm = (u.kind == 0 && ldc0 == 0);
        bf16_t* base = u.kind ? O1 : O0; const int ldc = hm ? HALF : (u.kind ? ldc1 : ldc0);
        const int row0 = u.pm * BM + wr * 64 + fr, col0 = (hm ? 0 : u.pn * BM) + wc * 32 + 8 * fq;
        const size_t hstride = hm ? (size_t)hm_rows * HALF : (size_t)HALF;
        if (hm) base += (size_t)(2 * u.pn) * hm_rows * HALF;
#pragma unroll
        for (int ai = 0; ai < 2; ++ai)
#pragma unroll
            for (int m = 0; m < 4; ++m) { bf16_t* rowp = base + (size_t)(row0 + ai * HALF + m * 16) * ldc + col0;
#pragma unroll
                for (int bj = 0; bj < 2; ++bj) { const f32x4 v0 = acc[ai][bj][m][0], v1 = acc[ai][bj][m][1];
                    u32x4 w; w.x = cvt_pk_bf16(v0[0], v0[1]); w.y = cvt_pk_bf16(v0[2], v0[3]); w.z = cvt_pk_bf16(v1[0], v1[1]); w.w = cvt_pk_bf16(v1[2], v1[3]);
                    *(u32x4*)(rowp + bj * hstride) = w; } }
    }
};
struct EpiResidX {
    static constexpr bool PERM = true, AFTER_DRAIN = false;
    const float* base; const bf16_t* baseb; float* out; bf16_t* xb; unsigned char* x8; float* ss; int ldc; int pv;
    __device__ __forceinline__ void init(f32x4 (&acc)[2][2][4][2], const Unit& u, int wr, int wc, int fr, int fq) const {
        const int row0 = u.pm * BM + wr * 64 + fr, col0 = u.pn * BM + wc * 32 + 8 * fq;
#pragma unroll
        for (int ai = 0; ai < 2; ++ai)
#pragma unroll
            for (int m = 0; m < 4; ++m) { const size_t off = (size_t)(row0 + ai * HALF + m * 16) * ldc + col0;
#pragma unroll
                for (int bj = 0; bj < 2; ++bj) {
                    if (pv == 2) { acc[ai][bj][m][0] = (f32x4){0.f, 0.f, 0.f, 0.f}; acc[ai][bj][m][1] = (f32x4){0.f, 0.f, 0.f, 0.f}; }
                    else if (base) { acc[ai][bj][m][0] = *(const f32x4*)(base + off + bj * HALF); acc[ai][bj][m][1] = *(const f32x4*)(base + off + bj * HALF + 4); }
                    else { const u32x4 w = *(const u32x4*)(baseb + off + bj * HALF);
                        acc[ai][bj][m][0] = (f32x4){__uint_as_float(w.x << 16), __uint_as_float(w.x & 0xffff0000u), __uint_as_float(w.y << 16), __uint_as_float(w.y & 0xffff0000u)};
                        acc[ai][bj][m][1] = (f32x4){__uint_as_float(w.z << 16), __uint_as_float(w.z & 0xffff0000u), __uint_as_float(w.w << 16), __uint_as_float(w.w & 0xffff0000u)}; } } }
    }
    __device__ __forceinline__ void operator()(const f32x4 (&acc)[2][2][4][2], const Unit& u, int wr, int wc, int fr, int fq) const {
        const int row0 = u.pm * BM + wr * 64 + fr, col0 = u.pn * BM + wc * 32 + 8 * fq;
#pragma unroll
        for (int ai = 0; ai < 2; ++ai)
#pragma unroll
            for (int m = 0; m < 4; ++m) { const int row = row0 + ai * HALF + m * 16; const size_t off = (size_t)row * ldc + col0; float sq = 0.f;
#pragma unroll
                for (int bj = 0; bj < 2; ++bj) { const f32x4 v0 = acc[ai][bj][m][0], v1 = acc[ai][bj][m][1];
                    if (out) { *(f32x4*)(out + off + bj * HALF) = v0; *(f32x4*)(out + off + bj * HALF + 4) = v1; }
                    sq += ((v0[0] * v0[0] + v0[1] * v0[1]) + (v0[2] * v0[2] + v0[3] * v0[3])) + ((v1[0] * v1[0] + v1[1] * v1[1]) + (v1[2] * v1[2] + v1[3] * v1[3]));
                    if (xb) { u32x4 w; w.x = cvt_pk_bf16(v0[0], v0[1]); w.y = cvt_pk_bf16(v0[2], v0[3]); w.z = cvt_pk_bf16(v1[0], v1[1]); w.w = cvt_pk_bf16(v1[2], v1[3]); *(u32x4*)(xb + off + bj * HALF) = w; }
                    if (x8) { typedef int i32x2 __attribute__((ext_vector_type(2)));
                        *(i32x2*)(x8 + off + bj * HALF) = (i32x2){cvt_fp8x4(v0[0] * FP8_SX, v0[1] * FP8_SX, v0[2] * FP8_SX, v0[3] * FP8_SX), cvt_fp8x4(v1[0] * FP8_SX, v1[1] * FP8_SX, v1[2] * FP8_SX, v1[3] * FP8_SX)}; } }
                sq += __shfl_xor(sq, 16); sq += __shfl_xor(sq, 32);
                if (fq == 0 && pv != 1) atomicAdd(ss + row, sq); }
    }
};
struct EpiSwiGlu8 {
    static constexpr bool PERM = true, AFTER_DRAIN = false;
    unsigned char* O; int ldc; const float* rs; float si, so;
    PG8_ZERO_INIT
    __device__ __forceinline__ float sw(float g, float u) const { return g * u * __builtin_amdgcn_rcpf(1.0f + __builtin_amdgcn_exp2f(-g * LOG2E)); }
    __device__ __forceinline__ void operator()(const f32x4 (&acc)[2][2][4][2], const Unit& u, int wr, int wc, int fr, int fq) const {
        const int row0 = u.pm * BM + wr * 64 + fr, col0 = u.pn * HALF + wc * 32 + 8 * fq;
#pragma unroll
        for (int ai = 0; ai < 2; ++ai)
#pragma unroll
            for (int m = 0; m < 4; ++m) { const int row = row0 + ai * HALF + m * 16; const float r = rs[row] * si; unsigned char* rowp = O + (size_t)row * ldc + col0;
                const f32x4 g0 = acc[ai][0][m][0] * r, g1 = acc[ai][0][m][1] * r, u0 = acc[ai][1][m][0] * r, u1 = acc[ai][1][m][1] * r;
                const int w0 = cvt_fp8x4(so * sw(g0[0], u0[0]), so * sw(g0[1], u0[1]), so * sw(g0[2], u0[2]), so * sw(g0[3], u0[3]));
                const int w1 = cvt_fp8x4(so * sw(g1[0], u1[0]), so * sw(g1[1], u1[1]), so * sw(g1[2], u1[2]), so * sw(g1[3], u1[3]));
                typedef int i32x2 __attribute__((ext_vector_type(2))); *(i32x2*)rowp = (i32x2){w0, w1}; }
    }
};
struct EpiScaleBf16 {
    static constexpr bool PERM = true, AFTER_DRAIN = false;
    bf16_t* O; int ldc; const float* rowscale; float cs;
    PG8_ZERO_INIT
    __device__ __forceinline__ void operator()(const f32x4 (&acc)[2][2][4][2], const Unit& u, int wr, int wc, int fr, int fq) const {
        const int row0 = u.pm * BM + wr * 64 + fr, col0 = u.pn * BM + wc * 32 + 8 * fq;
#pragma unroll
        for (int ai = 0; ai < 2; ++ai)
#pragma unroll
            for (int m = 0; m < 4; ++m) { const int row = row0 + ai * HALF + m * 16; const float s = rowscale[row] * cs; bf16_t* rowp = O + (size_t)row * ldc + col0;
#pragma unroll
                for (int bj = 0; bj < 2; ++bj) { const f32x4 v0 = acc[ai][bj][m][0] * s, v1 = acc[ai][bj][m][1] * s;
                    u32x4 w; w.x = cvt_pk_bf16(v0[0], v0[1]); w.y = cvt_pk_bf16(v0[2], v0[3]); w.z = cvt_pk_bf16(v1[0], v1[1]); w.w = cvt_pk_bf16(v1[2], v1[3]);
                    *(u32x4*)(rowp + bj * HALF) = w; } }
    }
};

template <class Epi, class Sched, bool FP8 = false, bool ALIGN_EPI = true>
__device__ __forceinline__ void gemm_phase(PG8_LAS unsigned char* lds, const int KB, const int ldbB, const Sched& S, const Epi& E) {
    const int tid = threadIdx.x, wid = __builtin_amdgcn_readfirstlane(tid >> 6), lane = tid & 63, wr = wid >> 2, wc = wid & 3, fr = lane & 15, fq = lane >> 4;
    const int nt = KB / (BK * 2);
    int RA[2], CA[2]; unsigned voffB[2];
#pragma unroll
    for (int i = 0; i < 2; ++i) { int R, C; stage_rc(tid * 16 + i * 8192, R, C); const int Rb = Epi::PERM ? ((R & ~31) + perm32(R & 31)) : R;
        RA[i] = R; CA[i] = C; voffB[i] = (unsigned)(Rb * ldbB + C * 2); }
    const size_t kstep = (size_t)(BK * 2);
    const size_t hstep = (size_t)HALF * ldbB;
    const unsigned ldsw = (unsigned)wid * 1024u;
    const int aoff = lds_byte(wr * 64 + fr, fq * 8), boff = lds_byte(wc * 32 + fr, fq * 8);
#define PG8_SA(b, h) (((b) * 2 + (h)) * HTB)
#define PG8_SB(b, h) ((4 + (b) * 2 + (h)) * HTB)
#define PG8_STAGE(bufoff, gbase, voff) do { _Pragma("unroll") for (int _i = 0; _i < 2; ++_i) \
        __builtin_amdgcn_global_load_lds((const unsigned*)((const char*)(gbase) + (voff)[_i]), (PG8_LAS unsigned*)(lds + (bufoff) + ldsw + _i * 8192), 16, 0, 0); } while (0)
#define PG8_RD(off_) (*(const PG8_LAS i32x4*)(lds + (off_)))
#define PG8_LDA(dst, b, h) do { _Pragma("unroll") for (int m = 0; m < 4; ++m) { \
        if constexpr (FP8) { const i32x4 lo_ = PG8_RD(PG8_SA(b, h) + aoff + m * 2048), hi_ = PG8_RD(PG8_SA(b, h) + aoff + m * 2048 + 1024); _Pragma("unroll") for (int e_ = 0; e_ < 4; ++e_) { dst##8[8 * m + e_] = lo_[e_]; dst##8[8 * m + 4 + e_] = hi_[e_]; } } \
        else { _Pragma("unroll") for (int k = 0; k < 2; ++k) dst[m][k] = *(const PG8_LAS bf16x8*)(lds + PG8_SA(b, h) + aoff + m * 2048 + k * 1024); } } } while (0)
#define PG8_LDB(dst, b, h) do { _Pragma("unroll") for (int n = 0; n < 2; ++n) { \
        if constexpr (FP8) { const i32x4 lo_ = PG8_RD(PG8_SB(b, h) + boff + n * 2048), hi_ = PG8_RD(PG8_SB(b, h) + boff + n * 2048 + 1024); _Pragma("unroll") for (int e_ = 0; e_ < 4; ++e_) { dst##8[8 * n + e_] = lo_[e_]; dst##8[8 * n + 4 + e_] = hi_[e_]; } } \
        else { _Pragma("unroll") for (int k = 0; k < 2; ++k) dst[n][k] = *(const PG8_LAS bf16x8*)(lds + PG8_SB(b, h) + boff + n * 2048 + k * 1024); } } } while (0)
#define PG8_SUB8(v, i) ((i32x8){v[8 * (i)], v[8 * (i) + 1], v[8 * (i) + 2], v[8 * (i) + 3], v[8 * (i) + 4], v[8 * (i) + 5], v[8 * (i) + 6], v[8 * (i) + 7]})
#define PG8_MMA(ai, bj, At, Bt) do { __builtin_amdgcn_s_setprio(1); _Pragma("unroll") for (int m = 0; m < 4; ++m) _Pragma("unroll") for (int n = 0; n < 2; ++n) { \
        if constexpr (FP8) asm volatile("v_mfma_scale_f32_16x16x128_f8f6f4 %0, %1, %2, %0, %3, %3 op_sel_hi:[0,0,0]" : "+v"(acc[ai][bj][m][n]) : "v"(PG8_SUB8(Bt##8, n)), "v"(PG8_SUB8(At##8, m)), "v"(sc1)); \
        else { _Pragma("unroll") for (int k = 0; k < 2; ++k) acc[ai][bj][m][n] = __builtin_amdgcn_mfma_f32_16x16x32_bf16(Bt[n][k], At[m][k], acc[ai][bj][m][n], 0, 0, 0); } } \
        __builtin_amdgcn_s_setprio(0); } while (0)
#define PG8_WAIT_V(n) asm volatile("s_waitcnt vmcnt(" #n ")" ::: "memory")
#define PG8_WAIT_L(n) asm volatile("s_waitcnt lgkmcnt(" #n ")" ::: "memory")
#define PG8_BAR __builtin_amdgcn_s_barrier()
#define PG8_SCHED __builtin_amdgcn_sched_barrier(0)
    Unit cur, nxt; int ui = 0;
    if (!S.next(0, cur)) return;
    unsigned vAc[2][2], vAn[2][2];
    S.a_offs(cur, RA, CA, vAc);
    f32x4 acc[2][2][4][2];
    E.init(acc, cur, wr, wc, fr, fq);
    const int sc1 = 0x7F7F7F7F;
    bf16x8 At[4][2], B0[2][2], B1[2][2]; i32x32 At8; i32x16 B08, B18;
    const char* cA = cur.A; const char* cB = cur.B;
    PG8_STAGE(PG8_SB(0, 0), cB, voffB); PG8_STAGE(PG8_SB(0, 1), cB + hstep, voffB); PG8_STAGE(PG8_SA(0, 0), cA, vAc[0]); PG8_STAGE(PG8_SA(0, 1), cA, vAc[1]);
    if (wr == 1) PG8_BAR;
    PG8_WAIT_V(2); PG8_BAR;
    PG8_STAGE(PG8_SB(1, 0), cB + kstep, voffB); PG8_STAGE(PG8_SA(1, 0), cA + kstep, vAc[0]); PG8_STAGE(PG8_SB(1, 1), cB + hstep + kstep, voffB);
    PG8_WAIT_V(6); PG8_BAR;
    for (;;) {
        const bool has_next = S.next(ui + 1, nxt);
        const char* nA = has_next ? nxt.A : cA; const char* nB = has_next ? nxt.B : cB;
        if (Sched::GATHER && has_next) S.a_offs(nxt, RA, CA, vAn);
        else {
#pragma unroll
            for (int h = 0; h < 2; ++h)
#pragma unroll
                for (int i = 0; i < 2; ++i) vAn[h][i] = vAc[h][i]; }
        for (int t = 0; t < nt; t += 2) {
            const bool last = (t == nt - 2);
            const char* a1 = cA + (size_t)(t + 1) * kstep;
            const char* a2 = last ? nA : cA + (size_t)(t + 2) * kstep; const char* b2 = last ? nB : cB + (size_t)(t + 2) * kstep;
            const char* a3 = a2 + kstep; const char* b3 = b2 + kstep;
            unsigned o2[2][2];
#pragma unroll
            for (int h = 0; h < 2; ++h)
#pragma unroll
                for (int i = 0; i < 2; ++i) o2[h][i] = (Sched::GATHER && last) ? vAn[h][i] : vAc[h][i];
            if (last && has_next) S.a_ready(nxt);
            PG8_LDB(B0, 0, 0); PG8_LDB(B1, 0, 1); PG8_SCHED; PG8_LDA(At, 0, 0); PG8_STAGE(PG8_SA(1, 1), a1, vAc[1]);
            PG8_WAIT_V(8); PG8_WAIT_L(0); PG8_BAR; PG8_MMA(0, 0, At, B0); PG8_MMA(0, 1, At, B1); PG8_BAR; PG8_SCHED;
            PG8_LDA(At, 0, 1); PG8_STAGE(PG8_SB(0, 0), b2, voffB); PG8_STAGE(PG8_SB(0, 1), b2 + hstep, voffB); PG8_STAGE(PG8_SA(0, 0), a2, o2[0]);
            PG8_WAIT_V(8); PG8_WAIT_L(0); PG8_BAR; PG8_MMA(1, 0, At, B0); PG8_MMA(1, 1, At, B1); PG8_BAR; PG8_SCHED;
            PG8_LDB(B0, 1, 0); PG8_LDB(B1, 1, 1); PG8_SCHED; PG8_LDA(At, 1, 0); PG8_STAGE(PG8_SA(0, 1), a2, o2[1]);
            PG8_WAIT_V(8); PG8_WAIT_L(0); PG8_BAR; PG8_MMA(0, 0, At, B0); PG8_MMA(0, 1, At, B1); PG8_BAR; PG8_SCHED;
            PG8_LDA(At, 1, 1); PG8_STAGE(PG8_SB(1, 0), b3, voffB); PG8_STAGE(PG8_SB(1, 1), b3 + hstep, voffB); PG8_STAGE(PG8_SA(1, 0), a3, o2[0]);
            PG8_WAIT_V(8); PG8_WAIT_L(0); PG8_BAR; PG8_MMA(1, 0, At, B0); PG8_MMA(1, 1, At, B1); PG8_BAR; PG8_SCHED;
        }
        if constexpr (ALIGN_EPI) { if (wr == 0) PG8_BAR; }
        if constexpr (FP8) asm volatile("s_nop 15\n\ts_nop 15" ::: "memory");
        E(acc, cur, wr, wc, fr, fq); S.done(cur);
        if (!has_next) break;
        E.init(acc, nxt, wr, wc, fr, fq);
        cur = nxt; cA = nA; cB = nB; ++ui;
#pragma unroll
        for (int h = 0; h < 2; ++h)
#pragma unroll
            for (int i = 0; i < 2; ++i) vAc[h][i] = vAn[h][i];
        if constexpr (ALIGN_EPI) { if (wr == 1) PG8_BAR; }
    }
    PG8_WAIT_V(0);
    if constexpr (!ALIGN_EPI) { if (wr == 0) PG8_BAR; }
    PG8_BAR;
#undef PG8_SA
#undef PG8_SB
#undef PG8_STAGE
#undef PG8_LDA
#undef PG8_LDB
#undef PG8_MMA
#undef PG8_WAIT_V
#undef PG8_WAIT_L
#undef PG8_BAR
#undef PG8_SCHED
}
}

#define GAS __attribute__((address_space(1)))
#define LAS __attribute__((address_space(3)))
typedef unsigned short bf16;
typedef unsigned v4u __attribute__((ext_vector_type(4)));
typedef float f32x4 __attribute__((ext_vector_type(4)));
typedef short bf16x8 __attribute__((ext_vector_type(8)));
typedef GAS unsigned gu32;
typedef GAS unsigned long long gu64;
#define RLX_AGENT __ATOMIC_RELAXED, __HIP_MEMORY_SCOPE_AGENT
#define LDS_WAIT() asm volatile("s_waitcnt lgkmcnt(0)" ::: "memory")
#define VM_WAIT() asm volatile("s_waitcnt vmcnt(0)" ::: "memory")
__device__ __forceinline__ unsigned long long rt() { return __builtin_amdgcn_s_memrealtime(); }
__device__ __forceinline__ unsigned f2bf(float f) { unsigned u = __builtin_bit_cast(unsigned, f); return (u + 0x7fffu + ((u >> 16) & 1u)) >> 16; }
__device__ __forceinline__ unsigned pk2(float lo, float hi) { return f2bf(lo) | (f2bf(hi) << 16); }

#define XB_TMO      128
#define XB_XCNT(j)  (256  + 64 * (j))
#define XB_XSUB(j)  (1280 + 64 * (j))
#define XB_XGEN(j)  (2304 + 64 * (j))
#define XB_TOP      3328
#define XB_TOPGEN   3392
#define XCD_BAR_WORDS 3456
#define XB_SPIN_CAP (1u << 18)

__device__ __forceinline__ unsigned xb_ld(unsigned* p)              { return __hip_atomic_load(p, __ATOMIC_RELAXED, __HIP_MEMORY_SCOPE_AGENT); }
__device__ __forceinline__ unsigned xb_add(unsigned* p, unsigned v) { return __hip_atomic_fetch_add(p, v, __ATOMIC_RELAXED, __HIP_MEMORY_SCOPE_AGENT); }
__device__ __forceinline__ unsigned xb_xcc_id() { return (unsigned)__builtin_amdgcn_s_getreg((3 << 11) | 20) & 0xFu; }
#define XB_SPIN(cond, bar) do { unsigned _sp = 0; while (cond) { __builtin_amdgcn_s_sleep(1); \
    if ((++_sp & 255u) == 0u) { if (xb_ld(&(bar)[XB_TMO])) break; if (_sp > XB_SPIN_CAP) { atomicAdd(&(bar)[XB_TMO], 1u); break; } } } } while (0)

struct XcdBarrier {
    unsigned* bar; unsigned x;
    volatile LAS unsigned* st;
};

__device__ __forceinline__ XcdBarrier xcd_barrier_post(unsigned* bar, volatile LAS unsigned* st) {
    XcdBarrier b; b.bar = bar; b.x = xb_xcc_id(); b.st = st;
    if (threadIdx.x == 0) (void)xb_add(&bar[XB_XCNT(b.x)], 1u);
    return b;
}
__device__ __forceinline__ void xcd_barrier_complete(unsigned* bar, unsigned x, unsigned& nloc, unsigned& nx) {
    const unsigned G = gridDim.x * gridDim.y * gridDim.z;
    unsigned sum, cnt, mine, sp = 0u;
    for (;;) {
        sum = 0u; cnt = 0u; mine = 0u;
#pragma unroll
        for (unsigned j = 0; j < 16; ++j) { const unsigned c = xb_ld(&bar[XB_XCNT(j)]); sum += c; cnt += (c > 0u) ? 1u : 0u; mine = (j == x) ? c : mine; }
        if (sum == G) break;
        __builtin_amdgcn_s_sleep(1);
        if ((++sp & 255u) == 0u) { if (xb_ld(&bar[XB_TMO])) break; if (sp > XB_SPIN_CAP) { atomicAdd(&bar[XB_TMO], 1u); break; } }
    }
    nloc = mine > 0u ? mine : 1u; nx = cnt > 0u ? cnt : 1u;
}

__device__ __forceinline__ void xcd_barrier(const XcdBarrier& b) {
    asm volatile("s_waitcnt vmcnt(0)" ::: "memory");
    __syncthreads();
    if (threadIdx.x == 0) {
        unsigned* bar = b.bar;
        __builtin_amdgcn_s_waitcnt(0);
        unsigned nloc = b.st[0], nx = b.st[1];
        if (nloc == 0u) { xcd_barrier_complete(bar, b.x, nloc, nx); b.st[0] = nloc; b.st[1] = nx; }
        const unsigned old = xb_add(&bar[XB_XSUB(b.x)], 1u);
        const unsigned gen = old / nloc;
        if (old + 1u == (gen + 1u) * nloc) {
            __builtin_amdgcn_fence(__ATOMIC_RELEASE, "agent");
            asm volatile("s_waitcnt vmcnt(0)" ::: "memory");
            const unsigned og = xb_add(&bar[XB_TOP], 1u);
            const unsigned tg = og / nx;
            if (og + 1u == (tg + 1u) * nx) xb_add(&bar[XB_TOPGEN], 1u);
            else XB_SPIN(xb_ld(&bar[XB_TOPGEN]) == tg, bar);
            __builtin_amdgcn_fence(__ATOMIC_ACQUIRE, "agent");
            xb_add(&bar[XB_XGEN(b.x)], 1u);
            asm volatile("s_waitcnt vmcnt(0)" ::: "memory");
        } else {
            XB_SPIN(xb_ld(&bar[XB_XGEN(b.x)]) == gen, bar);
            __builtin_amdgcn_fence(__ATOMIC_ACQUIRE, "agent");
            asm volatile("s_waitcnt vmcnt(0)" ::: "memory");
        }
    }
    __syncthreads();
}


constexpr size_t MiB = 1u << 20;
constexpr size_t WS_CTL = 0, CTL_ZERO_BYTES = 1 * MiB;
constexpr size_t WS_WIN = 1 * MiB;
constexpr size_t WS_WOUT = 19 * MiB;
constexpr size_t WS_WQM = 27 * MiB;
constexpr size_t WS_WKV = 29 * MiB;
constexpr size_t WS_WOM = 33 * MiB;
constexpr size_t WS_WGU = 35 * MiB;
constexpr size_t WS_WD = 291 * MiB;
constexpr size_t WS_XN = 419 * MiB;
constexpr size_t WS_MEMN = 451 * MiB;
constexpr size_t WS_PROJ = 453 * MiB;
constexpr size_t WS_KVM = 525 * MiB;
constexpr size_t WS_OPART = 526 * MiB;
constexpr size_t WS_OB = 574 * MiB;
constexpr size_t WS_LPART = 590 * MiB;
constexpr size_t WS_MIXED = 591 * MiB;
constexpr size_t WS_X1 = 623 * MiB;
constexpr size_t WS_QM = 687 * MiB;
constexpr size_t WS_OM = 695 * MiB;
constexpr size_t WS_AFF = 703 * MiB;
constexpr size_t WS_IDX = 704 * MiB;
constexpr size_t WS_GATE = 704 * MiB + 65536;
constexpr size_t WS_INV = 704 * MiB + 131072;
constexpr size_t WS_RS = 704 * MiB + 655360;
constexpr size_t WS_SS1 = 65536, WS_SS2 = 131072;
constexpr size_t WS_XE = 705 * MiB;
constexpr size_t WS_ACT = 769 * MiB;
constexpr size_t WS_YS = 833 * MiB;
constexpr size_t WS_X2 = 897 * MiB;
constexpr size_t WS_END = 961 * MiB;
constexpr int CW_BAR = 4096;

constexpr int RING_BYTES = 131072;
constexpr int LDSCTL_OFF = RING_BYTES, MISC_OFF = LDSCTL_OFF + 320;
constexpr int LDS_BYTES = 147456;
constexpr int NWAVES = 8, NTHREADS = 512;

typedef unsigned v2u __attribute__((ext_vector_type(2)));
typedef float f32x2 __attribute__((ext_vector_type(2)));
typedef __bf16 bf16x2_t __attribute__((ext_vector_type(2)));
__device__ __forceinline__ unsigned cvtpk(float lo, float hi) { f32x2 v = {lo, hi}; bf16x2_t b = __builtin_convertvector(v, bf16x2_t); return __builtin_bit_cast(unsigned, b); }
__device__ __forceinline__ float bflo(unsigned w) { return __uint_as_float(w << 16); }
__device__ __forceinline__ float bfhi(unsigned w) { return __uint_as_float(w & 0xffff0000u); }
__device__ __forceinline__ float bf2f(unsigned short h) { return __uint_as_float((unsigned)h << 16); }
__device__ __forceinline__ float wave_sum(float v) {
#pragma unroll
    for (int o = 1; o < 64; o <<= 1) v += __shfl_xor(v, o);
    return v;
}
__device__ __forceinline__ float wave_max(float v) {
#pragma unroll
    for (int o = 1; o < 64; o <<= 1) v = fmaxf(v, __shfl_xor(v, o));
    return v;
}
__device__ __forceinline__ float gain_absmax(const float* g, int lane) { return wave_max(fmaxf(fabsf(g[lane]), fabsf(g[lane + 64]))); }

struct CvtTile { const float* src; bf16* dst; const float* gk; int N, K, mode, k0, n0, fp8; };
constexpr int T_IN = 16 * 18, T_OUT = 16 * 8, T_QM = 16 * 2, T_KV = 16 * 4, T_OM = 4 * 8, T_EXP = 16 * 128;
constexpr int T_TOTAL = T_IN + T_OUT + T_QM + T_KV + T_OM + 3 * T_EXP;
template <class A_> __device__ __forceinline__ CvtTile cvt_decode(int it, const A_& args, unsigned char* ws) {
    CvtTile t; int r = it; t.gk = nullptr; t.fp8 = 0;
    if (r < T_IN) { t.src = args.in[4]; t.dst = (bf16*)(ws + WS_WIN); t.N = DIN; t.K = DM; t.mode = 0; t.k0 = (r / 18) * 128; t.n0 = (r % 18) * 256; return t; } r -= T_IN;
    if (r < T_KV) { t.src = args.in[16]; t.dst = (bf16*)(ws + WS_WKV); t.N = 2 * WMEM; t.K = DM; t.mode = 0; t.k0 = (r / 4) * 128; t.n0 = (r % 4) * 256; return t; } r -= T_KV;
    if (r < T_OUT) { t.src = args.in[12]; t.dst = (bf16*)(ws + WS_WOUT); t.N = DM; t.K = DM; t.mode = 0; t.k0 = (r / 8) * 128; t.n0 = (r % 8) * 256; return t; } r -= T_OUT;
    if (r < T_QM) { t.src = args.in[15]; t.gk = args.in[13]; t.dst = (bf16*)(ws + WS_WQM); t.N = WMEM; t.K = DM; t.mode = 0; t.k0 = (r / 2) * 128; t.n0 = (r % 2) * 256; return t; } r -= T_QM;
    if (r < T_OM) { t.src = args.in[19]; t.dst = (bf16*)(ws + WS_WOM); t.N = DM; t.K = WMEM; t.mode = 0; t.k0 = (r / 8) * 128; t.n0 = (r % 8) * 256; return t; } r -= T_OM;
    const int which = r / T_EXP; r -= which * T_EXP; const int e = r / 128, rr = r % 128; t.fp8 = 1;
    t.N = DM; t.K = DM; t.k0 = (rr / 8) * 128; t.n0 = (rr % 8) * 256;
    if (which < 2) t.gk = args.in[20];
    if (which == 0) { t.src = args.in[22] + (size_t)e * DM * DFF; t.dst = (bf16*)(ws + WS_WGU + (size_t)e * 2 * DFF * DM); t.mode = 1; }
    else if (which == 1) { t.src = args.in[23] + (size_t)e * DM * DFF; t.dst = (bf16*)(ws + WS_WGU + (size_t)e * 2 * DFF * DM); t.mode = 2; }
    else { t.src = args.in[24] + (size_t)e * DFF * DM; t.dst = (bf16*)(ws + WS_WD + (size_t)e * DM * DFF); t.mode = 0; }
    return t;
}
#define CVT_ISSUE(v, t) do { const float* p_ = (t).src + (size_t)((t).k0 + 4 * (tid >> 6)) * (t).N + (t).n0 + 4 * (tid & 63); \
    _Pragma("unroll") for (int ps_ = 0; ps_ < 4; ++ps_) _Pragma("unroll") for (int r_ = 0; r_ < 4; ++r_) v[ps_ * 4 + r_] = __builtin_nontemporal_load((const GAS f32x4*)(p_ + (size_t)(32 * ps_ + r_) * (t).N)); } while (0)
__device__ __forceinline__ void cvt_to_lds(const f32x4 (&v)[16], const float* gk, int k0, LAS unsigned char* lds, int tid) {
    const int c = tid & 63, kg = tid >> 6, f = c & 15;
#pragma unroll
    for (int ps = 0; ps < 4; ++ps) { const int kch = 8 * ps + kg;
        f32x4 gq = (f32x4){1.f, 1.f, 1.f, 1.f}; if (gk) gq = *(const GAS f32x4*)(gk + k0 + 32 * ps + 4 * kg);
#pragma unroll
        for (int j = 0; j < 4; ++j) { v2u w; w.x = cvtpk(v[ps * 4 + 0][j] * gq.x, v[ps * 4 + 1][j] * gq.y); w.y = cvtpk(v[ps * 4 + 2][j] * gq.z, v[ps * 4 + 3][j] * gq.w);
            *(LAS v2u*)(lds + (4 * c + j) * 256 + ((kch ^ f) * 8)) = w; } }
}
__device__ __forceinline__ void cvt_to_lds8(const f32x4 (&v)[16], const float* gk, int k0, LAS unsigned char* lds, int tid) {
    const int c = tid & 63, kg = tid >> 6, f = c & 7;
#pragma unroll
    for (int ps = 0; ps < 4; ++ps) { const int kch = 8 * ps + kg;
        f32x4 gq = (f32x4){FP8_SW, FP8_SW, FP8_SW, FP8_SW}; if (gk) gq = *(const GAS f32x4*)(gk + k0 + 32 * ps + 4 * kg) * FP8_SW;
#pragma unroll
        for (int j = 0; j < 4; ++j) { const int w = pg8::cvt_fp8x4(v[ps * 4 + 0][j] * gq.x, v[ps * 4 + 1][j] * gq.y, v[ps * 4 + 2][j] * gq.z, v[ps * 4 + 3][j] * gq.w);
            *(LAS int*)(lds + (4 * c + j) * 128 + (((kch >> 2) ^ f) * 16) + (kch & 3) * 4) = w; } }
}
__device__ __forceinline__ void cvt_store8(const CvtTile& t, LAS unsigned char* lds, int tid) {
    const int q = tid & 7;
#pragma unroll
    for (int ps = 0; ps < 4; ++ps) { const int n = (tid >> 3) + 64 * ps, f = (n >> 2) & 7; const v4u w = *(LAS v4u*)(lds + n * 128 + ((q ^ f) * 16));
        const int nn = t.n0 + n; const int drow = t.mode == 0 ? nn : ((nn >> 7) * 256 + (nn & 127) + (t.mode == 2 ? 128 : 0));
        *(GAS v4u*)((unsigned char*)t.dst + (size_t)drow * t.K + t.k0 + 16 * q) = w; }
}
__device__ __forceinline__ void cvt_store(const CvtTile& t, LAS unsigned char* lds, int tid) {
    const int q = tid & 15;
#pragma unroll
    for (int ps = 0; ps < 8; ++ps) { const int n = (tid >> 4) + 32 * ps, f = (n >> 2) & 15; v4u w = *(LAS v4u*)(lds + n * 256 + ((q ^ (f >> 1)) * 16));
        if (f & 1) { const unsigned a = w.x, b = w.y; w.x = w.z; w.y = w.w; w.z = a; w.w = b; }
        const int nn = t.n0 + n; const int drow = t.mode == 0 ? nn : ((nn >> 7) * 256 + (nn & 127) + (t.mode == 2 ? 128 : 0));
        *(GAS v4u*)(t.dst + (size_t)drow * t.K + t.k0 + 8 * q) = w; }
}
constexpr int CT_P0A = T_IN + T_KV;
#ifndef CT_P1N
#define CT_P1N 1180
#endif
#ifndef CT_P7N
#define CT_P7N 4
#endif
#ifndef CT_P8N
#define CT_P8N 2
#endif
#ifndef CT_P11N
#define CT_P11N 2
#endif
constexpr int CT_P1END = CT_P0A + CT_P1N, CT_P7END = CT_P1END + 192 * CT_P7N, CT_P8END = CT_P7END + 128 * CT_P8N, CT_P11END = CT_P8END + 224 * CT_P11N;
static_assert(CT_P11END <= T_TOTAL - T_EXP, "slots end before the w_down tiles");
constexpr int CT_P1END_ = 0;
static_assert(CT_P1N >= T_OUT + T_QM + T_OM && CT_P1END <= T_TOTAL, "conversion split");
#define CVT_STEP(vc_, tc_, tn2_, hn2_) do { __syncthreads(); if ((tc_).fp8) cvt_to_lds8(vc_, (tc_).gk, (tc_).k0, lds, tid); else cvt_to_lds(vc_, (tc_).gk, (tc_).k0, lds, tid); \
        if (hn2_) CVT_ISSUE(vc_, tn2_); \
        LDS_WAIT(); __syncthreads(); if ((tc_).fp8) cvt_store8(tc_, lds, tid); else cvt_store(tc_, lds, tid); } while (0)
#define CONVERT_RANGE(t0_, t1_, j_, n_) do { f32x4 va_[16], vb_[16]; int it_ = (t0_) + (j_); \
        bool ha_ = it_ < (t1_); CvtTile ta_ = cvt_decode(ha_ ? it_ : 0, args, ws); if (ha_) CVT_ISSUE(va_, ta_); it_ += (n_); \
        bool hb_ = it_ < (t1_); CvtTile tb_ = cvt_decode(hb_ ? it_ : 0, args, ws); if (hb_) CVT_ISSUE(vb_, tb_); it_ += (n_); \
        while (ha_) { \
            { const bool h2_ = it_ < (t1_); const CvtTile t2_ = cvt_decode(h2_ ? it_ : 0, args, ws); it_ += (n_); CVT_STEP(va_, ta_, t2_, h2_); ta_ = t2_; ha_ = h2_; } \
            if (!hb_) break; \
            { const bool h2_ = it_ < (t1_); const CvtTile t2_ = cvt_decode(h2_ ? it_ : 0, args, ws); it_ += (n_); CVT_STEP(vb_, tb_, t2_, h2_); tb_ = t2_; hb_ = h2_; } } \
        __syncthreads(); } while (0)
__device__ __forceinline__ void norm_row_bf16(const float* xrow, const float* g, bf16* orow, int lane) {
    f32x4 v[8]; float ss = 0.f;
#pragma unroll
    for (int j = 0; j < 8; ++j) { v[j] = *(const GAS f32x4*)(xrow + lane * 4 + 256 * j); ss += (v[j].x * v[j].x + v[j].y * v[j].y) + (v[j].z * v[j].z + v[j].w * v[j].w); }
    const float rstd = 1.0f / sqrtf(wave_sum(ss) * (1.0f / DM) + EPS);
#pragma unroll
    for (int j = 0; j < 8; ++j) { const f32x4 gg = *(const GAS f32x4*)(g + lane * 4 + 256 * j); v2u w; w.x = cvtpk(v[j].x * rstd * gg.x, v[j].y * rstd * gg.y); w.y = cvtpk(v[j].z * rstd * gg.z, v[j].w * rstd * gg.w);
        *(GAS v2u*)(orow + lane * 4 + 256 * j) = w; }
}

namespace att {
typedef short s16x4 __attribute__((ext_vector_type(4)));
typedef float f32x16 __attribute__((ext_vector_type(16)));
constexpr int NBUF = 3, TILEB = 16384, VBUF = NBUF * TILEB, STG_PITCH = 272, STG_W = 32 * STG_PITCH, WSF = 2 * NBUF * TILEB;
static_assert(8 * STG_W <= WSF && WSF + 8 * 256 <= 131072, "attention LDS map");
__device__ __forceinline__ int crow(int r, int hi) { return (r & 3) + 8 * (r >> 2) + 4 * hi; }
__device__ __forceinline__ s16x4 vtr(const LAS unsigned char* p) { return __builtin_bit_cast(s16x4, __builtin_amdgcn_ds_read_tr16_b64_v4i16((LAS s16x4*)p)); }
template <bool MASK, bool QNORM, bool NORMALIZE>
__device__ __forceinline__ void attn_unit(LAS unsigned char* lds, const bf16* qw, long q_stride, const bf16* k0, const bf16* v0, long kv_stride,
                                          int tlo, int thi, int a, int half, float negM2, float l_extra, bf16* ow, long o_stride, float* lw, long l_stride, const float* ssrow) {
    int tid_ = threadIdx.x; asm volatile("" : "+v"(tid_));
    const int tid = tid_, lane = tid & 63, c = lane & 31, hi = lane >> 5, wid = __builtin_amdgcn_readfirstlane(tid >> 6);
    const int srow = tid >> 4, sch = tid & 15;
    const bf16* kg = k0 + (long)srow * kv_stride + (sch ^ (srow & 15)) * 8; const bf16* vg = v0 + (long)srow * kv_stride + (sch ^ (((srow & 3) << 2) | ((srow >> 2) & 3))) * 8;
    const unsigned ldsw = (unsigned)wid * 1024u;
    const unsigned lds0 = (unsigned)(size_t)lds + ldsw;
#define AT_GLDS(gp, dst) do { unsigned keep_; asm volatile("s_mov_b32 %0, m0\n\ts_mov_b32 m0, %2\n\ts_nop 0\n\tglobal_load_lds_dwordx4 %1, off\n\ts_mov_b32 m0, %0" : "=&s"(keep_) : "v"(gp), "s"((unsigned)__builtin_amdgcn_readfirstlane(dst)) : "memory"); } while (0)
#define AT_ISSUE(t, bw) do { const long r_ = (long)(t) * 64; \
        AT_GLDS(kg + r_ * kv_stride, lds0 + (bw) * TILEB); AT_GLDS(kg + (r_ + 32) * kv_stride, lds0 + (bw) * TILEB + 8192); \
        AT_GLDS(vg + r_ * kv_stride, lds0 + VBUF + (bw) * TILEB); AT_GLDS(vg + (r_ + 32) * kv_stride, lds0 + VBUF + (bw) * TILEB + 8192); } while (0)
#define AT_WAITBAR(n) asm volatile("s_waitcnt vmcnt(" #n ") lgkmcnt(0)\n\ts_barrier" ::: "memory")
    AT_ISSUE(tlo, 0);
    if (tlo + 1 < thi) AT_ISSUE(tlo + 1, 1);
    bf16x8 qf[8];
    { const bf16* qp = qw + (long)c * q_stride + 8 * hi;
#pragma unroll
      for (int ks = 0; ks < 8; ++ks) qf[ks] = *(const GAS bf16x8*)(qp + 16 * ks); }
    float qs = 1.f;
    if (QNORM) { float ss = 0.f;
#pragma unroll
        for (int ks = 0; ks < 8; ++ks)
#pragma unroll
            for (int j = 0; j < 8; ++j) { const float f = bf2f((unsigned short)qf[ks][j]); ss += f * f; }
        ss += __shfl_xor(ss, 32); const float r1 = 1.0f / sqrtf(ssrow[c] * (1.0f / DM) + EPS);
        qs = QSCALE * r1 / sqrtf(r1 * r1 * ss * (1.0f / HD) + EPS); }
    const unsigned kbase = c * 256; const int cx = c & 15;
    const int q4 = (lane & 15) >> 2, p = lane & 3, g = (lane >> 4) & 1;
    unsigned vb[4][2];
#pragma unroll
    for (int db = 0; db < 4; ++db)
#pragma unroll
        for (int u = 0; u < 2; ++u) vb[db][u] = VBUF + 256 * (4 * hi + 8 * u + q4) + 16 * ((((db ^ q4)) << 2) | ((g ^ u) << 1) | ((p >> 1) ^ hi)) + 8 * (p & 1);
    f32x16 o[4];
#pragma unroll
    for (int db = 0; db < 4; ++db)
#pragma unroll
        for (int r = 0; r < 16; ++r) o[db][r] = 0.f;
    float lsum = 0.f;
    asm volatile("" : "+v"(qf[0]), "+v"(qf[1]), "+v"(qf[2]), "+v"(qf[3]), "+v"(qf[4]), "+v"(qf[5]), "+v"(qf[6]), "+v"(qf[7]));
    asm volatile("" : "+v"(qs));
    AT_WAITBAR(0);
    int buf = 0;
    for (int t = tlo; t < thi; ++t) {
        const bool more2 = (t + 2 < thi);
        if (more2) { const int b2 = (buf == 0) ? 2 : buf - 1; AT_ISSUE(t + 2, b2); }
        const bool need = !MASK || ((64 * t + 63 >= a - half) && (64 * t <= a + 31 + half));
        if (need) {
            const LAS unsigned char* kt = lds + buf * TILEB + kbase; const LAS unsigned char* vt = lds + buf * TILEB;
            const float ini = QNORM ? 0.f : negM2;
            const int jb = 64 * t + 4 * hi - (a + c);
            bf16x8 ka[2][8];
#pragma unroll
            for (int ks = 0; ks < 8; ++ks) { const int off = 16 * ((2 * ks + hi) ^ cx); ka[0][ks] = *(const LAS bf16x8*)(kt + off); ka[1][ks] = *(const LAS bf16x8*)(kt + off + 8192); }
            __builtin_amdgcn_sched_barrier(0);
            f32x16 pp[2];
#pragma unroll
            for (int r = 0; r < 16; ++r) { pp[0][r] = ini; pp[1][r] = ini; }
#pragma unroll
            for (int ks = 0; ks < 8; ++ks) { pp[0] = __builtin_amdgcn_mfma_f32_32x32x16_bf16(ka[0][ks], qf[ks], pp[0], 0, 0, 0); pp[1] = __builtin_amdgcn_mfma_f32_32x32x16_bf16(ka[1][ks], qf[ks], pp[1], 0, 0, 0); }
            s16x4 vl[2][4], vh[2][4];
#pragma unroll
            for (int sp = 0; sp < 4; ++sp) { const int imm = 8192 * (sp >> 1) + 4096 * (sp & 1); vl[0][sp] = vtr(vt + vb[0][0] + imm); vh[0][sp] = vtr(vt + vb[0][1] + imm); }
            __builtin_amdgcn_sched_barrier(0);
            v4u pw[4];
#pragma unroll
            for (int kb = 0; kb < 2; ++kb) {
#pragma unroll
                for (int r = 0; r < 16; ++r) {
                    float e0 = QNORM ? __builtin_amdgcn_exp2f(__builtin_fmaf(pp[kb][r], qs, negM2)) : __builtin_amdgcn_exp2f(pp[kb][r]);
                    if (MASK) { const int d0 = jb + 32 * kb + (r & 3) + 8 * (r >> 2); if ((unsigned)(d0 + half) > (unsigned)(2 * half)) e0 = 0.f; }
                    pp[kb][r] = e0; lsum += e0; }
                pw[2 * kb] = (v4u){cvtpk(pp[kb][0], pp[kb][1]), cvtpk(pp[kb][2], pp[kb][3]), cvtpk(pp[kb][4], pp[kb][5]), cvtpk(pp[kb][6], pp[kb][7])};
                pw[2 * kb + 1] = (v4u){cvtpk(pp[kb][8], pp[kb][9]), cvtpk(pp[kb][10], pp[kb][11]), cvtpk(pp[kb][12], pp[kb][13]), cvtpk(pp[kb][14], pp[kb][15])};
            }
#pragma unroll
            for (int db = 0; db < 4; ++db) {
                if (db < 3) {
#pragma unroll
                    for (int sp = 0; sp < 4; ++sp) { const int imm = 8192 * (sp >> 1) + 4096 * (sp & 1); vl[(db + 1) & 1][sp] = vtr(vt + vb[db + 1][0] + imm); vh[(db + 1) & 1][sp] = vtr(vt + vb[db + 1][1] + imm); } }
#pragma unroll
                for (int sp = 0; sp < 4; ++sp) { const s16x4 lo = vl[db & 1][sp], hv = vh[db & 1][sp];
                    const bf16x8 vf = (bf16x8){lo[0], lo[1], lo[2], lo[3], hv[0], hv[1], hv[2], hv[3]};
                    o[db] = __builtin_amdgcn_mfma_f32_32x32x16_bf16(__builtin_bit_cast(bf16x8, pw[sp]), vf, o[db], 0, 0, 0); }
                __builtin_amdgcn_sched_barrier(0);
            }
        }
        if (more2) { AT_WAITBAR(4); } else { AT_WAITBAR(0); }
        buf = (buf == 2) ? 0 : buf + 1;
    }
#undef AT_ISSUE
#undef AT_GLDS
#undef AT_WAITBAR
    lsum += __shfl_xor(lsum, 32); lsum += l_extra;
    LAS float* wsf = (LAS float*)(lds + WSF + wid * 256);
    if (NORMALIZE) { if (hi == 0) wsf[c] = 1.0f / lsum; } else { if (hi == 0) lw[(long)c * l_stride] = lsum; }
    LDS_WAIT();
    LAS unsigned char* stg = lds + wid * STG_W;
#pragma unroll
    for (int r = 0; r < 16; ++r) { const int row = crow(r, hi); const float sc = NORMALIZE ? wsf[row] : 1.0f;
#pragma unroll
        for (int db = 0; db < 4; ++db) *(LAS unsigned short*)(stg + row * STG_PITCH + (32 * db + c) * 2) = (unsigned short)f2bf(o[db][r] * sc); }
    LDS_WAIT();
#pragma unroll
    for (int i = 0; i < 8; ++i) { const int row = 4 * i + (lane >> 4), ch = lane & 15; const v4u w = *(const LAS v4u*)(stg + row * STG_PITCH + ch * 16);
        *(GAS v4u*)(ow + (long)row * o_stride + ch * 8) = w; }
    LDS_WAIT();
    __syncthreads();
}
}

#define PLAIN_A_OFFS(lda_) static constexpr bool GATHER = false; __device__ __forceinline__ void a_offs(const pg8::Unit&, const int (&RA)[2], const int (&CA)[2], unsigned (&vA)[2][2]) const { \
        _Pragma("unroll") for (int h = 0; h < 2; ++h) _Pragma("unroll") for (int i = 0; i < 2; ++i) vA[h][i] = (unsigned)((h * 128 + RA[i]) * (lda_) + CA[i] * 2); }
struct OrderP1 {
    int G, c, kvj; const char* XN; const char* WIN; const char* MEMN; const char* WKV;
    __device__ __forceinline__ bool next(int i, pg8::Unit& u) const {
        int pm, pn; u.rows = nullptr;
        if (kvj < 0) { if (!pg8::static_order(i, G, c, 32, 18, pm, pn)) return false;
            u.pm = pm; u.pn = pn; u.kind = 0; u.A = XN + (size_t)pm * 256 * DM * 2; u.B = WIN + (size_t)pn * 256 * DM * 2; return true; }
        if (i > 0 || kvj >= 8) return false;
        u.pm = kvj >> 2; u.pn = kvj & 3; u.kind = 1; u.A = MEMN + (size_t)u.pm * 256 * DM * 2; u.B = WKV + (size_t)u.pn * 256 * DM * 2; return true;
    }
    PLAIN_A_OFFS(DM * 2)
    __device__ __forceinline__ void a_ready(const pg8::Unit&) const {}
    __device__ __forceinline__ void done(const pg8::Unit&) const {}
};
struct OrderPlain {
    int G, c, nM, nN, KB; const char* A; const char* B;
    __device__ __forceinline__ bool next(int i, pg8::Unit& u) const {
        int pm, pn; if (!pg8::static_order(i, G, c, nM, nN, pm, pn)) return false;
        u.pm = pm; u.pn = pn; u.kind = 0; u.rows = nullptr; u.A = A + (size_t)pm * 256 * KB; u.B = B + (size_t)pn * 256 * KB; return true;
    }
    PLAIN_A_OFFS(KB)
    __device__ __forceinline__ void a_ready(const pg8::Unit&) const {}
    __device__ __forceinline__ void done(const pg8::Unit&) const {}
};
struct OrderMoe {
    int G, c, nN, KB; const char* A; const char* B;
    __device__ __forceinline__ bool next(int i, pg8::Unit& u) const {
        int pm, pn; if (!pg8::static_order(i, G, c, 64, nN, pm, pn)) return false;
        u.pm = pm; u.pn = pn; u.kind = 0; u.rows = nullptr; u.A = A + (size_t)pm * 256 * KB; u.B = B + ((size_t)(pm >> 2) * nN + pn) * 256 * KB; return true;
    }
    PLAIN_A_OFFS(KB)
    __device__ __forceinline__ void a_ready(const pg8::Unit&) const {}
    __device__ __forceinline__ void done(const pg8::Unit&) const {}
};
struct OrderMoeG {
    static constexpr bool GATHER = true; int G, c; const char* X; const char* B; const int* idx;
    __device__ __forceinline__ bool next(int i, pg8::Unit& u) const {
        int pm, pn; if (!pg8::static_order(i, G, c, 64, 16, pm, pn)) return false;
        u.pm = pm; u.pn = pn; u.kind = 0; u.rows = idx + pm * 256; u.A = X + (size_t)((pm >> 1) & 1) * SEQ * DM; u.B = B + ((size_t)(pm >> 2) * 16 + pn) * 256 * DM; return true;
    }
    __device__ __forceinline__ void a_offs(const pg8::Unit& u, const int (&RA)[2], const int (&CA)[2], unsigned (&vA)[2][2]) const {
#pragma unroll
        for (int h = 0; h < 2; ++h)
#pragma unroll
            for (int i = 0; i < 2; ++i) vA[h][i] = (unsigned)(u.rows[h * 128 + RA[i]] * DM + CA[i] * 2); }
    __device__ __forceinline__ void a_ready(const pg8::Unit&) const {}
    __device__ __forceinline__ void done(const pg8::Unit&) const {}
};

constexpr int NPHASE = 16;
struct Args { const float* in[25]; float* out; unsigned char* ws; int ph_lo, ph_hi, variant, pad; };
static_assert(sizeof(Args) == 25 * 8 + 8 + 8 + 16, "Args has no padding");

__global__ void __launch_bounds__(NTHREADS, 2) fwd_kernel(Args args) {
    extern __shared__ __attribute__((aligned(16))) unsigned char lds_raw[];
    LAS unsigned char* lds = (LAS unsigned char*)lds_raw;
    volatile LAS unsigned* MISC = (volatile LAS unsigned*)(lds + MISC_OFF);
    const int tid = threadIdx.x, lane = tid & 63, wave = __builtin_amdgcn_readfirstlane(tid >> 6);
    const int G = gridDim.x; const int bx = blockIdx.x; const int vcu = (G % 8 == 0) ? (bx % 8) * (G / 8) + bx / 8 : bx;
    unsigned char* ws = args.ws;
    gu32* ctl = (gu32*)(ws + WS_CTL);
    for (int u = tid; u < (LDS_BYTES - LDSCTL_OFF) / 4; u += NTHREADS) ((LAS unsigned*)(lds + LDSCTL_OFF))[u] = 0u;
    __syncthreads();
    XcdBarrier bar; bar.bar = (unsigned*)(ctl + CW_BAR); bar.x = 0; bar.st = nullptr;
    if (MK_ONE_LAUNCH) bar = xcd_barrier_post((unsigned*)(ctl + CW_BAR), MISC + 8);
    const int lo = args.ph_lo, hi = args.ph_hi;
#ifndef PH_MASK
#define PH_MASK 0xffff
#endif
#define IN(k) (((PH_MASK >> (k)) & 1) && lo <= (k) && (k) < hi)
#define SEAM(k) do { if (IN(k) && (k) + 1 < hi) xcd_barrier(bar); } while (0)
    const int gw = vcu * NWAVES + wave, NGW = G * NWAVES;
#define PH_BEGIN(k) if (IN(k)) { PHASE_IDS
#define PHASE_IDS int tid_p_ = threadIdx.x; asm volatile("" : "+v"(tid_p_)); const int tid = tid_p_, lane = tid_p_ & 63; (void)tid; (void)lane;

    bf16* const WIN = (bf16*)(ws + WS_WIN); bf16* const WOUT = (bf16*)(ws + WS_WOUT); bf16* const WQM = (bf16*)(ws + WS_WQM); bf16* const WKV = (bf16*)(ws + WS_WKV);
    bf16* const WOM = (bf16*)(ws + WS_WOM); bf16* const WGU = (bf16*)(ws + WS_WGU); bf16* const WD = (bf16*)(ws + WS_WD);
    bf16* const XN = (bf16*)(ws + WS_XN); bf16* const MEMN = (bf16*)(ws + WS_MEMN); bf16* const PROJ = (bf16*)(ws + WS_PROJ); bf16* const KVM = (bf16*)(ws + WS_KVM);
    bf16* const OPART = (bf16*)(ws + WS_OPART); bf16* const OB = (bf16*)(ws + WS_OB); float* const LPART = (float*)(ws + WS_LPART); bf16* const MIXED = (bf16*)(ws + WS_MIXED);
    float* const X1 = (float*)(ws + WS_X1); bf16* const QM = (bf16*)(ws + WS_QM); bf16* const OM = (bf16*)(ws + WS_OM); float* const AFF = (float*)(ws + WS_AFF);
    int* const IDX = (int*)(ws + WS_IDX); float* const GATE = (float*)(ws + WS_GATE); int* const INV = (int*)(ws + WS_INV);
    bf16* const XE = (bf16*)(ws + WS_XE); bf16* const ACT = (bf16*)(ws + WS_ACT); bf16* const YS = (bf16*)(ws + WS_YS);
    float* const OUT = args.out; float* const X2 = (float*)(ws + WS_X2);
    unsigned char* const XN8 = ws + WS_XE; unsigned char* const ACT8 = ws + WS_ACT;
    float* const SS1 = (float*)(ws + WS_SS1); float* const SS2 = (float*)(ws + WS_SS2); float* const RS = (float*)(ws + WS_RS);

    PH_BEGIN(0)
        CONVERT_RANGE(0, CT_P0A, vcu, G); CONVERT_RANGE(CT_P11END, T_TOTAL, vcu, G);
        for (int m = gw; m < TOK + BATCH * NMEM; m += NGW) {
            if (m < TOK) norm_row_bf16(args.in[0] + (size_t)m * DM, args.in[3], XN + (size_t)m * DM, lane);
            else norm_row_bf16(args.in[1] + (size_t)(m - TOK) * DM, args.in[14], MEMN + (size_t)(m - TOK) * DM, lane);
        }
    }
    SEAM(0);
    PH_BEGIN(1)
        const int xj = vcu & 31, xc = vcu >> 5; const bool split = (G == 256), conv = split && (xj >= 24); const int cj = (xj - 24) * 8 + xc;
        OrderP1 S{split ? 192 : G, split ? xj * 8 + xc : bx, conv ? cj : -1, (const char*)XN, (const char*)WIN, (const char*)MEMN, (const char*)WKV};
        pg8::EpiBf16 E{PROJ, 0, KVM, 2 * WMEM, TOK};
        pg8::gemm_phase<pg8::EpiBf16, OrderP1>(lds, DM * 2, DM * 2, S, E);
        if (conv) CONVERT_RANGE(CT_P0A, CT_P1END, cj, 64);
    }
    SEAM(1);
    PH_BEGIN(2)
        const int* pos = (const int*)args.in[2];
        const int pos16 = lane & 15, grp = lane >> 4, f0 = 8 * (pos16 & 7); const bool lowhalf = pos16 < 8;
        f32x4 gv[4][2];
#pragma unroll
        for (int v = 0; v < 4; ++v) { gv[v][0] = *(const GAS f32x4*)(args.in[5 + v] + 8 * pos16); gv[v][1] = *(const GAS f32x4*)(args.in[5 + v] + 8 * pos16 + 4); }
        for (int m = gw; m < TOK + BATCH * NMEM; m += NGW) {
            if (m < TOK) {
                const float inv_freq = exp2f(-(float)lane * (13.287712379549449f / 64.0f));
                const float ang = (float)pos[m] * inv_freq;
                const double ad = (double)ang; const double nrev = rint(ad * 0.15915494309189535); const float rf = (float)(ad - nrev * 6.283185307179586);
                const float cs = cosf(rf), sn = sinf(rf);
                float c8[8], s8[8];
#pragma unroll
                for (int j = 0; j < 8; ++j) { c8[j] = __shfl(cs, f0 + j); s8[j] = __shfl(sn, f0 + j); }
                bf16* row = PROJ + (size_t)m * HD + 8 * pos16;
                v4u x[7];
#pragma unroll
                for (int i = 0; i < 7; ++i) { const size_t off = (size_t)((i < 2 ? 0 : i < 4 ? 8 : i < 6 ? 24 : 32) + 4 * (i & 1) + grp) * TOK * HD;
                    x[i] = (i < 6 || grp < 2) ? *(const GAS v4u*)(row + off) : (v4u){0u, 0u, 0u, 0u}; }
#pragma unroll
                for (int i = 0; i < 7; ++i) { const size_t off = (size_t)((i < 2 ? 0 : i < 4 ? 8 : i < 6 ? 24 : 32) + 4 * (i & 1) + grp) * TOK * HD;
                    const int gi = i >> 1; const float sc = (gi == 0 || gi == 2) ? QSCALE : 1.f;
                    float t[8] = {bflo(x[i].x), bfhi(x[i].x), bflo(x[i].y), bfhi(x[i].y), bflo(x[i].z), bfhi(x[i].z), bflo(x[i].w), bfhi(x[i].w)};
                    float ss = 0.f;
#pragma unroll
                    for (int j = 0; j < 8; ++j) ss += t[j] * t[j];
                    ss += __shfl_xor(ss, 1); ss += __shfl_xor(ss, 2); ss += __shfl_xor(ss, 4); ss += __shfl_xor(ss, 8);
                    const float rstd = 1.0f / sqrtf(ss * (1.0f / HD) + EPS);
                    float o[8];
#pragma unroll
                    for (int j = 0; j < 8; ++j) { const float n = t[j] * rstd * gv[gi][j >> 2][j & 3]; const float p = __shfl_xor(n, 8);
                        o[j] = (lowhalf ? (n * c8[j] - p * s8[j]) : (n * c8[j] + p * s8[j])) * sc; }
                    const v4u w = (v4u){cvtpk(o[0], o[1]), cvtpk(o[2], o[3]), cvtpk(o[4], o[5]), cvtpk(o[6], o[7])};
                    if (i < 6 || grp < 2) *(GAS v4u*)(row + off) = w; }
            } else {
                bf16* row = KVM + (size_t)(m - TOK) * (2 * WMEM) + 128 * grp + 8 * pos16;
                const v4u xx = *(const GAS v4u*)row;
                float t[8] = {bflo(xx.x), bfhi(xx.x), bflo(xx.y), bfhi(xx.y), bflo(xx.z), bfhi(xx.z), bflo(xx.w), bfhi(xx.w)};
                float ss = 0.f;
#pragma unroll
                for (int j = 0; j < 8; ++j) ss += t[j] * t[j];
                ss += __shfl_xor(ss, 1); ss += __shfl_xor(ss, 2); ss += __shfl_xor(ss, 4); ss += __shfl_xor(ss, 8);
                const float rstd = 1.0f / sqrtf(ss * (1.0f / HD) + EPS);
                float o[8];
#pragma unroll
                for (int j = 0; j < 8; ++j) o[j] = t[j] * rstd * args.in[18][8 * pos16 + j] * args.in[17][8 * pos16 + j];
                *(GAS v4u*)row = (v4u){cvtpk(o[0], o[1]), cvtpk(o[2], o[3]), cvtpk(o[4], o[5]), cvtpk(o[6], o[7])};
            }
        }
    }
    SEAM(2);
    PH_BEGIN(3)
        const float negM2a = -(SQRT_HD * LOG2E) * gain_absmax(args.in[5], lane) * gain_absmax(args.in[6], lane);
        const float negM2b = -(SQRT_HD * LOG2E) * gain_absmax(args.in[7], lane) * gain_absmax(args.in[8], lane);
        const int pv = args.variant;
        for (int u0 = vcu; u0 < 1024; u0 += G) {
            const int u = (pv == 3) ? 768 + (u0 & 255) : (pv == 4 && u0 >= 768) ? (u0 & 255) : u0;
            if (u < 768) {
                const int xc = (u & 255) >> 5, Lh = (u & 31) + 32 * (u >> 8), pr = 2 * xc + Lh / 48, w = Lh % 48;
                const int gi = (pv == 1) ? 0 : (pv == 2) ? 2 : (w >> 4), b = pr >> 3, h = pr & 7, x = w & 15;
                const int dlog = 2 * gi, d = 1 << dlog, r = x & (d - 1), blk = x >> dlog;
                const int L = SEQ >> dlog, i0 = blk * 256, a = i0 + 32 * wave;
                const int tlo = (i0 >> 6) - 1 < 0 ? 0 : (i0 >> 6) - 1, thi = (i0 >> 6) + 5 > (L >> 6) ? (L >> 6) : (i0 >> 6) + 5;
                const size_t tok0 = (size_t)b * SEQ + r;
                att::attn_unit<true, false, false>(lds, PROJ + ((size_t)h * TOK + tok0 + (size_t)d * a) * HD, (long)d * HD,
                    PROJ + ((size_t)(8 + h) * TOK + tok0) * HD, PROJ + ((size_t)(16 + h) * TOK + tok0) * HD, (long)d * HD, tlo, thi, a, (pv == 5) ? -100000 : 64, negM2a, 0.f,
                    OPART + (size_t)gi * TOK * 1024 + (tok0 + (size_t)d * a) * 1024 + h * HD, (long)d * 1024, LPART + (size_t)gi * TOK * 8 + (tok0 + (size_t)d * a) * 8 + h, (long)d * 8, nullptr);
            } else {
                const int ub = u - 768, b = ub >> 7, kvh = (ub >> 6) & 1, blk = ub & 63;
                const int i0 = blk * 64, a = i0 + 32 * (wave & 1), head = kvh * 4 + (wave >> 1);
                const int tlo = blk - 2 < 0 ? 0 : blk - 2, thi = blk + 3 > 64 ? 64 : blk + 3;
                const size_t tok0 = (size_t)b * SEQ;
                const float lx = __builtin_amdgcn_exp2f(args.in[9][head] * LOG2E + negM2b);
                att::attn_unit<true, false, true>(lds, PROJ + ((size_t)(24 + head) * TOK + tok0 + a) * HD, (long)HD,
                    PROJ + ((size_t)(32 + kvh) * TOK + tok0) * HD, PROJ + ((size_t)(34 + kvh) * TOK + tok0) * HD, (long)HD, tlo, thi, a, (pv == 5) ? -100000 : 128, negM2b, lx,
                    OB + (tok0 + a) * 1024 + head * HD, 1024L, nullptr, 0L, nullptr);
            }
        }
    }
    SEAM(3);
    PH_BEGIN(4)
        for (int m = gw; m < TOK; m += NGW) {
            const int hd = lane >> 3; float oa[16], ob[16];
            float l = 0.f;
#pragma unroll
            for (int k = 0; k < 16; ++k) oa[k] = 0.f;
#pragma unroll
            for (int gi = 0; gi < 3; ++gi) { l += LPART[(size_t)gi * TOK * 8 + (size_t)m * 8 + hd];
                const GAS v4u* p = (const GAS v4u*)(OPART + (size_t)gi * TOK * 1024 + (size_t)m * 1024 + lane * 16);
#pragma unroll
                for (int q = 0; q < 2; ++q) { const v4u w = p[q]; oa[8 * q + 0] += bflo(w.x); oa[8 * q + 1] += bfhi(w.x); oa[8 * q + 2] += bflo(w.y); oa[8 * q + 3] += bfhi(w.y);
                    oa[8 * q + 4] += bflo(w.z); oa[8 * q + 5] += bfhi(w.z); oa[8 * q + 6] += bflo(w.w); oa[8 * q + 7] += bfhi(w.w); } }
            const float il = 1.0f / l; float ssa = 0.f, ssb = 0.f;
#pragma unroll
            for (int k = 0; k < 16; ++k) { oa[k] *= il; ssa += oa[k] * oa[k]; }
            { const GAS v4u* p = (const GAS v4u*)(OB + (size_t)m * 1024 + lane * 16);
#pragma unroll
              for (int q = 0; q < 2; ++q) { const v4u w = p[q]; ob[8 * q + 0] = bflo(w.x); ob[8 * q + 1] = bfhi(w.x); ob[8 * q + 2] = bflo(w.y); ob[8 * q + 3] = bfhi(w.y);
                  ob[8 * q + 4] = bflo(w.z); ob[8 * q + 5] = bfhi(w.z); ob[8 * q + 6] = bflo(w.w); ob[8 * q + 7] = bfhi(w.w); } }
#pragma unroll
            for (int k = 0; k < 16; ++k) ssb += ob[k] * ob[k];
            const float ra = 1.0f / sqrtf(wave_sum(ssa) * (1.0f / 1024.0f) + EPS), rb = 1.0f / sqrtf(wave_sum(ssb) * (1.0f / 1024.0f) + EPS);
            const float* ga = args.in[10] + lane * 16; const float* gb = args.in[11] + lane * 16;
            v4u wa[2], wb[2];
#pragma unroll
            for (int q = 0; q < 2; ++q) {
                wa[q] = (v4u){cvtpk(oa[8 * q] * ra * ga[8 * q], oa[8 * q + 1] * ra * ga[8 * q + 1]), cvtpk(oa[8 * q + 2] * ra * ga[8 * q + 2], oa[8 * q + 3] * ra * ga[8 * q + 3]),
                              cvtpk(oa[8 * q + 4] * ra * ga[8 * q + 4], oa[8 * q + 5] * ra * ga[8 * q + 5]), cvtpk(oa[8 * q + 6] * ra * ga[8 * q + 6], oa[8 * q + 7] * ra * ga[8 * q + 7])};
                wb[q] = (v4u){cvtpk(ob[8 * q] * rb * gb[8 * q], ob[8 * q + 1] * rb * gb[8 * q + 1]), cvtpk(ob[8 * q + 2] * rb * gb[8 * q + 2], ob[8 * q + 3] * rb * gb[8 * q + 3]),
                              cvtpk(ob[8 * q + 4] * rb * gb[8 * q + 4], ob[8 * q + 5] * rb * gb[8 * q + 5]), cvtpk(ob[8 * q + 6] * rb * gb[8 * q + 6], ob[8 * q + 7] * rb * gb[8 * q + 7])}; }
            GAS v4u* pa = (GAS v4u*)(MIXED + (size_t)m * DM + lane * 16); GAS v4u* pb = (GAS v4u*)(MIXED + (size_t)m * DM + 1024 + lane * 16);
            pa[0] = wa[0]; pa[1] = wa[1]; pb[0] = wb[0]; pb[1] = wb[1];
        }
    }
    SEAM(4);
    PH_BEGIN(5)
        OrderPlain S{G, bx, 32, 8, DM * 2, (const char*)MIXED, (const char*)WOUT};
        pg8::EpiResidX E{args.in[0], nullptr, nullptr, (args.variant == 3) ? nullptr : XN, nullptr, SS1, DM, args.variant};
        pg8::gemm_phase<pg8::EpiResidX, OrderPlain>(lds, DM * 2, DM * 2, S, E);
    }
    SEAM(5);
    PH_BEGIN(7)
        OrderPlain S{G, bx, 32, 2, DM * 2, (const char*)XN, (const char*)WQM};
        pg8::EpiBf16 E{QM, WMEM, QM, WMEM, 0};
        pg8::gemm_phase<pg8::EpiBf16, OrderPlain>(lds, DM * 2, DM * 2, S, E);
        if (bx >= 64 && CT_P7N > 0) CONVERT_RANGE(CT_P1END, CT_P7END, bx - 64, 192);
    }
    SEAM(7);
    PH_BEGIN(8)
        const float gg = wave_max(fmaxf(fabsf(args.in[17][lane] * args.in[18][lane]), fabsf(args.in[17][lane + 64] * args.in[18][lane + 64])));
        const float negM2c = -(SQRT_HD * LOG2E) * gg;
        if (vcu >= 128 && CT_P8N > 0) CONVERT_RANGE(CT_P7END, CT_P8END, vcu - 128, 128);
        for (int u = vcu; u < 128; u += G) {
            const int b = u >> 6, h = (u >> 4) & 3, blk = u & 15, a = blk * 256 + 32 * wave;
            const size_t tok0 = (size_t)b * SEQ;
            att::attn_unit<false, true, true>(lds, QM + (tok0 + a) * WMEM + h * HD, (long)WMEM, KVM + (size_t)b * NMEM * 2 * WMEM + h * HD, KVM + (size_t)b * NMEM * 2 * WMEM + WMEM + h * HD, 2L * WMEM,
                0, 4, a, 1 << 20, negM2c, 0.f, OM + (tok0 + a) * WMEM + h * HD, (long)WMEM, nullptr, 0L, SS1 + tok0 + a);
        }
    }
    SEAM(8);
    PH_BEGIN(9)
        OrderPlain S{G, bx, 32, 8, WMEM * 2, (const char*)OM, (const char*)WOM};
        pg8::EpiResidX E{nullptr, XN, X2, nullptr, XN8, SS2, DM, args.variant};
        pg8::gemm_phase<pg8::EpiResidX, OrderPlain>(lds, WMEM * 2, WMEM * 2, S, E);
    }
    SEAM(9);
    PH_BEGIN(10)
        LAS float* wrT = (LAS float*)lds;
        for (int i = tid; i < DM * NEXP / 4; i += NTHREADS) { const f32x4 w = *(const GAS f32x4*)(args.in[21] + 4 * i); const int k = i >> 2, e0 = (i & 3) * 4; const float g = args.in[20][k];
            wrT[(e0 + 0) * DM + k] = w.x * g; wrT[(e0 + 1) * DM + k] = w.y * g; wrT[(e0 + 2) * DM + k] = w.z * g; wrT[(e0 + 3) * DM + k] = w.w * g; }
        LDS_WAIT(); __syncthreads();
        for (int m = gw; m < TOK; m += 2 * NGW) {
            const int m2 = (m + NGW < TOK) ? m + NGW : m;
            const float* xa = X2 + (size_t)m * DM + lane * 4; const float* xb = X2 + (size_t)m2 * DM + lane * 4; f32x4 va[8], vb[8];
#pragma unroll
            for (int j = 0; j < 8; ++j) { va[j] = *(const GAS f32x4*)(xa + 256 * j); vb[j] = *(const GAS f32x4*)(xb + 256 * j); }
            float ssa = 0.f, ssb = 0.f;
#pragma unroll
            for (int j = 0; j < 8; ++j) { ssa += (va[j].x * va[j].x + va[j].y * va[j].y) + (va[j].z * va[j].z + va[j].w * va[j].w); ssb += (vb[j].x * vb[j].x + vb[j].y * vb[j].y) + (vb[j].z * vb[j].z + vb[j].w * vb[j].w); }
            float la[16], lb[16];
#pragma unroll
            for (int e = 0; e < 16; ++e) { float sa = 0.f, sb = 0.f;
#pragma unroll
                for (int j = 0; j < 8; ++j) { const f32x4 w = *(const LAS f32x4*)(wrT + e * DM + lane * 4 + 256 * j);
                    sa += (va[j].x * w.x + va[j].y * w.y) + (va[j].z * w.z + va[j].w * w.w); sb += (vb[j].x * w.x + vb[j].y * w.y) + (vb[j].z * w.z + vb[j].w * w.w); }
                la[e] = sa; lb[e] = sb; asm volatile("" ::: "memory"); }
            const float ra = 1.0f / sqrtf(wave_sum(ssa) * (1.0f / DM) + EPS), rb = 1.0f / sqrtf(wave_sum(ssb) * (1.0f / DM) + EPS);
#define XRED(v, out) do { float a8_[8], a4_[4], a2_[2]; \
                _Pragma("unroll") for (int e_ = 0; e_ < 8; ++e_) { const float k_ = (lane & 32) ? v[e_ + 8] : v[e_], s_ = (lane & 32) ? v[e_] : v[e_ + 8]; a8_[e_] = k_ + __shfl_xor(s_, 32); } \
                _Pragma("unroll") for (int e_ = 0; e_ < 4; ++e_) { const float k_ = (lane & 16) ? a8_[e_ + 4] : a8_[e_], s_ = (lane & 16) ? a8_[e_] : a8_[e_ + 4]; a4_[e_] = k_ + __shfl_xor(s_, 16); } \
                _Pragma("unroll") for (int e_ = 0; e_ < 2; ++e_) { const float k_ = (lane & 8) ? a4_[e_ + 2] : a4_[e_], s_ = (lane & 8) ? a4_[e_] : a4_[e_ + 2]; a2_[e_] = k_ + __shfl_xor(s_, 8); } \
                { const float k_ = (lane & 4) ? a2_[1] : a2_[0], s_ = (lane & 4) ? a2_[0] : a2_[1]; out = k_ + __shfl_xor(s_, 4); } \
                out += __shfl_xor(out, 2); out += __shfl_xor(out, 1); } while (0)
            float ta, tb; XRED(la, ta); XRED(lb, tb);
#undef XRED
            ta *= ra; tb *= rb;
            float mxa = ta, mxb = tb;
#pragma unroll
            for (int o = 4; o < 64; o <<= 1) { mxa = fmaxf(mxa, __shfl_xor(mxa, o)); mxb = fmaxf(mxb, __shfl_xor(mxb, o)); }
            const float exa = expf(ta - mxa), exb = expf(tb - mxb); float dna = exa, dnb = exb;
#pragma unroll
            for (int o = 4; o < 64; o <<= 1) { dna += __shfl_xor(dna, o); dnb += __shfl_xor(dnb, o); }
            if ((lane & 3) == 0) { const int e = lane >> 2;
                AFF[((size_t)(m >> 12) * NEXP + e) * SEQ + (m & (SEQ - 1))] = exa / dna;
                if (m2 != m) AFF[((size_t)(m2 >> 12) * NEXP + e) * SEQ + (m2 & (SEQ - 1))] = exb / dnb; }
        }
    }
    SEAM(10);
    PH_BEGIN(11)
        LAS unsigned* hist = (LAS unsigned*)lds; LAS unsigned* misc = hist + 256; LAS unsigned* wtot = hist + 272;
        if (vcu >= 32 && CT_P11N > 0) CONVERT_RANGE(CT_P8END, CT_P11END, vcu - 32, 224);
        for (int u = vcu; u < BATCH * NEXP; u += G) {
            const int b = u >> 4, e = u & 15; const float* aff = AFF + (size_t)u * SEQ;
            const f32x4 a0 = *(const GAS f32x4*)(aff + tid * 8), a1 = *(const GAS f32x4*)(aff + tid * 8 + 4);
            unsigned bits[8] = {__float_as_uint(a0.x), __float_as_uint(a0.y), __float_as_uint(a0.z), __float_as_uint(a0.w), __float_as_uint(a1.x), __float_as_uint(a1.y), __float_as_uint(a1.z), __float_as_uint(a1.w)};
            unsigned prefix = 0u, krem = CAP;
#pragma unroll 1
            for (int pass = 0; pass < 4; ++pass) { const int shift = 24 - 8 * pass;
                __syncthreads();
                if (tid < 256) hist[tid] = 0u;
                __syncthreads();
#pragma unroll
                for (int i = 0; i < 8; ++i) if (pass == 0 || (bits[i] >> (shift + 8)) == prefix) __hip_atomic_fetch_add(&hist[(bits[i] >> shift) & 255u], 1u, __ATOMIC_RELAXED, __HIP_MEMORY_SCOPE_WORKGROUP);
                __syncthreads();
                if (wave == 0) {
                    const unsigned h0 = hist[255 - 4 * lane], h1 = hist[254 - 4 * lane], h2 = hist[253 - 4 * lane], h3 = hist[252 - 4 * lane];
                    const unsigned s = h0 + h1 + h2 + h3; unsigned incl = s;
#pragma unroll
                    for (int o = 1; o < 64; o <<= 1) { const unsigned t = __shfl_up(incl, o); if (lane >= o) incl += t; }
                    const unsigned excl = incl - s;
                    if (excl < krem && krem <= incl) { unsigned rem = krem - excl; unsigned bin;
                        if (rem <= h0) bin = 255 - 4 * lane; else { rem -= h0; if (rem <= h1) bin = 254 - 4 * lane; else { rem -= h1; if (rem <= h2) bin = 253 - 4 * lane; else { rem -= h2; bin = 252 - 4 * lane; } } }
                        misc[0] = (prefix << 8) | bin; misc[1] = rem; }
                }
                __syncthreads();
                prefix = misc[0]; krem = misc[1];
            }
            unsigned ngt = 0u, neq = 0u;
#pragma unroll
            for (int i = 0; i < 8; ++i) { ngt += bits[i] > prefix; neq += bits[i] == prefix; }
            unsigned cnt = ngt | (neq << 16), incl = cnt;
#pragma unroll
            for (int o = 1; o < 64; o <<= 1) { const unsigned t = __shfl_up(incl, o); if (lane >= o) incl += t; }
            if (lane == 63) wtot[wave] = incl;
            __syncthreads();
            unsigned base = 0u;
#pragma unroll
            for (int w = 0; w < 8; ++w) if (w < wave) base += wtot[w];
            const unsigned excl = base + incl - cnt; unsigned gtb = excl & 0xffffu, eqb = excl >> 16;
            const int rowbase = (e * BATCH + b) * CAP;
            const float vals[8] = {a0.x, a0.y, a0.z, a0.w, a1.x, a1.y, a1.z, a1.w};
#pragma unroll
            for (int i = 0; i < 8; ++i) { const bool gt = bits[i] > prefix, eq = bits[i] == prefix; const bool sel = gt || (eq && eqb < krem);
                const int slot = (int)(gtb + (eqb < krem ? eqb : krem)); const int s = tid * 8 + i;
                if (sel) { IDX[rowbase + slot] = s; GATE[rowbase + slot] = vals[i]; RS[rowbase + slot] = 1.0f / sqrtf(SS2[(size_t)b * SEQ + s] * (1.0f / DM) + EPS); }
                INV[((size_t)b * SEQ + s) * NEXP + e] = sel ? rowbase + slot : -1;
                gtb += gt; eqb += eq; }
            __syncthreads();
        }
    }
    SEAM(11);
    PH_BEGIN(13)
        OrderMoeG S{G, bx, (const char*)XN8, (const char*)WGU, IDX};
        pg8::EpiSwiGlu8 E{ACT8, DFF, RS, 1.0f / (FP8_SX * FP8_SW), FP8_SA};
        pg8::gemm_phase<pg8::EpiSwiGlu8, OrderMoeG, true>(lds, DM, DM, S, E);
    }
    SEAM(13);
    PH_BEGIN(14)
        OrderMoe S{G, bx, 8, DFF, (const char*)ACT8, (const char*)WD};
        pg8::EpiScaleBf16 E{YS, DM, GATE, 1.0f / (FP8_SA * FP8_SW)};
        pg8::gemm_phase<pg8::EpiScaleBf16, OrderMoe, true>(lds, DFF, DFF, S, E);
    }
    SEAM(14);
    PH_BEGIN(15)
        for (int m0 = gw; m0 < TOK; m0 += 2 * NGW) {
            f32x4 acc[2][8]; int myr[2];
#pragma unroll
            for (int t = 0; t < 2; ++t) { const int m = m0 + t * NGW; if (m < TOK) { const float* xrow = X2 + (size_t)m * DM + lane * 4;
#pragma unroll
                    for (int j = 0; j < 8; ++j) acc[t][j] = *(const GAS f32x4*)(xrow + 256 * j);
                    myr[t] = (lane < NEXP) ? INV[(size_t)m * NEXP + lane] : -1; } else myr[t] = -1; }
#pragma unroll
            for (int t = 0; t < 2; ++t) { unsigned long long mask = __ballot(myr[t] >= 0);
                while (mask) { const int e = __builtin_ctzll(mask); mask &= mask - 1; const int r = __builtin_amdgcn_readlane(myr[t], e);
                    const GAS v2u* p = (const GAS v2u*)(YS + (size_t)r * DM + lane * 4);
#pragma unroll
                    for (int j = 0; j < 8; ++j) { const v2u w = p[64 * j]; acc[t][j].x += bflo(w.x); acc[t][j].y += bfhi(w.x); acc[t][j].z += bflo(w.y); acc[t][j].w += bfhi(w.y); } } }
#pragma unroll
            for (int t = 0; t < 2; ++t) { const int m = m0 + t * NGW; if (m < TOK) { float* orow = OUT + (size_t)m * DM + lane * 4;
#pragma unroll
                    for (int j = 0; j < 8; ++j) *(GAS f32x4*)(orow + 256 * j) = acc[t][j]; } }
        }
    }
#ifdef PROBE_XBAR
    for (int i_ = 0; i_ < PROBE_XBAR; ++i_) xcd_barrier(bar);
#endif
#undef IN
#undef SEAM
}

extern "C" void kernel_launch(void* const* d_in, const int* in_sizes, int n_in, void* d_out, int out_size, void* d_ws, size_t ws_size, hipStream_t stream) {
    static int grid = 0;
    if (grid == 0) {
        if (n_in != 25 || out_size != TOK * DM || ws_size < WS_END) { fprintf(stderr, "kernel_launch: unexpected problem (n_in %d out %d ws %zu)\n", n_in, out_size, ws_size); grid = -1; return; }
        int dev = 0, cus = 0;
        if (hipGetDevice(&dev) != hipSuccess || hipDeviceGetAttribute(&cus, hipDeviceAttributeMultiprocessorCount, dev) != hipSuccess) { grid = -1; return; }
        if (hipFuncSetAttribute((const void*)fwd_kernel, hipFuncAttributeMaxDynamicSharedMemorySize, LDS_BYTES) != hipSuccess) { fprintf(stderr, "kernel_launch: hipFuncSetAttribute failed\n"); grid = -1; return; }
        int per_cu = 0; (void)hipOccupancyMaxActiveBlocksPerMultiprocessor(&per_cu, (const void*)fwd_kernel, NTHREADS, LDS_BYTES); (void)hipGetLastError();
        grid = cus;
    }
    if (grid < 0) return;
    (void)hipMemsetAsync((char*)d_ws + WS_CTL, 0, CTL_ZERO_BYTES, stream);
    Args a{};
    for (int i = 0; i < 25; ++i) a.in[i] = (const float*)d_in[i];
    a.out = (float*)d_out; a.ws = (unsigned char*)d_ws;
#if MK_ONE_LAUNCH
    a.ph_lo = 0; a.ph_hi = NPHASE;
    hipLaunchKernelGGL(fwd_kernel, dim3(grid), dim3(NTHREADS), LDS_BYTES, stream, a);
#ifdef PROBE_RELAUNCH
#ifndef PROBE_VARIANT
#define PROBE_VARIANT 0
#endif
    for (int p = 0; p < NPHASE; ++p) if ((PROBE_RELAUNCH >> p) & 1) { a.ph_lo = p; a.ph_hi = p + 1; a.variant = PROBE_VARIANT; hipLaunchKernelGGL(fwd_kernel, dim3(grid), dim3(NTHREADS), LDS_BYTES, stream, a); }
#endif
#else
    for (int p = 0; p < NPHASE; ++p) { a.ph_lo = p; a.ph_hi = p + 1; hipLaunchKernelGGL(fwd_kernel, dim3(grid), dim3(NTHREADS), LDS_BYTES, stream, a); }
#endif
}
```

```cpp
#include <hip/hip_runtime.h>
#include <hip/hip_bf16.h>
#include <cstdio>
#include <cstdint>

#ifndef MK_ONE_LAUNCH
#define MK_ONE_LAUNCH 1
#endif

constexpr int BATCH = 2, SEQ = 4096, DM = 2048, TOK = BATCH * SEQ, HD = 128;
constexpr int DIN = 4608, NMEM = 256, WMEM = 512, NEXP = 16, CAP = 512, DFF = 2048;
constexpr int OFF_QA = 0, OFF_KA = 1024, OFF_VA = 2048, OFF_QB = 3072, OFF_KB = 4096, OFF_VB = 4352;
constexpr float EPS = 1e-6f;
constexpr float LOG2E = 1.4426950408889634f;
constexpr float QSCALE = 0.08838834764831845f * LOG2E;
constexpr float SQRT_HD = 11.313708498984761f;
constexpr float FP8_SY = 64.f;
constexpr float FP8_SW = 256.f, FP8_SX = 16.f, FP8_SA = 8.f;

namespace pg8 {
#define PG8_LAS __attribute__((address_space(3)))
typedef unsigned short bf16_t;
typedef short bf16x8 __attribute__((ext_vector_type(8)));
typedef float f32x4 __attribute__((ext_vector_type(4)));
typedef unsigned u32x4 __attribute__((ext_vector_type(4)));
typedef int i32x4 __attribute__((ext_vector_type(4)));
typedef int i32x8 __attribute__((ext_vector_type(8)));
typedef int i32x16 __attribute__((ext_vector_type(16)));
typedef int i32x32 __attribute__((ext_vector_type(32)));
constexpr int BM = 256, BK = 64, HALF = 128, HTB = HALF * BK * 2  , STAGE_BYTES = 8 * HTB, NXCD = 8, WGM = 8;

__host__ __device__ __forceinline__ int lds_byte(int r, int c) { const int st = (r >> 4) * 2 + (c >> 5), rr = r & 15, cc = c & 31, ob = rr * 64 + cc * 2; return st * 1024 + (ob ^ (((ob >> 9) & 1) << 5)); }
__host__ __device__ __forceinline__ void stage_rc(int b, int& R, int& C) { const int st = b / 1024, sb = b % 1024, swz = sb ^ (((sb >> 9) & 1) << 5); R = (st >> 1) * 16 + swz / 64; C = (st & 1) * 32 + (swz % 64) / 2; }
__host__ __device__ __forceinline__ int perm32(int rho) { const int n = rho >> 4, i = rho & 15; return 8 * (i >> 2) + 4 * n + (i & 3); }

struct Unit { int pm, pn, kind, seq; const char* A; const char* B; const int* rows; };

__device__ __forceinline__ bool static_order(int i, int G, int c, int nM, int nN, int& pm, int& pn, const int wgm = WGM) {
    const int nwg = nM * nN; const long L = (long)i * G + c; if (L >= nwg) return false;
    int wgid = (int)L; { const int q = nwg / NXCD, r = nwg % NXCD, xcd = wgid % NXCD, off = wgid / NXCD; wgid = (xcd < r ? xcd * (q + 1) : r * (q + 1) + (xcd - r) * q) + off; }
    const int nig = wgm * nN, gid = wgid / nig, fm = gid * wgm, gsz = (nM - fm) < wgm ? (nM - fm) : wgm;
    pm = fm + ((wgid % nig) % gsz); pn = (wgid % nig) / gsz; return true;
}

__device__ __forceinline__ float clamp8(float x) { return __builtin_amdgcn_fmed3f(x, -448.f, 448.f); }
__device__ __forceinline__ int cvt_fp8x4(float a, float b, float c, float d) { int w = 0; w = __builtin_amdgcn_cvt_pk_fp8_f32(clamp8(a), clamp8(b), w, false); return __builtin_amdgcn_cvt_pk_fp8_f32(clamp8(c), clamp8(d), w, true); }
__device__ __forceinline__ unsigned cvt_pk_bf16(float lo, float hi) { unsigned r; asm volatile("v_cvt_pk_bf16_f32 %0, %1, %2" : "=v"(r) : "v"(lo), "v"(hi)); return r; }

#define PG8_ZERO_INIT __device__ __forceinline__ void init(f32x4 (&acc)[2][2][4][2], const Unit&, int, int, int, int) const { \
        _Pragma("unroll") for (int a = 0; a < 2; ++a) _Pragma("unroll") for (int b = 0; b < 2; ++b) _Pragma("unroll") for (int m = 0; m < 4; ++m) _Pragma("unroll") for (int n = 0; n < 2; ++n) acc[a][b][m][n] = (f32x4){0.f, 0.f, 0.f, 0.f}; }
#define PG8_BPERM32 static constexpr int BHROWS = HALF; __host__ __device__ static __forceinline__ int bperm(int R) { return (R & ~31) + perm32(R & 31); }
struct EpiBf16 {
    static constexpr bool PERM = true, AFTER_DRAIN = false; PG8_BPERM32
    bf16_t* O0; int ldc0; bf16_t* O1; int ldc1; int hm_rows;
    PG8_ZERO_INIT
    __device__ __forceinline__ void operator()(const f32x4 (&acc)[2][2][4][2], const Unit& u, int wr, int wc, int fr, int fq) const {
        const bool hm = (u.kind == 0 && ldc0 == 0);
        bf16_t* base = u.kind ? O1 : O0; const int ldc = hm ? HALF : (u.kind ? ldc1 : ldc0);
        const int row0 = u.pm * BM + wr * 64 + fr, col0 = (hm ? 0 : u.pn * BM) + wc * 32 + 8 * fq;
        const size_t hstride = hm ? (size_t)hm_rows * HALF : (size_t)HALF;
        if (hm) base += (size_t)(2 * u.pn) * hm_rows * HALF;
#pragma unroll
        for (int ai = 0; ai < 2; ++ai)
#pragma unroll
            for (int m = 0; m < 4; ++m) { bf16_t* rowp = base + (size_t)(row0 + ai * HALF + m * 16) * ldc + col0;
#pragma unroll
                for (int bj = 0; bj < 2; ++bj) { const f32x4 v0 = acc[ai][bj][m][0], v1 = acc[ai][bj][m][1];
                    u32x4 w; w.x = cvt_pk_bf16(v0[0], v0[1]); w.y = cvt_pk_bf16(v0[2], v0[3]); w.z = cvt_pk_bf16(v1[0], v1[1]); w.w = cvt_pk_bf16(v1[2], v1[3]);
                    *(u32x4*)(rowp + bj * hstride) = w; } }
    }
};
struct EpiProj {
    static constexpr bool PERM = true, AFTER_DRAIN = false; static constexpr int BHROWS = HALF;
    __host__ __device__ static __forceinline__ int bperm(int R) { return 64 * ((R >> 4) & 1) + 16 * (R >> 5) + (R & 15); }
    bf16_t* PROJ; bf16_t* KVM; const float* gqa; const float* gka; const float* gqb; const float* gkb; const float* gkm; const float* gqm; const int* pos; PG8_LAS float* P; int tok;
    __device__ __forceinline__ void stage_gains() const { const int t = threadIdx.x;
        if (t < 128) { P[2560 + t] = gqa[t]; P[2560 + 128 + t] = gka[t]; P[2560 + 256 + t] = gqb[t]; P[2560 + 384 + t] = gkb[t]; P[2560 + 512 + t] = gkm[t] * gqm[t]; } }
    __device__ __forceinline__ void init(f32x4 (&acc)[2][2][4][2], const Unit& u, int, int, int, int) const {
        _Pragma("unroll") for (int a = 0; a < 2; ++a) _Pragma("unroll") for (int b = 0; b < 2; ++b) _Pragma("unroll") for (int m = 0; m < 4; ++m) _Pragma("unroll") for (int n = 0; n < 2; ++n) acc[a][b][m][n] = (f32x4){0.f, 0.f, 0.f, 0.f};
        const int t = threadIdx.x; if (u.kind == 0 && t < 256) { unsigned keep_; const unsigned dst_ = (unsigned)(size_t)(P + 2048 + (u.seq & 1) * 256) + (unsigned)__builtin_amdgcn_readfirstlane(t & ~63) * 4u;
            asm volatile("s_mov_b32 %0, m0\n\ts_mov_b32 m0, %2\n\ts_nop 2\n\tglobal_load_lds_dword %1, %3\n\ts_mov_b32 m0, %0" : "=&s"(keep_) : "v"(t * 4), "s"(dst_), "s"(pos + u.pm * BM) : "memory"); } }
    __device__ __forceinline__ void operator()(const f32x4 (&acc)[2][2][4][2], const Unit& u, int wr, int wc, int fr, int fq) const {
        typedef unsigned u32x2 __attribute__((ext_vector_type(2)));
        const int d0 = 16 * wc + 4 * fq, row0 = u.pm * BM + wr * 64 + fr;
        int mode = 0, gsel = 0; float sc = 1.f;
        if (u.kind == 0) { if (u.pn < 4) { mode = 1; gsel = 0; sc = QSCALE; } else if (u.pn < 8) { mode = 1; gsel = 1; } else if (u.pn < 12) mode = 0; else if (u.pn < 16) { mode = 1; gsel = 2; sc = QSCALE; } else if (u.pn == 16) { mode = 1; gsel = 3; } }
        else if (u.pn < 2) { mode = 2; gsel = 4; }
        bf16_t* base; size_t rstride, hstride;
        if (u.kind == 0) { base = PROJ + (size_t)(2 * u.pn) * tok * HALF + d0; rstride = HALF; hstride = (size_t)tok * HALF; }
        else { base = KVM + u.pn * BM + d0; rstride = 1024; hstride = HALF; }
        if (mode == 0) {
#pragma unroll
            for (int ai = 0; ai < 2; ++ai)
#pragma unroll
                for (int m = 0; m < 4; ++m) { bf16_t* rowp = base + (size_t)(row0 + ai * HALF + m * 16) * rstride;
#pragma unroll
                    for (int bj = 0; bj < 2; ++bj) { const f32x4 v0 = acc[ai][bj][m][0], v1 = acc[ai][bj][m][1];
                        *(u32x2*)(rowp + bj * hstride) = (u32x2){cvt_pk_bf16(v0[0], v0[1]), cvt_pk_bf16(v0[2], v0[3])}; *(u32x2*)(rowp + bj * hstride + 64) = (u32x2){cvt_pk_bf16(v1[0], v1[1]), cvt_pk_bf16(v1[2], v1[3])}; } }
            return; }
        float posf[2][4];
#pragma unroll
        for (int ai = 0; ai < 2; ++ai)
#pragma unroll
            for (int m = 0; m < 4; ++m) posf[ai][m] = 0.f;
        f32x4 kf;
#pragma unroll
        for (int j = 0; j < 4; ++j) kf[j] = exp2f(-(float)(d0 + j) * (13.287712379549449f / 64.0f)) * 0.15915494309189535f;
#pragma unroll
        for (int ai = 0; ai < 2; ++ai)
#pragma unroll
            for (int m = 0; m < 4; ++m)
#pragma unroll
                for (int bj = 0; bj < 2; ++bj) { const f32x4 v0 = acc[ai][bj][m][0], v1 = acc[ai][bj][m][1];
                    float sq = ((v0[0] * v0[0] + v0[1] * v0[1]) + (v0[2] * v0[2] + v0[3] * v0[3])) + ((v1[0] * v1[0] + v1[1] * v1[1]) + (v1[2] * v1[2] + v1[3] * v1[3]));
                    sq += __shfl_xor(sq, 16); sq += __shfl_xor(sq, 32);
                    if (fq == 0) P[((ai * HALF + wr * 64 + m * 16 + fr) * 2 + bj) * 4 + wc] = sq; }
        asm volatile("s_waitcnt lgkmcnt(0)\n\ts_barrier" ::: "memory");
        const f32x4 ga = *(const PG8_LAS f32x4*)(P + 2560 + gsel * 128 + d0) * sc, gb = *(const PG8_LAS f32x4*)(P + 2560 + gsel * 128 + d0 + 64) * sc;
        if (mode == 1) {
#pragma unroll
            for (int ai = 0; ai < 2; ++ai)
#pragma unroll
                for (int m = 0; m < 4; ++m) posf[ai][m] = (float)((const PG8_LAS int*)P)[2048 + (u.seq & 1) * 256 + ai * HALF + wr * 64 + m * 16 + fr]; }
#pragma unroll
        for (int ai = 0; ai < 2; ++ai)
#pragma unroll
            for (int m = 0; m < 4; ++m) { const int rl = ai * HALF + wr * 64 + m * 16 + fr, row = u.pm * BM + rl; bf16_t* rowp = base + (size_t)row * rstride;
                f32x4 c4 = (f32x4){1.f, 1.f, 1.f, 1.f}, s4 = (f32x4){0.f, 0.f, 0.f, 0.f};
                if (mode == 1) {
#pragma unroll
                    for (int j = 0; j < 4; ++j) { const float fr_ = __builtin_amdgcn_fractf(posf[ai][m] * kf[j]); c4[j] = __builtin_amdgcn_cosf(fr_); s4[j] = __builtin_amdgcn_sinf(fr_); } }
#pragma unroll
                for (int bj = 0; bj < 2; ++bj) { const f32x4 pp = *(const PG8_LAS f32x4*)(P + (rl * 2 + bj) * 4);
                    const float rstd = __builtin_amdgcn_rsqf(((pp[0] + pp[1]) + (pp[2] + pp[3])) * (1.0f / HALF) + EPS);
                    const f32x4 n1 = acc[ai][bj][m][0] * rstd * ga, n2 = acc[ai][bj][m][1] * rstd * gb;
                    const f32x4 o1 = n1 * c4 - n2 * s4, o2 = n2 * c4 + n1 * s4;
                    *(u32x2*)(rowp + bj * hstride) = (u32x2){cvt_pk_bf16(o1[0], o1[1]), cvt_pk_bf16(o1[2], o1[3])}; *(u32x2*)(rowp + bj * hstride + 64) = (u32x2){cvt_pk_bf16(o2[0], o2[1]), cvt_pk_bf16(o2[2], o2[3])}; }
            }
    }
};
struct EpiResidX {
    static constexpr bool PERM = true, AFTER_DRAIN = false; static constexpr int BHROWS = 8;
    __host__ __device__ static __forceinline__ int bperm(int R) { return 64 * ((R >> 5) & 3) + 16 * ((R >> 2) & 3) + 4 * ((R >> 4) & 1) + (R & 3); }
    const float* base; const bf16_t* baseb; float* out; bf16_t* xb; unsigned char* x8; float* ss; int ldc; int pv;
    __device__ __forceinline__ void init(f32x4 (&acc)[2][2][4][2], const Unit& u, int wr, int wc, int fr, int fq) const {
        const int row0 = u.pm * BM + wr * 64 + fr, col0 = u.pn * BM + wc * 64 + 16 * fq;
#pragma unroll
        for (int ai = 0; ai < 2; ++ai)
#pragma unroll
            for (int m = 0; m < 4; ++m) { const size_t off = (size_t)(row0 + ai * HALF + m * 16) * ldc + col0;
#pragma unroll
                for (int bj = 0; bj < 2; ++bj) {
                    if (pv == 2) { acc[ai][bj][m][0] = (f32x4){0.f, 0.f, 0.f, 0.f}; acc[ai][bj][m][1] = (f32x4){0.f, 0.f, 0.f, 0.f}; }
                    else if (base) { acc[ai][bj][m][0] = *(const f32x4*)(base + off + bj * 8); acc[ai][bj][m][1] = *(const f32x4*)(base + off + bj * 8 + 4); }
                    else { const u32x4 w = *(const u32x4*)(baseb + off + bj * 8);
                        acc[ai][bj][m][0] = (f32x4){__uint_as_float(w.x << 16), __uint_as_float(w.x & 0xffff0000u), __uint_as_float(w.y << 16), __uint_as_float(w.y & 0xffff0000u)};
                        acc[ai][bj][m][1] = (f32x4){__uint_as_float(w.z << 16), __uint_as_float(w.z & 0xffff0000u), __uint_as_float(w.w << 16), __uint_as_float(w.w & 0xffff0000u)}; } } }
    }
    __device__ __forceinline__ void operator()(const f32x4 (&acc)[2][2][4][2], const Unit& u, int wr, int wc, int fr, int fq) const {
        const int row0 = u.pm * BM + wr * 64 + fr, col0 = u.pn * BM + wc * 64 + 16 * fq;
#pragma unroll
        for (int ai = 0; ai < 2; ++ai)
#pragma unroll
            for (int m = 0; m < 4; ++m) { const int row = row0 + ai * HALF + m * 16; const size_t off = (size_t)row * ldc + col0; float sq = 0.f; int w8[4];
#pragma unroll
                for (int bj = 0; bj < 2; ++bj) { const f32x4 v0 = acc[ai][bj][m][0], v1 = acc[ai][bj][m][1];
                    if (out) { *(f32x4*)(out + off + bj * 8) = v0; *(f32x4*)(out + off + bj * 8 + 4) = v1; }
                    sq += ((v0[0] * v0[0] + v0[1] * v0[1]) + (v0[2] * v0[2] + v0[3] * v0[3])) + ((v1[0] * v1[0] + v1[1] * v1[1]) + (v1[2] * v1[2] + v1[3] * v1[3]));
                    if (xb) { u32x4 w; w.x = cvt_pk_bf16(v0[0], v0[1]); w.y = cvt_pk_bf16(v0[2], v0[3]); w.z = cvt_pk_bf16(v1[0], v1[1]); w.w = cvt_pk_bf16(v1[2], v1[3]); *(u32x4*)(xb + off + bj * 8) = w; }
                    if (x8) { w8[2 * bj] = cvt_fp8x4(v0[0] * FP8_SX, v0[1] * FP8_SX, v0[2] * FP8_SX, v0[3] * FP8_SX); w8[2 * bj + 1] = cvt_fp8x4(v1[0] * FP8_SX, v1[1] * FP8_SX, v1[2] * FP8_SX, v1[3] * FP8_SX); } }
                if (x8) *(i32x4*)(x8 + off) = (i32x4){w8[0], w8[1], w8[2], w8[3]};
                sq += __shfl_xor(sq, 16); sq += __shfl_xor(sq, 32);
                if (fq == 0 && pv != 1) atomicAdd(ss + row, sq); }
    }
};
struct EpiSwiGlu8 {
    static constexpr bool PERM = true, AFTER_DRAIN = false; PG8_BPERM32
    unsigned char* O; int ldc; const float* rs; float si, so; PG8_LAS float* L;
#define SRC rs
    __device__ __forceinline__ void init(f32x4 (&acc)[2][2][4][2], const Unit& u, int, int, int, int) const {
        _Pragma("unroll") for (int a = 0; a < 2; ++a) _Pragma("unroll") for (int b = 0; b < 2; ++b) _Pragma("unroll") for (int m = 0; m < 4; ++m) _Pragma("unroll") for (int n = 0; n < 2; ++n) acc[a][b][m][n] = (f32x4){0.f, 0.f, 0.f, 0.f};
        const int t = threadIdx.x; if (t < 256) { unsigned keep_; const unsigned dst_ = (unsigned)(size_t)(L + (u.seq & 1) * 256) + (unsigned)__builtin_amdgcn_readfirstlane(t & ~63) * 4u;
            asm volatile("s_mov_b32 %0, m0\n\ts_mov_b32 m0, %2\n\ts_nop 2\n\tglobal_load_lds_dword %1, %3\n\ts_mov_b32 m0, %0" : "=&s"(keep_) : "v"(t * 4), "s"(dst_), "s"(SRC + u.pm * BM) : "memory"); } }
#undef SRC
    __device__ __forceinline__ float sw(float g, float u) const { return g * u * __builtin_amdgcn_rcpf(1.0f + __builtin_amdgcn_exp2f(-g * LOG2E)); }
    __device__ __forceinline__ void operator()(const f32x4 (&acc)[2][2][4][2], const Unit& u, int wr, int wc, int fr, int fq) const {
        const int row0 = u.pm * BM + wr * 64 + fr, col0 = u.pn * HALF + wc * 32 + 8 * fq;
#pragma unroll
        for (int ai = 0; ai < 2; ++ai)
#pragma unroll
            for (int m = 0; m < 4; ++m) { const int row = row0 + ai * HALF + m * 16; const float r = L[(u.seq & 1) * 256 + ai * HALF + wr * 64 + m * 16 + fr] * si; unsigned char* rowp = O + (size_t)row * ldc + col0;
                typedef float f32x2_ __attribute__((ext_vector_type(2))); const float c1 = -r * LOG2E, c2 = r * r * so; int w[2];
#pragma unroll
                for (int n = 0; n < 2; ++n) { const f32x4 a4 = acc[ai][0][m][n], b4 = acc[ai][1][m][n]; f32x2_ p[2];
#pragma unroll
                    for (int h = 0; h < 2; ++h) { const f32x2_ a = {a4[2 * h], a4[2 * h + 1]}, b = {b4[2 * h], b4[2 * h + 1]}; const f32x2_ t = a * c1;
                        f32x2_ d = {__builtin_amdgcn_exp2f(t.x), __builtin_amdgcn_exp2f(t.y)}; d = d + 1.0f; const f32x2_ q = {__builtin_amdgcn_rcpf(d.x), __builtin_amdgcn_rcpf(d.y)};
                        p[h] = ((a * b) * c2) * q; }
                    w[n] = cvt_fp8x4(p[0].x, p[0].y, p[1].x, p[1].y); }
                typedef int i32x2 __attribute__((ext_vector_type(2))); *(i32x2*)rowp = (i32x2){w[0], w[1]}; }
    }
};
struct EpiScaleBf16 {
    static constexpr bool PERM = true, AFTER_DRAIN = false; static constexpr int BHROWS = 8;
    __host__ __device__ static __forceinline__ int bperm(int R) { return 64 * ((R >> 5) & 3) + 16 * ((R >> 2) & 3) + 4 * ((R >> 4) & 1) + (R & 3); }
    unsigned char* O; int ldc; const float* rowscale; float cs; PG8_LAS float* L;
#define SRC rowscale
    __device__ __forceinline__ void init(f32x4 (&acc)[2][2][4][2], const Unit& u, int, int, int, int) const {
        _Pragma("unroll") for (int a = 0; a < 2; ++a) _Pragma("unroll") for (int b = 0; b < 2; ++b) _Pragma("unroll") for (int m = 0; m < 4; ++m) _Pragma("unroll") for (int n = 0; n < 2; ++n) acc[a][b][m][n] = (f32x4){0.f, 0.f, 0.f, 0.f};
        const int t = threadIdx.x; if (t < 256) { unsigned keep_; const unsigned dst_ = (unsigned)(size_t)(L + (u.seq & 1) * 256) + (unsigned)__builtin_amdgcn_readfirstlane(t & ~63) * 4u;
            asm volatile("s_mov_b32 %0, m0\n\ts_mov_b32 m0, %2\n\ts_nop 2\n\tglobal_load_lds_dword %1, %3\n\ts_mov_b32 m0, %0" : "=&s"(keep_) : "v"(t * 4), "s"(dst_), "s"(SRC + u.pm * BM) : "memory"); } }
#undef SRC
    __device__ __forceinline__ void operator()(const f32x4 (&acc)[2][2][4][2], const Unit& u, int wr, int wc, int fr, int fq) const {
        const int row0 = u.pm * BM + wr * 64 + fr, col0 = u.pn * BM + wc * 64 + 16 * fq;
#pragma unroll
        for (int ai = 0; ai < 2; ++ai)
#pragma unroll
            for (int m = 0; m < 4; ++m) { const int row = row0 + ai * HALF + m * 16; const float s = L[(u.seq & 1) * 256 + ai * HALF + wr * 64 + m * 16 + fr] * cs; unsigned char* rowp = O + (size_t)row * ldc + col0;
                int w[4];
#pragma unroll
                for (int bj = 0; bj < 2; ++bj) { const f32x4 v0 = acc[ai][bj][m][0] * s, v1 = acc[ai][bj][m][1] * s; w[2 * bj] = cvt_fp8x4(v0[0], v0[1], v0[2], v0[3]); w[2 * bj + 1] = cvt_fp8x4(v1[0], v1[1], v1[2], v1[3]); }
                *(i32x4*)rowp = (i32x4){w[0], w[1], w[2], w[3]}; }
    }
};

struct NoPre { static constexpr bool ON = false; __device__ __forceinline__ void arrive() const {} __device__ __forceinline__ void wait() const {} };
template <class Epi, class Sched, bool FP8 = false, bool ALIGN_EPI = true, class Pre = NoPre>
__device__ __forceinline__ void gemm_phase(PG8_LAS unsigned char* lds, const int KB, const int ldbB, const Sched& S, const Epi& E, const Pre& pre = Pre()) {
    const int tid = threadIdx.x, wid = __builtin_amdgcn_readfirstlane(tid >> 6), lane = tid & 63, wr = wid >> 2, wc = wid & 3, fr = lane & 15, fq = lane >> 4;
    const int nt = KB / (BK * 2);
    int RA[2], CA[2]; unsigned voffB[2];
#pragma unroll
    for (int i = 0; i < 2; ++i) { int R, C; stage_rc(tid * 16 + i * 8192, R, C); const int Rb = Epi::bperm(R);
        RA[i] = R; CA[i] = C; voffB[i] = (unsigned)(Rb * ldbB + C * 2); }
    const size_t kstep = (size_t)(BK * 2);
    const size_t hstep = (size_t)Epi::BHROWS * ldbB;
    const unsigned ldsw = (unsigned)wid * 1024u;
    const int aoff = lds_byte(wr * 64 + fr, fq * 8), boff = lds_byte(wc * 32 + fr, fq * 8);
#define PG8_SA(b, h) (((b) * 2 + (h)) * HTB)
#define PG8_SB(b, h) ((4 + (b) * 2 + (h)) * HTB)
#define PG8_STAGE(bufoff, gbase, voff) do { _Pragma("unroll") for (int _i = 0; _i < 2; ++_i) \
        __builtin_amdgcn_global_load_lds((const unsigned*)((const char*)(gbase) + (voff)[_i]), (PG8_LAS unsigned*)(lds + (bufoff) + ldsw + _i * 8192), 16, 0, 0); } while (0)
#define PG8_RD(off_) (*(const PG8_LAS i32x4*)(lds + (off_)))
#define PG8_LDA(dst, b, h) do { _Pragma("unroll") for (int m = 0; m < 4; ++m) { \
        if constexpr (FP8) { const i32x4 lo_ = PG8_RD(PG8_SA(b, h) + aoff + m * 2048), hi_ = PG8_RD(PG8_SA(b, h) + aoff + m * 2048 + 1024); _Pragma("unroll") for (int e_ = 0; e_ < 4; ++e_) { dst##8[8 * m + e_] = lo_[e_]; dst##8[8 * m + 4 + e_] = hi_[e_]; } } \
        else { _Pragma("unroll") for (int k = 0; k < 2; ++k) dst[m][k] = *(const PG8_LAS bf16x8*)(lds + PG8_SA(b, h) + aoff + m * 2048 + k * 1024); } } } while (0)
#define PG8_LDB(dst, b, h) do { _Pragma("unroll") for (int n = 0; n < 2; ++n) { \
        if constexpr (FP8) { const i32x4 lo_ = PG8_RD(PG8_SB(b, h) + boff + n * 2048), hi_ = PG8_RD(PG8_SB(b, h) + boff + n * 2048 + 1024); _Pragma("unroll") for (int e_ = 0; e_ < 4; ++e_) { dst##8[8 * n + e_] = lo_[e_]; dst##8[8 * n + 4 + e_] = hi_[e_]; } } \
        else { _Pragma("unroll") for (int k = 0; k < 2; ++k) dst[n][k] = *(const PG8_LAS bf16x8*)(lds + PG8_SB(b, h) + boff + n * 2048 + k * 1024); } } } while (0)
#define PG8_SUB8(v, i) ((i32x8){v[8 * (i)], v[8 * (i) + 1], v[8 * (i) + 2], v[8 * (i) + 3], v[8 * (i) + 4], v[8 * (i) + 5], v[8 * (i) + 6], v[8 * (i) + 7]})
#define PG8_MMA(ai, bj, At, Bt) do { __builtin_amdgcn_s_setprio(1); _Pragma("unroll") for (int m = 0; m < 4; ++m) _Pragma("unroll") for (int n = 0; n < 2; ++n) { \
        if constexpr (FP8) asm volatile("v_mfma_scale_f32_16x16x128_f8f6f4 %0, %1, %2, %0, %3, %3 op_sel_hi:[0,0,0]" : "+v"(acc[ai][bj][m][n]) : "v"(PG8_SUB8(Bt##8, n)), "v"(PG8_SUB8(At##8, m)), "v"(sc1)); \
        else { _Pragma("unroll") for (int k = 0; k < 2; ++k) acc[ai][bj][m][n] = __builtin_amdgcn_mfma_f32_16x16x32_bf16(Bt[n][k], At[m][k], acc[ai][bj][m][n], 0, 0, 0); } } \
        __builtin_amdgcn_s_setprio(0); } while (0)
#define PG8_WAIT_V(n) asm volatile("s_waitcnt vmcnt(" #n ")" ::: "memory")
#define PG8_WAIT_L(n) asm volatile("s_waitcnt lgkmcnt(" #n ")" ::: "memory")
#define PG8_BAR __builtin_amdgcn_s_barrier()
#define PG8_SCHED __builtin_amdgcn_sched_barrier(0)
    Unit cur, nxt; int ui = 0;
    if (!S.next(0, cur)) return;
    cur.seq = 0;
    unsigned vAc[2][2], vAn[2][2];
    S.a_offs(cur, RA, CA, vAc);
    f32x4 acc[2][2][4][2];
    if constexpr (Pre::ON) { pre.arrive(); if (wid != 0) E.init(acc, cur, wr, wc, fr, fq); pre.wait(); if (wid == 0) E.init(acc, cur, wr, wc, fr, fq); }
    else E.init(acc, cur, wr, wc, fr, fq);
    const int sc1 = 0x7F7F7F7F;
    bf16x8 At[4][2], B0[2][2], B1[2][2]; i32x32 At8; i32x16 B08, B18;
    const char* cA = cur.A; const char* cB = cur.B;
    PG8_STAGE(PG8_SB(0, 0), cB, voffB); PG8_STAGE(PG8_SB(0, 1), cB + hstep, voffB); PG8_STAGE(PG8_SA(0, 0), cA, vAc[0]); PG8_STAGE(PG8_SA(0, 1), cA, vAc[1]);
    if (wr == 1) PG8_BAR;
    PG8_WAIT_V(2); PG8_BAR;
    PG8_STAGE(PG8_SB(1, 0), cB + kstep, voffB); PG8_STAGE(PG8_SA(1, 0), cA + kstep, vAc[0]); PG8_STAGE(PG8_SB(1, 1), cB + hstep + kstep, voffB);
    PG8_WAIT_V(6); PG8_BAR;
    for (;;) {
        const bool has_next = S.next(ui + 1, nxt); nxt.seq = ui + 1;
        const char* nA = has_next ? nxt.A : cA; const char* nB = has_next ? nxt.B : cB;
        if (Sched::GATHER && has_next) S.a_offs(nxt, RA, CA, vAn);
        else {
#pragma unroll
            for (int h = 0; h < 2; ++h)
#pragma unroll
                for (int i = 0; i < 2; ++i) vAn[h][i] = vAc[h][i]; }
        for (int t = 0; t < nt; t += 2) {
            const bool last = (t == nt - 2);
            const char* a1 = cA + (size_t)(t + 1) * kstep;
            const char* a2 = last ? nA : cA + (size_t)(t + 2) * kstep; const char* b2 = last ? nB : cB + (size_t)(t + 2) * kstep;
            const char* a3 = a2 + kstep; const char* b3 = b2 + kstep;
            unsigned o2[2][2];
#pragma unroll
            for (int h = 0; h < 2; ++h)
#pragma unroll
                for (int i = 0; i < 2; ++i) o2[h][i] = (Sched::GATHER && last) ? vAn[h][i] : vAc[h][i];
            if (last && has_next) S.a_ready(nxt);
            PG8_LDB(B0, 0, 0); PG8_LDB(B1, 0, 1); PG8_SCHED; PG8_LDA(At, 0, 0); PG8_STAGE(PG8_SA(1, 1), a1, vAc[1]);
            PG8_WAIT_V(8); PG8_WAIT_L(0); PG8_BAR; PG8_MMA(0, 0, At, B0); PG8_MMA(0, 1, At, B1); PG8_BAR; PG8_SCHED;
            PG8_LDA(At, 0, 1); PG8_STAGE(PG8_SB(0, 0), b2, voffB); PG8_STAGE(PG8_SB(0, 1), b2 + hstep, voffB); PG8_STAGE(PG8_SA(0, 0), a2, o2[0]);
            PG8_WAIT_V(8); PG8_WAIT_L(0); PG8_BAR; PG8_MMA(1, 0, At, B0); PG8_MMA(1, 1, At, B1); PG8_BAR; PG8_SCHED;
            PG8_LDB(B0, 1, 0); PG8_LDB(B1, 1, 1); PG8_SCHED; PG8_LDA(At, 1, 0); PG8_STAGE(PG8_SA(0, 1), a2, o2[1]);
            PG8_WAIT_V(8); PG8_WAIT_L(0); PG8_BAR; PG8_MMA(0, 0, At, B0); PG8_MMA(0, 1, At, B1); PG8_BAR; PG8_SCHED;
            PG8_LDA(At, 1, 1); PG8_STAGE(PG8_SB(1, 0), b3, voffB); PG8_STAGE(PG8_SB(1, 1), b3 + hstep, voffB); PG8_STAGE(PG8_SA(1, 0), a3, o2[0]);
            PG8_WAIT_V(8); PG8_WAIT_L(0); PG8_BAR; PG8_MMA(1, 0, At, B0); PG8_MMA(1, 1, At, B1); PG8_BAR; PG8_SCHED;
        }
        if constexpr (ALIGN_EPI) { if (wr == 0) PG8_BAR; }
        if constexpr (FP8) asm volatile("s_nop 15\n\ts_nop 15" ::: "memory");
        E(acc, cur, wr, wc, fr, fq); S.done(cur);
        if (!has_next) break;
        E.init(acc, nxt, wr, wc, fr, fq);
        cur = nxt; cA = nA; cB = nB; ++ui;
#pragma unroll
        for (int h = 0; h < 2; ++h)
#pragma unroll
            for (int i = 0; i < 2; ++i) vAc[h][i] = vAn[h][i];
        if constexpr (ALIGN_EPI) { if (wr == 1) PG8_BAR; }
    }
    PG8_WAIT_V(0);
    if constexpr (!ALIGN_EPI) { if (wr == 0) PG8_BAR; }
    PG8_BAR;
#undef PG8_SA
#undef PG8_SB
#undef PG8_STAGE
#undef PG8_LDA
#undef PG8_LDB
#undef PG8_MMA
#undef PG8_WAIT_V
#undef PG8_WAIT_L
#undef PG8_BAR
#undef PG8_SCHED
}
}

#define GAS __attribute__((address_space(1)))
#define LAS __attribute__((address_space(3)))
typedef unsigned short bf16;
typedef unsigned v4u __attribute__((ext_vector_type(4)));
typedef float f32x4 __attribute__((ext_vector_type(4)));
typedef short bf16x8 __attribute__((ext_vector_type(8)));
typedef GAS unsigned gu32;
typedef GAS unsigned long long gu64;
#define RLX_AGENT __ATOMIC_RELAXED, __HIP_MEMORY_SCOPE_AGENT
#define LDS_WAIT() asm volatile("s_waitcnt lgkmcnt(0)" ::: "memory")
#define VM_WAIT() asm volatile("s_waitcnt vmcnt(0)" ::: "memory")
__device__ __forceinline__ unsigned long long rt() { return __builtin_amdgcn_s_memrealtime(); }
__device__ __forceinline__ unsigned f2bf(float f) { unsigned u = __builtin_bit_cast(unsigned, f); return (u + 0x7fffu + ((u >> 16) & 1u)) >> 16; }
__device__ __forceinline__ unsigned pk2(float lo, float hi) { return f2bf(lo) | (f2bf(hi) << 16); }

#define XB_TMO      128
#define XB_XCNT(j)  (256  + 64 * (j))
#define XB_XSUB(j)  (1280 + 64 * (j))
#define XB_XGEN(j)  (2304 + 64 * (j))
#define XB_TOP      3328
#define XB_TOPGEN   3392
#define XCD_BAR_WORDS 3456
#define XB_SPIN_CAP (1u << 18)

__device__ __forceinline__ unsigned xb_ld(unsigned* p)              { return __hip_atomic_load(p, __ATOMIC_RELAXED, __HIP_MEMORY_SCOPE_AGENT); }
__device__ __forceinline__ unsigned xb_add(unsigned* p, unsigned v) { return __hip_atomic_fetch_add(p, v, __ATOMIC_RELAXED, __HIP_MEMORY_SCOPE_AGENT); }
__device__ __forceinline__ unsigned xb_xcc_id() { return (unsigned)__builtin_amdgcn_s_getreg((3 << 11) | 20) & 0xFu; }
#define XB_SPIN(cond, bar) do { unsigned _sp = 0; while (cond) { __builtin_amdgcn_s_sleep(1); \
    if ((++_sp & 255u) == 0u) { if (xb_ld(&(bar)[XB_TMO])) break; if (_sp > XB_SPIN_CAP) { atomicAdd(&(bar)[XB_TMO], 1u); break; } } } } while (0)

struct XcdBarrier {
    unsigned* bar; unsigned x;
    volatile LAS unsigned* st;
};

__device__ __forceinline__ XcdBarrier xcd_barrier_post(unsigned* bar, volatile LAS unsigned* st) {
    XcdBarrier b; b.bar = bar; b.x = xb_xcc_id(); b.st = st;
    if (threadIdx.x == 0) (void)xb_add(&bar[XB_XCNT(b.x)], 1u);
    return b;
}
__device__ __forceinline__ void xcd_barrier_complete(unsigned* bar, unsigned x, unsigned& nloc, unsigned& nx) {
    const unsigned G = gridDim.x * gridDim.y * gridDim.z;
    unsigned sum, cnt, mine, sp = 0u;
    for (;;) {
        sum = 0u; cnt = 0u; mine = 0u;
#pragma unroll
        for (unsigned j = 0; j < 16; ++j) { const unsigned c = xb_ld(&bar[XB_XCNT(j)]); sum += c; cnt += (c > 0u) ? 1u : 0u; mine = (j == x) ? c : mine; }
        if (sum == G) break;
        __builtin_amdgcn_s_sleep(1);
        if ((++sp & 255u) == 0u) { if (xb_ld(&bar[XB_TMO])) break; if (sp > XB_SPIN_CAP) { atomicAdd(&bar[XB_TMO], 1u); break; } }
    }
    nloc = mine > 0u ? mine : 1u; nx = cnt > 0u ? cnt : 1u;
}

__device__ __forceinline__ void xcd_barrier_lead(const XcdBarrier& b);
__device__ __forceinline__ void xcd_barrier(const XcdBarrier& b) {
    asm volatile("s_waitcnt vmcnt(0)" ::: "memory");
    __syncthreads();
    xcd_barrier_lead(b);
    __syncthreads();
}
__device__ __forceinline__ void xcd_barrier_arrive(const XcdBarrier&) { asm volatile("s_waitcnt vmcnt(0)" ::: "memory"); __syncthreads(); }
__device__ __forceinline__ void xcd_barrier_wait(const XcdBarrier& b) { xcd_barrier_lead(b); asm volatile("" ::: "memory"); __builtin_amdgcn_s_barrier(); asm volatile("" ::: "memory"); }
__device__ __forceinline__ void xcd_barrier_lead(const XcdBarrier& b) {
    if (threadIdx.x == 0) {
        unsigned* bar = b.bar;
        __builtin_amdgcn_s_waitcnt(0);
        unsigned nloc = b.st[0], nx = b.st[1];
        if (nloc == 0u) { xcd_barrier_complete(bar, b.x, nloc, nx); b.st[0] = nloc; b.st[1] = nx; }
        const unsigned nbar = b.st[2]; b.st[2] = nbar + 1u;
        const unsigned old = xb_add(&bar[XB_XSUB(b.x)], 1u);
        const unsigned gen = old / nloc;
        if (old + 1u == (gen + 1u) * nloc) {
            __builtin_amdgcn_fence(__ATOMIC_RELEASE, "agent");
            asm volatile("s_waitcnt vmcnt(0)" ::: "memory");
            const unsigned og = xb_add(&bar[XB_TOP], 1u);
            const unsigned tg = og / nx;
            __builtin_amdgcn_fence(__ATOMIC_ACQUIRE, "agent");
            if (og + 1u == (tg + 1u) * nx) xb_add(&bar[XB_TOPGEN], 1u);
            else XB_SPIN(xb_ld(&bar[XB_TOPGEN]) == tg, bar);
            asm volatile("s_waitcnt vmcnt(0)" ::: "memory");
        } else {
            __builtin_amdgcn_fence(__ATOMIC_ACQUIRE, "agent");
            (void)gen; XB_SPIN(xb_ld(&bar[XB_TOPGEN]) == nbar, bar);
            asm volatile("s_waitcnt vmcnt(0)" ::: "memory");
        }
    }
}

struct BarPre { static constexpr bool ON = true; const XcdBarrier& b; bool on; __device__ __forceinline__ void arrive() const { if (on) xcd_barrier_arrive(b); } __device__ __forceinline__ void wait() const { if (on) xcd_barrier_wait(b); } };

constexpr size_t MiB = 1u << 20;
constexpr size_t WS_CTL = 0, CTL_ZERO_BYTES = 163840;
constexpr size_t WS_WIN = 1 * MiB;
constexpr size_t WS_WOUT = 19 * MiB;
constexpr size_t WS_WQM = 27 * MiB;
constexpr size_t WS_WKV = 29 * MiB;
constexpr size_t WS_WOM = 33 * MiB;
constexpr size_t WS_WGU = 35 * MiB;
constexpr size_t WS_WD = 291 * MiB;
constexpr size_t WS_XN = 419 * MiB;
constexpr size_t WS_MEMN = 451 * MiB;
constexpr size_t WS_PROJ = 453 * MiB;
constexpr size_t WS_KVM = 525 * MiB;
constexpr size_t WS_OPART = 526 * MiB;
constexpr size_t WS_OB = 574 * MiB;
constexpr size_t WS_LPART = 590 * MiB;
constexpr size_t WS_MIXED = 591 * MiB;
constexpr size_t WS_X1 = 623 * MiB;
constexpr size_t WS_QM = 687 * MiB;
constexpr size_t WS_OM = 695 * MiB;
constexpr size_t WS_AFF = 703 * MiB;
constexpr size_t WS_IDX = 704 * MiB;
constexpr size_t WS_GATE = 704 * MiB + 65536;
constexpr size_t WS_INV = 704 * MiB + 131072;
constexpr size_t WS_RS = 704 * MiB + 655360;
constexpr size_t WS_WRT = 627 * MiB;
constexpr size_t WS_CTAB = 623 * MiB, WS_STAB = 625 * MiB;
constexpr size_t WS_SS1 = 65536, WS_SS2 = 131072;
constexpr size_t WS_XE = 705 * MiB;
constexpr size_t WS_ACT = 769 * MiB;
constexpr size_t WS_YS = 833 * MiB;
constexpr size_t WS_X2 = 897 * MiB;
constexpr size_t WS_END = 961 * MiB;
constexpr int CW_BAR = 4096;

constexpr int RING_BYTES = 131072;
constexpr int LDSCTL_OFF = RING_BYTES, MISC_OFF = LDSCTL_OFF + 320;
constexpr int LDS_BYTES = 147456;
constexpr int NWAVES = 8, NTHREADS = 512;

typedef unsigned v2u __attribute__((ext_vector_type(2)));
typedef float f32x2 __attribute__((ext_vector_type(2)));
typedef __bf16 bf16x2_t __attribute__((ext_vector_type(2)));
__device__ __forceinline__ unsigned cvtpk(float lo, float hi) { f32x2 v = {lo, hi}; bf16x2_t b = __builtin_convertvector(v, bf16x2_t); return __builtin_bit_cast(unsigned, b); }
__device__ __forceinline__ float bflo(unsigned w) { return __uint_as_float(w << 16); }
__device__ __forceinline__ float bfhi(unsigned w) { return __uint_as_float(w & 0xffff0000u); }
__device__ __forceinline__ float bf2f(unsigned short h) { return __uint_as_float((unsigned)h << 16); }
__device__ __forceinline__ float wave_sum(float v) {
#pragma unroll
    for (int o = 1; o < 64; o <<= 1) v += __shfl_xor(v, o);
    return v;
}
__device__ __forceinline__ float wave_max(float v) {
#pragma unroll
    for (int o = 1; o < 64; o <<= 1) v = fmaxf(v, __shfl_xor(v, o));
    return v;
}
__device__ __forceinline__ float gain_absmax(const float* g, int lane) { return wave_max(fmaxf(fabsf(g[lane]), fabsf(g[lane + 64]))); }

struct CvtTile { const float* src; bf16* dst; const float* gk; int N, K, mode, k0, n0, fp8; };
constexpr int T_IN = 16 * 18, T_OUT = 16 * 8, T_QM = 16 * 2, T_KV = 16 * 4, T_OM = 4 * 8, T_EXP = 16 * 128;
constexpr int T_TOTAL = T_IN + T_OUT + T_QM + T_KV + T_OM + 3 * T_EXP;
template <class A_> __device__ __forceinline__ CvtTile cvt_decode(int it, const A_& args, unsigned char* ws) {
    CvtTile t; int r = it; t.gk = nullptr; t.fp8 = 0;
    if (r < T_IN) { t.src = args.in[4]; t.dst = (bf16*)(ws + WS_WIN); t.N = DIN; t.K = DM; t.mode = 0; t.k0 = (r / 18) * 128; t.n0 = (r % 18) * 256; return t; } r -= T_IN;
    if (r < T_KV) { t.src = args.in[16]; t.dst = (bf16*)(ws + WS_WKV); t.N = 2 * WMEM; t.K = DM; t.mode = 0; t.k0 = (r / 4) * 128; t.n0 = (r % 4) * 256; return t; } r -= T_KV;
    if (r < T_OUT) { t.src = args.in[12]; t.dst = (bf16*)(ws + WS_WOUT); t.N = DM; t.K = DM; t.mode = 0; t.k0 = (r / 8) * 128; t.n0 = (r % 8) * 256; return t; } r -= T_OUT;
    if (r < T_QM) { t.src = args.in[15]; t.gk = args.in[13]; t.dst = (bf16*)(ws + WS_WQM); t.N = WMEM; t.K = DM; t.mode = 0; t.k0 = (r / 2) * 128; t.n0 = (r % 2) * 256; return t; } r -= T_QM;
    if (r < T_OM) { t.src = args.in[19]; t.dst = (bf16*)(ws + WS_WOM); t.N = DM; t.K = WMEM; t.mode = 0; t.k0 = (r / 8) * 128; t.n0 = (r % 8) * 256; return t; } r -= T_OM;
    const int which = r / T_EXP; r -= which * T_EXP; const int e = r / 128, rr = r % 128; t.fp8 = 1;
    t.N = DM; t.K = DM; t.k0 = (rr / 8) * 128; t.n0 = (rr % 8) * 256;
    if (which < 2) t.gk = args.in[20];
    if (which == 0) { t.src = args.in[22] + (size_t)e * DM * DFF; t.dst = (bf16*)(ws + WS_WGU + (size_t)e * 2 * DFF * DM); t.mode = 1; }
    else if (which == 1) { t.src = args.in[23] + (size_t)e * DM * DFF; t.dst = (bf16*)(ws + WS_WGU + (size_t)e * 2 * DFF * DM); t.mode = 2; }
    else { t.src = args.in[24] + (size_t)e * DFF * DM; t.dst = (bf16*)(ws + WS_WD + (size_t)e * DM * DFF); t.mode = 0; }
    return t;
}
#define CVT_ISSUE(v, t) do { const float* p_ = (t).src + (size_t)((t).k0 + 4 * (tid >> 6)) * (t).N + (t).n0 + 4 * (tid & 63); \
    _Pragma("unroll") for (int ps_ = 0; ps_ < 4; ++ps_) _Pragma("unroll") for (int r_ = 0; r_ < 4; ++r_) v[ps_ * 4 + r_] = __builtin_nontemporal_load((const GAS f32x4*)(p_ + (size_t)(32 * ps_ + r_) * (t).N)); } while (0)
__device__ __forceinline__ void cvt_to_lds(const f32x4 (&v)[16], const float* gk, int k0, LAS unsigned char* lds, int tid) {
    const int c = tid & 63, kg = tid >> 6, f = c & 15;
#pragma unroll
    for (int ps = 0; ps < 4; ++ps) { const int kch = 8 * ps + kg;
        f32x4 gq = (f32x4){1.f, 1.f, 1.f, 1.f}; if (gk) gq = *(const GAS f32x4*)(gk + k0 + 32 * ps + 4 * kg);
#pragma unroll
        for (int j = 0; j < 4; ++j) { v2u w; w.x = cvtpk(v[ps * 4 + 0][j] * gq.x, v[ps * 4 + 1][j] * gq.y); w.y = cvtpk(v[ps * 4 + 2][j] * gq.z, v[ps * 4 + 3][j] * gq.w);
            *(LAS v2u*)(lds + (4 * c + j) * 256 + ((kch ^ f) * 8)) = w; } }
}
__device__ __forceinline__ void cvt_to_lds8(const f32x4 (&v)[16], const float* gk, int k0, LAS unsigned char* lds, int tid) {
    const int c = tid & 63, kg = tid >> 6, f = c & 7;
#pragma unroll
    for (int ps = 0; ps < 4; ++ps) { const int kch = 8 * ps + kg;
        f32x4 gq = (f32x4){FP8_SW, FP8_SW, FP8_SW, FP8_SW}; if (gk) gq = *(const GAS f32x4*)(gk + k0 + 32 * ps + 4 * kg) * FP8_SW;
#pragma unroll
        for (int j = 0; j < 4; ++j) { const int w = pg8::cvt_fp8x4(v[ps * 4 + 0][j] * gq.x, v[ps * 4 + 1][j] * gq.y, v[ps * 4 + 2][j] * gq.z, v[ps * 4 + 3][j] * gq.w);
            *(LAS int*)(lds + (4 * c + j) * 128 + (((kch >> 2) ^ f) * 16) + (kch & 3) * 4) = w; } }
}
__device__ __forceinline__ void cvt_store8(const CvtTile& t, LAS unsigned char* lds, int tid) {
    const int q = tid & 7;
#pragma unroll
    for (int ps = 0; ps < 4; ++ps) { const int n = (tid >> 3) + 64 * ps, f = (n >> 2) & 7; const v4u w = *(LAS v4u*)(lds + n * 128 + ((q ^ f) * 16));
        const int nn = t.n0 + n; const int drow = t.mode == 0 ? nn : ((nn >> 7) * 256 + (nn & 127) + (t.mode == 2 ? 128 : 0));
        *(GAS v4u*)((unsigned char*)t.dst + (size_t)drow * t.K + t.k0 + 16 * q) = w; }
}
__device__ __forceinline__ void cvt_store(const CvtTile& t, LAS unsigned char* lds, int tid) {
    const int q = tid & 15;
#pragma unroll
    for (int ps = 0; ps < 8; ++ps) { const int n = (tid >> 4) + 32 * ps, f = (n >> 2) & 15; v4u w = *(LAS v4u*)(lds + n * 256 + ((q ^ (f >> 1)) * 16));
        if (f & 1) { const unsigned a = w.x, b = w.y; w.x = w.z; w.y = w.w; w.z = a; w.w = b; }
        const int nn = t.n0 + n; const int drow = t.mode == 0 ? nn : ((nn >> 7) * 256 + (nn & 127) + (t.mode == 2 ? 128 : 0));
        *(GAS v4u*)(t.dst + (size_t)drow * t.K + t.k0 + 8 * q) = w; }
}
constexpr int CT_P0A = T_IN + T_KV;
#ifndef CT_P1N
#define CT_P1N 3300
#endif
#ifndef CT_P7N
#define CT_P7N 13
#endif
#ifndef CT_P8N
#define CT_P8N 0
#endif
#ifndef CT_P11N
#define CT_P11N 2
#endif
#ifndef CT_P7G
#define CT_P7G 0
#endif
constexpr int CT_P1END = CT_P0A + CT_P1N, CT_P7END = CT_P1END + 192 * CT_P7N, CT_P8END = CT_P7END + 128 * CT_P8N, CT_P11END = CT_P8END + 224 * CT_P11N;
static_assert(CT_P11END <= T_TOTAL, "conversion slots");
constexpr int P1_GPX = 18;
constexpr int CT_P1KV = 180;
static_assert(CT_P1N >= T_OUT + T_QM + T_OM && CT_P1END <= T_TOTAL, "conversion split");
#define CVT_STEP(vc_, tc_, tn2_, hn2_) do { __syncthreads(); if ((tc_).fp8) cvt_to_lds8(vc_, (tc_).gk, (tc_).k0, lds, tid); else cvt_to_lds(vc_, (tc_).gk, (tc_).k0, lds, tid); \
        if (hn2_) CVT_ISSUE(vc_, tn2_); \
        LDS_WAIT(); __syncthreads(); if ((tc_).fp8) cvt_store8(tc_, lds, tid); else cvt_store(tc_, lds, tid); } while (0)
#define CONVERT_RANGE(t0_, t1_, j_, n_) do { f32x4 va_[16], vb_[16]; int it_ = (t0_) + (j_); \
        bool ha_ = it_ < (t1_); CvtTile ta_ = cvt_decode(ha_ ? it_ : 0, args, ws); if (ha_) CVT_ISSUE(va_, ta_); it_ += (n_); \
        bool hb_ = it_ < (t1_); CvtTile tb_ = cvt_decode(hb_ ? it_ : 0, args, ws); if (hb_) CVT_ISSUE(vb_, tb_); it_ += (n_); \
        while (ha_) { \
            { const bool h2_ = it_ < (t1_); const CvtTile t2_ = cvt_decode(h2_ ? it_ : 0, args, ws); it_ += (n_); CVT_STEP(va_, ta_, t2_, h2_); ta_ = t2_; ha_ = h2_; } \
            if (!hb_) break; \
            { const bool h2_ = it_ < (t1_); const CvtTile t2_ = cvt_decode(h2_ ? it_ : 0, args, ws); it_ += (n_); CVT_STEP(vb_, tb_, t2_, h2_); tb_ = t2_; hb_ = h2_; } } \
        __syncthreads(); } while (0)
__device__ __forceinline__ void norm_row_bf16(const float* xrow, const float* g, bf16* orow, int lane) {
    f32x4 v[8]; float ss = 0.f;
#pragma unroll
    for (int j = 0; j < 8; ++j) { v[j] = *(const GAS f32x4*)(xrow + lane * 4 + 256 * j); ss += (v[j].x * v[j].x + v[j].y * v[j].y) + (v[j].z * v[j].z + v[j].w * v[j].w); }
    const float rstd = 1.0f / sqrtf(wave_sum(ss) * (1.0f / DM) + EPS);
#pragma unroll
    for (int j = 0; j < 8; ++j) { const f32x4 gg = *(const GAS f32x4*)(g + lane * 4 + 256 * j); v2u w; w.x = cvtpk(v[j].x * rstd * gg.x, v[j].y * rstd * gg.y); w.y = cvtpk(v[j].z * rstd * gg.z, v[j].w * rstd * gg.w);
        *(GAS v2u*)(orow + lane * 4 + 256 * j) = w; }
}

namespace att {
typedef short s16x4 __attribute__((ext_vector_type(4)));
typedef float f32x16 __attribute__((ext_vector_type(16)));
constexpr int NBUF = 4, TILEB = 16384, VBUF = NBUF * TILEB;
static_assert(2 * NBUF * TILEB <= 131072, "attention LDS map");
__device__ __forceinline__ int crow(int r, int hi) { return (r & 3) + 8 * (r >> 2) + 4 * hi; }
__device__ __forceinline__ s16x4 vtr(const LAS unsigned char* p) { return __builtin_bit_cast(s16x4, __builtin_amdgcn_ds_read_tr16_b64_v4i16((LAS s16x4*)p)); }
struct AttnJob { const bf16* qw; long q_stride; const bf16* k0; const bf16* v0; long kv_stride; int tlo, thi, a, half; float negM2, l_extra; bf16* ow; long o_stride; float* lw; long l_stride; const float* ssrow; };
template <bool MASK, bool QNORM, bool NORMALIZE>
__device__ __forceinline__ void attn_unit(LAS unsigned char* lds, const AttnJob& J, bf16x8 (&qf)[8], float& ssn, const bool primed, const bool has_next, const AttnJob& N, int pf = 0) {
    const bf16* const qw = J.qw; const long q_stride = J.q_stride, kv_stride = J.kv_stride; const int tlo = J.tlo, thi = J.thi, a = J.a, half = J.half; const float negM2 = J.negM2, l_extra = J.l_extra;
    bf16* const ow = J.ow; const long o_stride = J.o_stride; float* const lw = J.lw; const long l_stride = J.l_stride;
    int tid_ = threadIdx.x; asm volatile("" : "+v"(tid_));
    const int tid = tid_, lane = tid & 63, c = lane & 31, hi = lane >> 5, wid = __builtin_amdgcn_readfirstlane(tid >> 6);
    const int srow = tid >> 4, sch = tid & 15;
    const long kvo_k = (long)(sch ^ (srow & 15)) * 8, kvo_v = (long)(sch ^ (((srow & 3) << 2) | ((srow >> 2) & 3))) * 8;
    const bf16* kg = J.k0 + (long)srow * kv_stride + kvo_k; const bf16* vg = J.v0 + (long)srow * kv_stride + kvo_v;
    const unsigned ldsw = (unsigned)wid * 1024u;
    const unsigned lds0 = (unsigned)(size_t)lds + ldsw;
#define AT_GLDS(gp, dst) do { unsigned keep_; asm volatile("s_mov_b32 %0, m0\n\ts_mov_b32 m0, %2\n\ts_nop 0\n\tglobal_load_lds_dwordx4 %1, off\n\ts_mov_b32 m0, %0" : "=&s"(keep_) : "v"(gp), "s"((unsigned)__builtin_amdgcn_readfirstlane(dst)) : "memory"); } while (0)
#define AT_ISSUE_G(kg_, vg_, st_, t, bw) do { const long r_ = (long)(t) * 64; \
        AT_GLDS((kg_) + r_ * (st_), lds0 + (bw) * TILEB); AT_GLDS((kg_) + (r_ + 32) * (st_), lds0 + (bw) * TILEB + 8192); \
        AT_GLDS((vg_) + r_ * (st_), lds0 + VBUF + (bw) * TILEB); AT_GLDS((vg_) + (r_ + 32) * (st_), lds0 + VBUF + (bw) * TILEB + 8192); } while (0)
#define AT_ISSUE(t, bw) AT_ISSUE_G(kg, vg, kv_stride, t, bw)
#define AT_WAITBAR(n) asm volatile("s_waitcnt vmcnt(" #n ") lgkmcnt(0)\n\ts_barrier" ::: "memory")
    if (!primed) {
        AT_ISSUE(tlo, 0);
        if (tlo + 1 < thi) AT_ISSUE(tlo + 1, 1);
        if (tlo + 2 < thi) AT_ISSUE(tlo + 2, 2);
        const bf16* qp = qw + (long)c * q_stride + 8 * hi;
#pragma unroll
        for (int ks = 0; ks < 8; ++ks) qf[ks] = (pf & 4) ? (bf16x8){0, 0, 0, 0, 0, 0, 0, 0} : *(const GAS bf16x8*)(qp + 16 * ks);
        if (QNORM) ssn = J.ssrow[c];
    }
    float qs = 1.f;
    if (QNORM) { float ss = 0.f;
#pragma unroll
        for (int ks = 0; ks < 8; ++ks)
#pragma unroll
            for (int j = 0; j < 8; ++j) { const float f = bf2f((unsigned short)qf[ks][j]); ss += f * f; }
        ss += __shfl_xor(ss, 32); const float r1 = 1.0f / sqrtf(ssn * (1.0f / DM) + EPS);
        qs = QSCALE * r1 / sqrtf(r1 * r1 * ss * (1.0f / HD) + EPS); }
    const unsigned kbase = c * 256; const int cx = c & 15;
    const int q4 = (lane & 15) >> 2, p = lane & 3, g = (lane >> 4) & 1;
    unsigned vbu[2];
#pragma unroll
    for (int u = 0; u < 2; ++u) vbu[u] = VBUF + 256 * (4 * hi + 8 * u + q4) + 16 * ((q4 << 2) | ((g ^ u) << 1) | ((p >> 1) ^ hi)) + 8 * (p & 1);
#define VB(db_, u_) (vbu[u_] ^ ((unsigned)(db_) << 6))
    f32x16 o[4];
#pragma unroll
    for (int db = 0; db < 4; ++db)
#pragma unroll
        for (int r = 0; r < 16; ++r) o[db][r] = 0.f;
    float lsum = 0.f;
    asm volatile("" : "+v"(qf[0]), "+v"(qf[1]), "+v"(qf[2]), "+v"(qf[3]), "+v"(qf[4]), "+v"(qf[5]), "+v"(qf[6]), "+v"(qf[7]));
    asm volatile("" : "+v"(qs));
    asm volatile("s_waitcnt lgkmcnt(0)\n\ts_barrier" ::: "memory");
    int buf = 0;
#pragma unroll 1
    for (int t = tlo; t < thi; ++t) {
        const bool more2 = (t + 2 < thi), more3 = (t + 3 < thi);
        if (more3) { const int b3 = (buf == 0) ? 3 : buf - 1; AT_ISSUE(t + 3, b3); }
        const bool need = !MASK || ((64 * t + 63 >= a - half) && (64 * t <= a + 31 + half));
        if (need) {
            const LAS unsigned char* kt = lds + buf * TILEB + kbase; const LAS unsigned char* vt = lds + buf * TILEB;
            const float ini = QNORM ? 0.f : negM2;
            const int jb = 64 * t + 4 * hi - (a + c);
            f32x16 pp[2];
#pragma unroll
            for (int kb = 0; kb < 2; ++kb) {
                bf16x8 ka[8];
#pragma unroll
                for (int ks = 0; ks < 8; ++ks) { const int off = 16 * ((2 * ks + hi) ^ cx) + 8192 * kb; ka[ks] = *(const LAS bf16x8*)(kt + off); }
#pragma unroll
                for (int r = 0; r < 16; ++r) pp[kb][r] = ini;
#pragma unroll
                for (int ks = 0; ks < 8; ++ks) pp[kb] = __builtin_amdgcn_mfma_f32_32x32x16_bf16(ka[ks], qf[ks], pp[kb], 0, 0, 0);
                __builtin_amdgcn_sched_barrier(0);
            }
            s16x4 vl[2][4], vh[2][4];
#pragma unroll
            for (int sp = 0; sp < 4; ++sp) { const int imm = 8192 * (sp >> 1) + 4096 * (sp & 1); vl[0][sp] = vtr(vt + VB(0, 0) + imm); vh[0][sp] = vtr(vt + VB(0, 1) + imm); }
            __builtin_amdgcn_sched_barrier(0);
            v4u pw[4];
#pragma unroll
            for (int kb = 0; kb < 2; ++kb) {
#pragma unroll
                for (int r = 0; r < 16; ++r) {
                    float e0 = QNORM ? __builtin_amdgcn_exp2f(__builtin_fmaf(pp[kb][r], qs, negM2)) : __builtin_amdgcn_exp2f(pp[kb][r]);
                    if (MASK) { const int d0 = jb + 32 * kb + (r & 3) + 8 * (r >> 2); if ((unsigned)(d0 + half) > (unsigned)(2 * half)) e0 = 0.f; }
                    pp[kb][r] = e0; lsum += e0; }
                pw[2 * kb] = (v4u){cvtpk(pp[kb][0], pp[kb][1]), cvtpk(pp[kb][2], pp[kb][3]), cvtpk(pp[kb][4], pp[kb][5]), cvtpk(pp[kb][6], pp[kb][7])};
                pw[2 * kb + 1] = (v4u){cvtpk(pp[kb][8], pp[kb][9]), cvtpk(pp[kb][10], pp[kb][11]), cvtpk(pp[kb][12], pp[kb][13]), cvtpk(pp[kb][14], pp[kb][15])};
            }
#pragma unroll
            for (int db = 0; db < 4; ++db) {
                if (db < 3) {
#pragma unroll
                    for (int sp = 0; sp < 4; ++sp) { const int imm = 8192 * (sp >> 1) + 4096 * (sp & 1); vl[(db + 1) & 1][sp] = vtr(vt + VB(db + 1, 0) + imm); vh[(db + 1) & 1][sp] = vtr(vt + VB(db + 1, 1) + imm); } }
#pragma unroll
                for (int sp = 0; sp < 4; ++sp) { const s16x4 lo = vl[db & 1][sp], hv = vh[db & 1][sp];
                    const bf16x8 vf = (bf16x8){lo[0], lo[1], lo[2], lo[3], hv[0], hv[1], hv[2], hv[3]};
                    o[db] = __builtin_amdgcn_mfma_f32_32x32x16_bf16(vf, __builtin_bit_cast(bf16x8, pw[sp]), o[db], 0, 0, 0); }
                __builtin_amdgcn_sched_barrier(0);
            }
        }
        if (more3) { AT_WAITBAR(8); } else if (more2) { AT_WAITBAR(4); } else { AT_WAITBAR(0); }
        buf = (buf == 3) ? 0 : buf + 1;
    }
    if (has_next) {
        const bf16* nkg = N.k0 + (long)srow * N.kv_stride + kvo_k; const bf16* nvg = N.v0 + (long)srow * N.kv_stride + kvo_v;
        AT_ISSUE_G(nkg, nvg, N.kv_stride, N.tlo, 0);
        if (N.tlo + 1 < N.thi) AT_ISSUE_G(nkg, nvg, N.kv_stride, N.tlo + 1, 1);
        if (N.tlo + 2 < N.thi) AT_ISSUE_G(nkg, nvg, N.kv_stride, N.tlo + 2, 2);
        const bf16* qp = N.qw + (long)c * N.q_stride + 8 * hi;
#pragma unroll
        for (int ks = 0; ks < 8; ++ks) if (!(pf & 8)) qf[ks] = *(const GAS bf16x8*)(qp + 16 * ks);
        if (QNORM) ssn = N.ssrow[c];
    }
    if (pf & 2) return;
    lsum += __shfl_xor(lsum, 32); lsum += l_extra;
    const float sc = NORMALIZE ? 1.0f / lsum : 1.0f;
    if (!NORMALIZE) { if (hi == 0) lw[(long)c * l_stride] = lsum; }
    LAS unsigned char* const ep = lds + (wid < 4 ? 3 * TILEB + wid * 4096 : VBUF + 3 * TILEB + (wid - 4) * 4096);
#pragma unroll
    for (int hf = 0; hf < 2; ++hf) {
#pragma unroll
        for (int dd = 0; dd < 2; ++dd)
#pragma unroll
            for (int gp = 0; gp < 2; ++gp) { const int db = 2 * hf + dd, r0 = 8 * gp;
                unsigned ax = cvtpk(o[db][r0] * sc, o[db][r0 + 1] * sc), ay = cvtpk(o[db][r0 + 2] * sc, o[db][r0 + 3] * sc);
                unsigned bx_ = cvtpk(o[db][r0 + 4] * sc, o[db][r0 + 5] * sc), by_ = cvtpk(o[db][r0 + 6] * sc, o[db][r0 + 7] * sc);
                { const auto r = __builtin_amdgcn_permlane32_swap(ax, bx_, false, false); ax = r[0]; bx_ = r[1]; }
                { const auto r = __builtin_amdgcn_permlane32_swap(ay, by_, false, false); ay = r[0]; by_ = r[1]; }
                const int chunk = dd * 4 + gp * 2 + hi;
                *(LAS v4u*)(ep + c * 128 + ((chunk ^ (c & 7)) * 16)) = (v4u){ax, ay, bx_, by_}; }
        asm volatile("s_waitcnt lgkmcnt(0)" ::: "memory");
#pragma unroll
        for (int j = 0; j < 4; ++j) { const int row = (lane >> 3) + 8 * j, chunk = lane & 7; const v4u w = *(const LAS v4u*)(ep + row * 128 + ((chunk ^ (row & 7)) * 16));
            if (!(pf & 16)) *(GAS v4u*)(ow + (long)row * o_stride + 64 * hf + 8 * chunk) = w; }
        asm volatile("s_waitcnt lgkmcnt(0)" ::: "memory");
    }
#undef VB
#undef AT_ISSUE
#undef AT_ISSUE_G
#undef AT_GLDS
#undef AT_WAITBAR
}
}

#define PLAIN_A_OFFS(lda_) static constexpr bool GATHER = false; __device__ __forceinline__ void a_offs(const pg8::Unit&, const int (&RA)[2], const int (&CA)[2], unsigned (&vA)[2][2]) const { \
        _Pragma("unroll") for (int h = 0; h < 2; ++h) _Pragma("unroll") for (int i = 0; i < 2; ++i) vA[h][i] = (unsigned)((h * 128 + RA[i]) * (lda_) + CA[i] * 2); }
struct OrderP1 {
    int G, c, kvj; const char* XN; const char* WIN; const char* MEMN; const char* WKV;
    __device__ __forceinline__ bool next(int i, pg8::Unit& u) const {
        int pm, pn; u.rows = nullptr;
        if (kvj < 0) { if (pg8::static_order(i, G, c, 32, 18, pm, pn)) { u.pm = pm; u.pn = pn; u.kind = 0; u.A = XN + (size_t)pm * 256 * DM * 2; u.B = WIN + (size_t)pn * 256 * DM * 2; return true; }
            const long L = (long)i * G + c - 576; if (kvj == -1 || L < 0 || L >= 8) return false;
            u.pm = (int)L >> 2; u.pn = (int)L & 3; u.kind = 1; u.A = MEMN + (size_t)u.pm * 256 * DM * 2; u.B = WKV + (size_t)u.pn * 256 * DM * 2; return true; }
        if (i > 0 || kvj >= 8) return false;
        u.pm = kvj >> 2; u.pn = kvj & 3; u.kind = 1; u.A = MEMN + (size_t)u.pm * 256 * DM * 2; u.B = WKV + (size_t)u.pn * 256 * DM * 2; return true;
    }
    PLAIN_A_OFFS(DM * 2)
    __device__ __forceinline__ void a_ready(const pg8::Unit&) const {}
    __device__ __forceinline__ void done(const pg8::Unit&) const {}
};
struct OrderPlain {
    int G, c, nM, nN, KB; const char* A; const char* B;
    __device__ __forceinline__ bool next(int i, pg8::Unit& u) const {
        int pm, pn; if (!pg8::static_order(i, G, c, nM, nN, pm, pn)) return false;
        u.pm = pm; u.pn = pn; u.kind = 0; u.rows = nullptr; u.A = A + (size_t)pm * 256 * KB; u.B = B + (size_t)pn * 256 * KB; return true;
    }
    PLAIN_A_OFFS(KB)
    __device__ __forceinline__ void a_ready(const pg8::Unit&) const {}
    __device__ __forceinline__ void done(const pg8::Unit&) const {}
};
struct OrderMoe {
    int G, c, nN, KB; const char* A; const char* B;
    __device__ __forceinline__ bool next(int i, pg8::Unit& u) const {
        int pm, pn; if (!pg8::static_order(i, G, c, 64, nN, pm, pn, 4)) return false;
        u.pm = pm; u.pn = pn; u.kind = 0; u.rows = nullptr; u.A = A + (size_t)pm * 256 * KB; u.B = B + ((size_t)(pm >> 2) * nN + pn) * 256 * KB; return true;
    }
    PLAIN_A_OFFS(KB)
    __device__ __forceinline__ void a_ready(const pg8::Unit&) const {}
    __device__ __forceinline__ void done(const pg8::Unit&) const {}
};
struct OrderMoeG {
    static constexpr bool GATHER = true; int G, c; const char* X; const char* B; const int* idx;
    __device__ __forceinline__ bool next(int i, pg8::Unit& u) const {
        int pm, pn; if (!pg8::static_order(i, G, c, 64, 16, pm, pn, 4)) return false;
        u.pm = pm; u.pn = pn; u.kind = 0; u.rows = idx + pm * 256; u.A = X + (size_t)((pm >> 1) & 1) * SEQ * DM; u.B = B + ((size_t)(pm >> 2) * 16 + pn) * 256 * DM; return true;
    }
    __device__ __forceinline__ void a_offs(const pg8::Unit& u, const int (&RA)[2], const int (&CA)[2], unsigned (&vA)[2][2]) const {
#pragma unroll
        for (int h = 0; h < 2; ++h)
#pragma unroll
            for (int i = 0; i < 2; ++i) vA[h][i] = (unsigned)(u.rows[h * 128 + RA[i]] * DM + CA[i] * 2); }
    __device__ __forceinline__ void a_ready(const pg8::Unit&) const {}
    __device__ __forceinline__ void done(const pg8::Unit&) const {}
};

constexpr int NPHASE = 16;
struct Args { const float* in[25]; float* out; unsigned char* ws; int ph_lo, ph_hi, variant, pad; };
static_assert(sizeof(Args) == 25 * 8 + 8 + 8 + 16, "Args has no padding");

__global__ void __launch_bounds__(NTHREADS, 2) fwd_kernel(Args args) {
    extern __shared__ __attribute__((aligned(16))) unsigned char lds_raw[];
    LAS unsigned char* lds = (LAS unsigned char*)lds_raw;
    volatile LAS unsigned* MISC = (volatile LAS unsigned*)(lds + MISC_OFF);
    const int tid = threadIdx.x, lane = tid & 63, wave = __builtin_amdgcn_readfirstlane(tid >> 6);
    const int G = gridDim.x; const int bx = blockIdx.x; const int vcu = (G % 8 == 0) ? (bx % 8) * (G / 8) + bx / 8 : bx;
    unsigned char* ws = args.ws;
    gu32* ctl = (gu32*)(ws + WS_CTL);
    for (int u = tid; u < (LDS_BYTES - LDSCTL_OFF) / 4; u += NTHREADS) ((LAS unsigned*)(lds + LDSCTL_OFF))[u] = 0u;
    __syncthreads();
    XcdBarrier bar; bar.bar = (unsigned*)(ctl + CW_BAR); bar.x = 0; bar.st = nullptr;
    if (MK_ONE_LAUNCH) bar = xcd_barrier_post((unsigned*)(ctl + CW_BAR), MISC + 8);
    const int lo = args.ph_lo, hi = args.ph_hi;
#ifndef PH_MASK
#define PH_MASK 0xffff
#endif
#define IN(k) (((PH_MASK >> (k)) & 1) && lo <= (k) && (k) < hi)
#define SEAM(k) do { if (IN(k) && (k) + 1 < hi) xcd_barrier(bar); } while (0)
    const int gw = vcu * NWAVES + wave, NGW = G * NWAVES;
#define PH_BEGIN(k) if (IN(k)) { PHASE_IDS
#define PRESYNC(k) (G == 256 && IN(k) && (k) + 1 < hi)
#define PHASE_IDS int tid_p_ = threadIdx.x; asm volatile("" : "+v"(tid_p_)); const int tid = tid_p_, lane = tid_p_ & 63; (void)tid; (void)lane; \
    const __attribute__((address_space(4))) Args* ap_ = (const __attribute__((address_space(4))) Args*)__builtin_amdgcn_kernarg_segment_ptr(); asm volatile("" : "+s"(ap_)); const __attribute__((address_space(4))) Args& args = *ap_; unsigned char* const ws = args.ws; (void)ws;

#define WIN ((bf16*)(ws + WS_WIN))
#define WOUT ((bf16*)(ws + WS_WOUT))
#define WQM ((bf16*)(ws + WS_WQM))
#define WKV ((bf16*)(ws + WS_WKV))
#define WOM ((bf16*)(ws + WS_WOM))
#define WGU ((bf16*)(ws + WS_WGU))
#define WD ((bf16*)(ws + WS_WD))
#define XN ((bf16*)(ws + WS_XN))
#define MEMN ((bf16*)(ws + WS_MEMN))
#define PROJ ((bf16*)(ws + WS_PROJ))
#define KVM ((bf16*)(ws + WS_KVM))
#define OPART ((bf16*)(ws + WS_OPART))
#define OB ((bf16*)(ws + WS_OB))
#define LPART ((float*)(ws + WS_LPART))
#define MIXED ((bf16*)(ws + WS_MIXED))
#define QM ((bf16*)(ws + WS_QM))
#define OM ((bf16*)(ws + WS_OM))
#define AFF ((float*)(ws + WS_AFF))
#define IDX ((int*)(ws + WS_IDX))
#define GATE ((float*)(ws + WS_GATE))
#define INV ((int*)(ws + WS_INV))
#define YS (ws + WS_YS)
#define OUT (args.out)
#define XN8 (ws + WS_XE)
#define ACT8 (ws + WS_ACT)
#define SS1 ((float*)(ws + WS_SS1))
#define SS2 ((float*)(ws + WS_SS2))
#define RS ((float*)(ws + WS_RS))
    PH_BEGIN(0)
        if (G == 256) { CONVERT_RANGE(0, CT_P0A, vcu, G); CONVERT_RANGE(CT_P11END, T_TOTAL, vcu, G); } else CONVERT_RANGE(0, T_TOTAL, vcu, G);
        for (int i = bx * NTHREADS + tid; i < NEXP * DM; i += G * NTHREADS) { const int e = i >> 11, k = i & (DM - 1); const float v = args.in[21][k * NEXP + e] * args.in[20][k];
            const unsigned h1 = f2bf(v); const float r1 = v - bf2f((unsigned short)h1); const unsigned h2 = f2bf(r1); const float r2 = r1 - bf2f((unsigned short)h2);
            bf16* w3 = (bf16*)(ws + WS_WRT); w3[i] = (bf16)h1; w3[NEXP * DM + i] = (bf16)h2; w3[2 * NEXP * DM + i] = (bf16)f2bf(r2); }
        for (int m = gw; m < TOK + BATCH * NMEM; m += NGW) {
            if (m < TOK) norm_row_bf16(args.in[0] + (size_t)m * DM, args.in[3], XN + (size_t)m * DM, lane);
            else norm_row_bf16(args.in[1] + (size_t)(m - TOK) * DM, args.in[14], MEMN + (size_t)(m - TOK) * DM, lane);
        }
    }
    SEAM(0);
    PH_BEGIN(1)
        const int xj = vcu & 31, xc = vcu >> 5; const bool split = (G == 256), conv = split && (xj >= P1_GPX); const int cj = (xj - P1_GPX) * 8 + xc;
        OrderP1 S{split ? 8 * P1_GPX : G, split ? xj * 8 + xc : bx, conv ? cj : (split ? -1 : -2), (const char*)XN, (const char*)WIN, (const char*)MEMN, (const char*)WKV};
        pg8::EpiProj E{PROJ, KVM, args.in[5], args.in[6], args.in[7], args.in[8], args.in[18], args.in[17], (const int*)args.in[2], (PG8_LAS float*)(lds + 132096), TOK};
        E.stage_gains();
        pg8::gemm_phase<pg8::EpiProj, OrderP1>(lds, DM * 2, DM * 2, S, E);
        if (conv) { PHASE_IDS
            if (cj >= 8) CONVERT_RANGE(CT_P0A + CT_P1KV, CT_P1END, cj - 8, 8 * (32 - P1_GPX) - 8); else CONVERT_RANGE(CT_P0A, CT_P0A + CT_P1KV, cj, 8); }
    }
    SEAM(1);
    PH_BEGIN(3)
        const float negM2a = __uint_as_float(__builtin_amdgcn_readfirstlane(__float_as_uint(-(SQRT_HD * LOG2E) * gain_absmax(args.in[5], lane) * gain_absmax(args.in[6], lane))));
        const float negM2b = __uint_as_float(__builtin_amdgcn_readfirstlane(__float_as_uint(-(SQRT_HD * LOG2E) * gain_absmax(args.in[7], lane) * gain_absmax(args.in[8], lane))));
        const int pv = args.variant;
#define P3_JOB(J, kind, u0_) do { const int u = (pv == 3) ? 768 + ((u0_) & 255) : (pv == 4 && (u0_) >= 768) ? ((u0_) & 255) : (u0_); \
            if (u < 768) {   \
                const int xc = (u & 255) >> 5, Lh = (u & 31) + 32 * (u >> 8), pr = 2 * xc + Lh / 48, w = Lh % 48; \
                const int gi = (pv == 1) ? 0 : (pv == 2) ? 2 : (w >> 4), b = pr >> 3, h = pr & 7, x = w & 15; \
                const int dlog = 2 * gi, d = 1 << dlog, r = x & (d - 1), blk = x >> dlog; \
                const int L = SEQ >> dlog, i0 = blk * 256, a = i0 + 32 * wave; \
                const size_t tok0 = (size_t)b * SEQ + r; \
                kind = 0; J.qw = PROJ + ((size_t)h * TOK + tok0 + (size_t)d * a) * HD; J.q_stride = (long)d * HD; J.k0 = PROJ + ((size_t)(8 + h) * TOK + tok0) * HD; J.v0 = PROJ + ((size_t)(16 + h) * TOK + tok0) * HD; J.kv_stride = (long)d * HD; \
                J.tlo = (i0 >> 6) - 1 < 0 ? 0 : (i0 >> 6) - 1; J.thi = (i0 >> 6) + 5 > (L >> 6) ? (L >> 6) : (i0 >> 6) + 5; J.a = a; J.half = (pv >= 5) ? -100000 : 64; J.negM2 = negM2a; J.l_extra = 0.f; \
                J.ow = OPART + (size_t)gi * TOK * 1024 + (tok0 + (size_t)d * a) * 1024 + h * HD; J.o_stride = (long)d * 1024; J.lw = LPART + (size_t)gi * TOK * 8 + (tok0 + (size_t)d * a) * 8 + h; J.l_stride = (long)d * 8; J.ssrow = nullptr; \
            } else { const int ub = u - 768, b = ub >> 7, kvh = (ub >> 6) & 1, blk = ub & 63; \
                const int i0 = blk * 64, a = i0 + 32 * (wave & 1), head = kvh * 4 + (wave >> 1); \
                const size_t tok0 = (size_t)b * SEQ; \
                kind = 1; J.qw = PROJ + ((size_t)(24 + head) * TOK + tok0 + a) * HD; J.q_stride = (long)HD; J.k0 = PROJ + ((size_t)(32 + kvh) * TOK + tok0) * HD; J.v0 = PROJ + ((size_t)(34 + kvh) * TOK + tok0) * HD; J.kv_stride = (long)HD; \
                J.tlo = blk - 2 < 0 ? 0 : blk - 2; J.thi = blk + 3 > 64 ? 64 : blk + 3; J.a = a; J.half = (pv >= 5) ? -100000 : 128; J.negM2 = negM2b; J.l_extra = __uint_as_float(__builtin_amdgcn_readfirstlane(__float_as_uint(__builtin_amdgcn_exp2f(args.in[9][head] * LOG2E + negM2b)))); \
                J.ow = OB + (tok0 + a) * 1024 + head * HD; J.o_stride = 1024L; J.lw = nullptr; J.l_stride = 0L; J.ssrow = nullptr; } } while (0)
        bf16x8 qf[8]; float ssn = 0.f;
#pragma unroll
        for (int ks = 0; ks < 8; ++ks) qf[ks] = (bf16x8){0, 0, 0, 0, 0, 0, 0, 0};
        att::AttnJob J, N; int kJ = 0, kN = 0; bool primed = false;
        if (vcu < 1024) P3_JOB(J, kJ, vcu);
        for (int u0 = vcu; u0 < 1024; u0 += G) {
            const bool has_next = (u0 + G < 1024) && pv != 6 && pv != 7;
            if (u0 + G < 1024) P3_JOB(N, kN, u0 + G); else { N = J; kN = kJ; }
            const int pf = pv == 6 ? 2 : pv == 7 ? 6 : pv == 8 ? 8 : pv == 9 ? 16 : pv == 10 ? 24 : 0;
            if (kJ == 0) att::attn_unit<true, false, false>(lds, J, qf, ssn, primed, has_next, N, pf);
            else att::attn_unit<true, false, true>(lds, J, qf, ssn, primed, has_next, N, pf);
            primed = has_next; J = N; kJ = kN;
        }
#undef P3_JOB
    }
    SEAM(3);
    PH_BEGIN(4)
        float ga[16], gb[16];
#pragma unroll
        for (int q = 0; q < 4; ++q) { const f32x4 a4 = *(const GAS f32x4*)(args.in[10] + lane * 16 + 4 * q), b4 = *(const GAS f32x4*)(args.in[11] + lane * 16 + 4 * q);
            ga[4 * q] = a4.x; ga[4 * q + 1] = a4.y; ga[4 * q + 2] = a4.z; ga[4 * q + 3] = a4.w; gb[4 * q] = b4.x; gb[4 * q + 1] = b4.y; gb[4 * q + 2] = b4.z; gb[4 * q + 3] = b4.w; }
        for (int m = gw; m < TOK; m += NGW) {
            const int hd = lane >> 3; float oa[16], ob[16];
            float l = 0.f;
#pragma unroll
            for (int k = 0; k < 16; ++k) oa[k] = 0.f;
#pragma unroll
            for (int gi = 0; gi < 3; ++gi) { l += LPART[(size_t)gi * TOK * 8 + (size_t)m * 8 + hd];
                const GAS v4u* p = (const GAS v4u*)(OPART + (size_t)gi * TOK * 1024 + (size_t)m * 1024 + lane * 16);
#pragma unroll
                for (int q = 0; q < 2; ++q) { const v4u w = p[q]; oa[8 * q + 0] += bflo(w.x); oa[8 * q + 1] += bfhi(w.x); oa[8 * q + 2] += bflo(w.y); oa[8 * q + 3] += bfhi(w.y);
                    oa[8 * q + 4] += bflo(w.z); oa[8 * q + 5] += bfhi(w.z); oa[8 * q + 6] += bflo(w.w); oa[8 * q + 7] += bfhi(w.w); } }
            const float il = 1.0f / l; float ssa = 0.f, ssb = 0.f;
#pragma unroll
            for (int k = 0; k < 16; ++k) { oa[k] *= il; ssa += oa[k] * oa[k]; }
            { const GAS v4u* p = (const GAS v4u*)(OB + (size_t)m * 1024 + lane * 16);
#pragma unroll
              for (int q = 0; q < 2; ++q) { const v4u w = p[q]; ob[8 * q + 0] = bflo(w.x); ob[8 * q + 1] = bfhi(w.x); ob[8 * q + 2] = bflo(w.y); ob[8 * q + 3] = bfhi(w.y);
                  ob[8 * q + 4] = bflo(w.z); ob[8 * q + 5] = bfhi(w.z); ob[8 * q + 6] = bflo(w.w); ob[8 * q + 7] = bfhi(w.w); } }
#pragma unroll
            for (int k = 0; k < 16; ++k) ssb += ob[k] * ob[k];
            const float ra = 1.0f / sqrtf(wave_sum(ssa) * (1.0f / 1024.0f) + EPS), rb = 1.0f / sqrtf(wave_sum(ssb) * (1.0f / 1024.0f) + EPS);
            v4u wa[2], wb[2];
#pragma unroll
            for (int q = 0; q < 2; ++q) {
                wa[q] = (v4u){cvtpk(oa[8 * q] * ra * ga[8 * q], oa[8 * q + 1] * ra * ga[8 * q + 1]), cvtpk(oa[8 * q + 2] * ra * ga[8 * q + 2], oa[8 * q + 3] * ra * ga[8 * q + 3]),
                              cvtpk(oa[8 * q + 4] * ra * ga[8 * q + 4], oa[8 * q + 5] * ra * ga[8 * q + 5]), cvtpk(oa[8 * q + 6] * ra * ga[8 * q + 6], oa[8 * q + 7] * ra * ga[8 * q + 7])};
                wb[q] = (v4u){cvtpk(ob[8 * q] * rb * gb[8 * q], ob[8 * q + 1] * rb * gb[8 * q + 1]), cvtpk(ob[8 * q + 2] * rb * gb[8 * q + 2], ob[8 * q + 3] * rb * gb[8 * q + 3]),
                              cvtpk(ob[8 * q + 4] * rb * gb[8 * q + 4], ob[8 * q + 5] * rb * gb[8 * q + 5]), cvtpk(ob[8 * q + 6] * rb * gb[8 * q + 6], ob[8 * q + 7] * rb * gb[8 * q + 7])}; }
            GAS v4u* pa = (GAS v4u*)(MIXED + (size_t)m * DM + lane * 16); GAS v4u* pb = (GAS v4u*)(MIXED + (size_t)m * DM + 1024 + lane * 16);
            pa[0] = wa[0]; pa[1] = wa[1]; pb[0] = wb[0]; pb[1] = wb[1];
        }
    }
    if (!PRESYNC(4)) SEAM(4);
    PH_BEGIN(5)
        OrderPlain S{G, bx, 32, 8, DM * 2, (const char*)MIXED, (const char*)WOUT};
        pg8::EpiResidX E{args.in[0], nullptr, nullptr, (args.variant == 3) ? nullptr : XN, nullptr, SS1, DM, args.variant};
        pg8::gemm_phase<pg8::EpiResidX, OrderPlain, false, true, BarPre>(lds, DM * 2, DM * 2, S, E, BarPre{bar, PRESYNC(4)});
    }
    SEAM(5);
    PH_BEGIN(7)
        OrderPlain S{G, bx, 32, 2, DM * 2, (const char*)XN, (const char*)WQM};
        pg8::EpiBf16 E{QM, WMEM, QM, WMEM, 0};
        pg8::gemm_phase<pg8::EpiBf16, OrderPlain>(lds, DM * 2, DM * 2, S, E);
        if (G == 256) { PHASE_IDS
            if (bx >= 64) CONVERT_RANGE(CT_P1END, CT_P7END, bx - 64, 192);
            else {
                int pm = 0, pn = 0; (void)pg8::static_order(0, G, bx, 32, 2, pm, pn);
                const float gg = wave_max(fmaxf(fabsf(args.in[17][lane] * args.in[18][lane]), fabsf(args.in[17][lane + 64] * args.in[18][lane + 64])));
                const float negM2c = __uint_as_float(__builtin_amdgcn_readfirstlane(__float_as_uint(-(SQRT_HD * LOG2E) * gg)));
                bf16x8 qf[8]; float ssn = 0.f;
#pragma unroll
                for (int ks = 0; ks < 8; ++ks) qf[ks] = (bf16x8){0, 0, 0, 0, 0, 0, 0, 0};
                const int b = pm >> 4, blk = pm & 15, a = blk * 256 + 32 * wave; const size_t tok0 = (size_t)b * SEQ;
                att::AttnJob J0, J1;
#define P7_JOB(J, h) do { J.qw = QM + (tok0 + a) * WMEM + (h) * HD; J.q_stride = (long)WMEM; J.k0 = KVM + (size_t)b * NMEM * 2 * WMEM + (h) * HD; J.v0 = KVM + (size_t)b * NMEM * 2 * WMEM + WMEM + (h) * HD; J.kv_stride = 2L * WMEM; \
                    J.tlo = 0; J.thi = 4; J.a = a; J.half = 1 << 20; J.negM2 = negM2c; J.l_extra = 0.f; J.ow = OM + (tok0 + a) * WMEM + (h) * HD; J.o_stride = (long)WMEM; J.lw = nullptr; J.l_stride = 0L; J.ssrow = SS1 + tok0 + a; } while (0)
                P7_JOB(J0, 2 * pn); P7_JOB(J1, 2 * pn + 1);
#undef P7_JOB
                att::attn_unit<false, true, true>(lds, J0, qf, ssn, false, true, J1);
                att::attn_unit<false, true, true>(lds, J1, qf, ssn, true, false, J1);
            }
        }
    }
    if (G != 256) SEAM(7);
    PH_BEGIN(8)
        const float gg = wave_max(fmaxf(fabsf(args.in[17][lane] * args.in[18][lane]), fabsf(args.in[17][lane + 64] * args.in[18][lane + 64])));
        const float negM2c = __uint_as_float(__builtin_amdgcn_readfirstlane(__float_as_uint(-(SQRT_HD * LOG2E) * gg)));
        bf16x8 qf[8]; float ssn = 0.f;
#pragma unroll
        for (int ks = 0; ks < 8; ++ks) qf[ks] = (bf16x8){0, 0, 0, 0, 0, 0, 0, 0};
        for (int u = vcu; u < 128 && G != 256; u += G) {
            const int b = u >> 6, h = (u >> 4) & 3, blk = u & 15, a = blk * 256 + 32 * wave;
            const size_t tok0 = (size_t)b * SEQ;
            att::AttnJob J; J.qw = QM + (tok0 + a) * WMEM + h * HD; J.q_stride = (long)WMEM; J.k0 = KVM + (size_t)b * NMEM * 2 * WMEM + h * HD; J.v0 = KVM + (size_t)b * NMEM * 2 * WMEM + WMEM + h * HD; J.kv_stride = 2L * WMEM;
            J.tlo = 0; J.thi = 4; J.a = a; J.half = 1 << 20; J.negM2 = negM2c; J.l_extra = 0.f; J.ow = OM + (tok0 + a) * WMEM + h * HD; J.o_stride = (long)WMEM; J.lw = nullptr; J.l_stride = 0L; J.ssrow = SS1 + tok0 + a;
            att::attn_unit<false, true, true>(lds, J, qf, ssn, false, false, J);
        }
    }
    if (!PRESYNC(8)) SEAM(8);
    PH_BEGIN(9)
        OrderPlain S{G, bx, 32, 8, WMEM * 2, (const char*)OM, (const char*)WOM};
        pg8::EpiResidX E{nullptr, XN, nullptr, XN, XN8, SS2, DM, args.variant};
        pg8::gemm_phase<pg8::EpiResidX, OrderPlain, false, true, BarPre>(lds, WMEM * 2, WMEM * 2, S, E, BarPre{bar, PRESYNC(8)});
    }
    SEAM(9);
    PH_BEGIN(10)
        LAS float* PL = (LAS float*)lds;
        LAS float* PS = PL + 8 * 32 * 16;
        LAS float* PA = PS + 8 * 32;
        const int fr = lane & 15, fq = lane >> 4;
        for (int t0 = vcu * 32; t0 < TOK; t0 += G * 32) {
            f32x4 c0 = (f32x4){0.f, 0.f, 0.f, 0.f}, c1 = c0; float s0 = 0.f, s1 = 0.f;
            const bf16* xa = XN + (size_t)(t0 + fr) * DM + 256 * wave + 8 * fq;
            const bf16* wb = (const bf16*)(ws + WS_WRT) + (size_t)fr * DM + 256 * wave + 8 * fq;
#pragma unroll
            for (int ks = 0; ks < 8; ++ks) {
                const bf16x8 a0 = *(const GAS bf16x8*)(xa + 32 * ks), a1 = *(const GAS bf16x8*)(xa + 16 * DM + 32 * ks);
                const bf16x8 b0 = *(const GAS bf16x8*)(wb + 32 * ks), b1 = *(const GAS bf16x8*)(wb + NEXP * DM + 32 * ks), b2 = *(const GAS bf16x8*)(wb + 2 * NEXP * DM + 32 * ks);
#pragma unroll
                for (int j = 0; j < 8; ++j) { const float u0 = bf2f((unsigned short)a0[j]), u1 = bf2f((unsigned short)a1[j]); s0 += u0 * u0; s1 += u1 * u1; }
                c0 = __builtin_amdgcn_mfma_f32_16x16x32_bf16(a0, b2, c0, 0, 0, 0); c1 = __builtin_amdgcn_mfma_f32_16x16x32_bf16(a1, b2, c1, 0, 0, 0);
                c0 = __builtin_amdgcn_mfma_f32_16x16x32_bf16(a0, b1, c0, 0, 0, 0); c1 = __builtin_amdgcn_mfma_f32_16x16x32_bf16(a1, b1, c1, 0, 0, 0);
                c0 = __builtin_amdgcn_mfma_f32_16x16x32_bf16(a0, b0, c0, 0, 0, 0); c1 = __builtin_amdgcn_mfma_f32_16x16x32_bf16(a1, b0, c1, 0, 0, 0);
            }
            s0 += __shfl_xor(s0, 16); s0 += __shfl_xor(s0, 32); s1 += __shfl_xor(s1, 16); s1 += __shfl_xor(s1, 32);
            __syncthreads();
#pragma unroll
            for (int r = 0; r < 4; ++r) { PL[(wave * 32 + 4 * fq + r) * 16 + fr] = c0[r]; PL[(wave * 32 + 16 + 4 * fq + r) * 16 + fr] = c1[r]; }
            if (fq == 0) { PS[wave * 32 + fr] = s0; PS[wave * 32 + 16 + fr] = s1; }
            LDS_WAIT(); __syncthreads();
            { const int tk = tid >> 4, e = tid & 15; float lg = 0.f, sq = 0.f;
#pragma unroll
              for (int w = 0; w < 8; ++w) { lg += PL[(w * 32 + tk) * 16 + e]; sq += PS[w * 32 + tk]; }
              const float tv = lg * (1.0f / sqrtf(sq * (1.0f / DM) + EPS));
              float mx = tv;
#pragma unroll
              for (int o = 1; o < 16; o <<= 1) mx = fmaxf(mx, __shfl_xor(mx, o));
              const float ex = expf(tv - mx); float dn = ex;
#pragma unroll
              for (int o = 1; o < 16; o <<= 1) dn += __shfl_xor(dn, o);
              PA[e * 32 + tk] = ex / dn; }
            LDS_WAIT(); __syncthreads();
            { const int e = tid >> 5, tk = tid & 31, m = t0 + tk; AFF[((size_t)(m >> 12) * NEXP + e) * SEQ + (m & (SEQ - 1))] = PA[e * 32 + tk]; }
        }
    }
    SEAM(10);
    PH_BEGIN(11)
        LAS unsigned* hist = (LAS unsigned*)lds; LAS unsigned* misc = hist + 256; LAS unsigned* wtot = hist + 272;
        if (G == 256 && vcu >= 32 && CT_P11N > 0) CONVERT_RANGE(CT_P8END, CT_P11END, vcu - 32, 224);
        for (int u = vcu; u < BATCH * NEXP; u += G) {
            const int b = u >> 4, e = u & 15; const float* aff = AFF + (size_t)u * SEQ;
            const f32x4 a0 = *(const GAS f32x4*)(aff + tid * 8), a1 = *(const GAS f32x4*)(aff + tid * 8 + 4);
            unsigned bits[8] = {__float_as_uint(a0.x), __float_as_uint(a0.y), __float_as_uint(a0.z), __float_as_uint(a0.w), __float_as_uint(a1.x), __float_as_uint(a1.y), __float_as_uint(a1.z), __float_as_uint(a1.w)};
            unsigned prefix = 0u, krem = CAP;
#pragma unroll 1
            for (int pass = 0; pass < 4; ++pass) { const int shift = 24 - 8 * pass;
                __syncthreads();
                if (tid < 256) hist[tid] = 0u;
                __syncthreads();
#pragma unroll
                for (int i = 0; i < 8; ++i) if (pass == 0 || (bits[i] >> (shift + 8)) == prefix) __hip_atomic_fetch_add(&hist[(bits[i] >> shift) & 255u], 1u, __ATOMIC_RELAXED, __HIP_MEMORY_SCOPE_WORKGROUP);
                __syncthreads();
                if (wave == 0) {
                    const unsigned h0 = hist[255 - 4 * lane], h1 = hist[254 - 4 * lane], h2 = hist[253 - 4 * lane], h3 = hist[252 - 4 * lane];
                    const unsigned s = h0 + h1 + h2 + h3; unsigned incl = s;
#pragma unroll
                    for (int o = 1; o < 64; o <<= 1) { const unsigned t = __shfl_up(incl, o); if (lane >= o) incl += t; }
                    const unsigned excl = incl - s;
                    if (excl < krem && krem <= incl) { unsigned rem = krem - excl; unsigned bin;
                        if (rem <= h0) bin = 255 - 4 * lane; else { rem -= h0; if (rem <= h1) bin = 254 - 4 * lane; else { rem -= h1; if (rem <= h2) bin = 253 - 4 * lane; else { rem -= h2; bin = 252 - 4 * lane; } } }
                        misc[0] = (prefix << 8) | bin; misc[1] = rem; }
                }
                __syncthreads();
                prefix = misc[0]; krem = misc[1];
            }
            unsigned ngt = 0u, neq = 0u;
#pragma unroll
            for (int i = 0; i < 8; ++i) { ngt += bits[i] > prefix; neq += bits[i] == prefix; }
            unsigned cnt = ngt | (neq << 16), incl = cnt;
#pragma unroll
            for (int o = 1; o < 64; o <<= 1) { const unsigned t = __shfl_up(incl, o); if (lane >= o) incl += t; }
            if (lane == 63) wtot[wave] = incl;
            __syncthreads();
            unsigned base = 0u;
#pragma unroll
            for (int w = 0; w < 8; ++w) if (w < wave) base += wtot[w];
            const unsigned excl = base + incl - cnt; unsigned gtb = excl & 0xffffu, eqb = excl >> 16;
            const int rowbase = (e * BATCH + b) * CAP;
            const float vals[8] = {a0.x, a0.y, a0.z, a0.w, a1.x, a1.y, a1.z, a1.w};
#pragma unroll
            for (int i = 0; i < 8; ++i) { const bool gt = bits[i] > prefix, eq = bits[i] == prefix; const bool sel = gt || (eq && eqb < krem);
                const int slot = (int)(gtb + (eqb < krem ? eqb : krem)); const int s = tid * 8 + i;
                if (sel) { IDX[rowbase + slot] = s; GATE[rowbase + slot] = vals[i]; RS[rowbase + slot] = 1.0f / sqrtf(SS2[(size_t)b * SEQ + s] * (1.0f / DM) + EPS); }
                INV[((size_t)b * SEQ + s) * NEXP + e] = sel ? rowbase + slot : -1;
                gtb += gt; eqb += eq; }
            __syncthreads();
        }
    }
    SEAM(11);
    PH_BEGIN(13)
        OrderMoeG S{G, bx, (const char*)XN8, (const char*)WGU, IDX};
        pg8::EpiSwiGlu8 E{ACT8, DFF, RS, 1.0f / (FP8_SX * FP8_SW), FP8_SA, (PG8_LAS float*)(lds + 132096)};
        pg8::gemm_phase<pg8::EpiSwiGlu8, OrderMoeG, true>(lds, DM, DM, S, E);
    }
    SEAM(13);
    PH_BEGIN(14)
        OrderMoe S{G, bx, 8, DFF, (const char*)ACT8, (const char*)WD};
        pg8::EpiScaleBf16 E{YS, DM, GATE, FP8_SY / (FP8_SA * FP8_SW), (PG8_LAS float*)(lds + 132096)};
        pg8::gemm_phase<pg8::EpiScaleBf16, OrderMoe, true>(lds, DFF, DFF, S, E);
    }
    if (!PRESYNC(14)) SEAM(14);
    PH_BEGIN(15)
        const bool pre = PRESYNC(14);
        v2u xw[2][8]; int myr[2];
#define P15_LOAD(m0_) do { _Pragma("unroll") for (int t = 0; t < 2; ++t) { const int m = (m0_) + t * NGW; if (m < TOK) { const bf16* xrow = XN + (size_t)m * DM + lane * 4; \
                    _Pragma("unroll") for (int j = 0; j < 8; ++j) xw[t][j] = *(const GAS v2u*)(xrow + 256 * j); \
                    myr[t] = (lane < NEXP) ? INV[(size_t)m * NEXP + lane] : -1; } else myr[t] = -1; } } while (0)
        if (pre) xcd_barrier_arrive(bar);
        if (wave != 0) P15_LOAD(gw);
        if (pre) xcd_barrier_wait(bar);
        if (wave == 0) P15_LOAD(gw);
        for (int m0 = gw; m0 < TOK; m0 += 2 * NGW) {
            f32x4 acc[2][8];
            if (m0 != gw) P15_LOAD(m0);
#pragma unroll
            for (int t = 0; t < 2; ++t)
#pragma unroll
                for (int j = 0; j < 8; ++j) { const v2u w = xw[t][j]; acc[t][j] = (f32x4){bflo(w.x), bfhi(w.x), bflo(w.y), bfhi(w.y)}; }
#pragma unroll
            for (int t = 0; t < 2; ++t) { unsigned long long mask = __ballot(myr[t] >= 0);
                while (mask) { const int e = __builtin_ctzll(mask); mask &= mask - 1; const int r = __builtin_amdgcn_readlane(myr[t], e);
                    const GAS int* p = (const GAS int*)(YS + (size_t)r * DM + lane * 4);
#pragma unroll
                    for (int j = 0; j < 8; ++j) { const int w = p[64 * j]; const f32x2 lo = __builtin_amdgcn_cvt_pk_f32_fp8(w, false), hi2 = __builtin_amdgcn_cvt_pk_f32_fp8(w, true);
                        acc[t][j].x += lo.x * (1.0f / FP8_SY); acc[t][j].y += lo.y * (1.0f / FP8_SY); acc[t][j].z += hi2.x * (1.0f / FP8_SY); acc[t][j].w += hi2.y * (1.0f / FP8_SY); } } }
#pragma unroll
            for (int t = 0; t < 2; ++t) { const int m = m0 + t * NGW; if (m < TOK) { float* orow = OUT + (size_t)m * DM + lane * 4;
#pragma unroll
                    for (int j = 0; j < 8; ++j) *(GAS f32x4*)(orow + 256 * j) = acc[t][j]; } }
        }
    }
#ifdef PROBE_XBAR
    for (int i_ = 0; i_ < PROBE_XBAR; ++i_) xcd_barrier(bar);
#endif
#undef IN
#undef SEAM
}

extern "C" void kernel_launch(void* const* d_in, const int* in_sizes, int n_in, void* d_out, int out_size, void* d_ws, size_t ws_size, hipStream_t stream) {
    static int grid = 0;
    if (grid == 0) {
        if (n_in != 25 || out_size != TOK * DM || ws_size < WS_END) { fprintf(stderr, "kernel_launch: unexpected problem (n_in %d out %d ws %zu)\n", n_in, out_size, ws_size); grid = -1; return; }
        int dev = 0, cus = 0;
        if (hipGetDevice(&dev) != hipSuccess || hipDeviceGetAttribute(&cus, hipDeviceAttributeMultiprocessorCount, dev) != hipSuccess) { grid = -1; return; }
        if (hipFuncSetAttribute((const void*)fwd_kernel, hipFuncAttributeMaxDynamicSharedMemorySize, LDS_BYTES) != hipSuccess) { fprintf(stderr, "kernel_launch: hipFuncSetAttribute failed\n"); grid = -1; return; }
        int per_cu = 0; (void)hipOccupancyMaxActiveBlocksPerMultiprocessor(&per_cu, (const void*)fwd_kernel, NTHREADS, LDS_BYTES); (void)hipGetLastError();
        grid = cus;
    }
    if (grid < 0) return;
    (void)hipMemsetAsync((char*)d_ws + WS_CTL, 0, CTL_ZERO_BYTES, stream);
    Args a{};
    for (int i = 0; i < 25; ++i) a.in[i] = (const float*)d_in[i];
    a.out = (float*)d_out; a.ws = (unsigned char*)d_ws;
#if MK_ONE_LAUNCH
    a.ph_lo = 0; a.ph_hi = NPHASE;
    hipLaunchKernelGGL(fwd_kernel, dim3(grid), dim3(NTHREADS), LDS_BYTES, stream, a);
#ifdef PROBE_RELAUNCH
#ifndef PROBE_VARIANT
#define PROBE_VARIANT 0
#endif
    for (int p = 0; p < NPHASE; ++p) if ((PROBE_RELAUNCH >> p) & 1) { a.ph_lo = p; a.ph_hi = p + 1; a.variant = PROBE_VARIANT; hipLaunchKernelGGL(fwd_kernel, dim3(grid), dim3(NTHREADS), LDS_BYTES, stream, a); }
#endif
#else
    for (int p = 0; p < NPHASE; ++p) { a.ph_lo = p; a.ph_hi = p + 1; hipLaunchKernelGGL(fwd_kernel, dim3(grid), dim3(NTHREADS), LDS_BYTES, stream, a); }
#endif
}
```
